# Optimizing an MI355X kernel written in HIP

```python
import jax
import jax.numpy as jnp
from jax import lax
import numpy as np

D_MODEL = 1024
BATCH = 8
SEQ = 2048
DEPTH = 2

DN_HEADS = 4
DN_DK = 128
DN_DV = 128
DN_CONV = 4
DN_CHUNK = 64
DN_WIDTH = DN_HEADS * DN_DV
POOL_WINDOWS = (2, 4, 8, 16)
POOL_GROUP = 128
POOL_WIDTH = POOL_GROUP * len(POOL_WINDOWS)
SA_HEADS = 4
SA_HEAD_DIM = 128
SA_WIDTH = SA_HEADS * SA_HEAD_DIM
IDX_HEADS = 4
IDX_DIM = 64
TOPK_MAX = 256
Q_BLOCK = 128
ROPE_THETA = 10000.0
NORM_EPS = 1e-6
N_BRANCH = 3
BRANCH_WIDTH = 512
SPLIT_SIZES = (DN_WIDTH, DN_WIDTH, DN_WIDTH, DN_WIDTH, DN_HEADS, DN_HEADS,
               POOL_WIDTH, POOL_WIDTH,
               SA_WIDTH, SA_WIDTH, SA_WIDTH, SA_WIDTH, IDX_HEADS * IDX_DIM, IDX_DIM, IDX_HEADS,
               N_BRANCH * D_MODEL)
IN_WIDTH = sum(SPLIT_SIZES)

kernel_name = 'hybrid_deltanet_pool_dsa'


def rms_norm(x, g):
    x32 = x.astype(jnp.float32)
    y = x32 * lax.rsqrt(jnp.mean(x32 * x32, axis=-1, keepdims=True) + NORM_EPS)
    return y.astype(x.dtype) * g


def l2_normalize(x):
    x32 = x.astype(jnp.float32)
    return x32 * lax.rsqrt(jnp.sum(x32 * x32, axis=-1, keepdims=True) + NORM_EPS)


def rope_tables(seq_len, dim):
    inv_freq = ROPE_THETA ** (-jnp.arange(0, dim, 2, dtype=jnp.float32) / dim)
    ang = jnp.arange(seq_len, dtype=jnp.float32)[:, None] * inv_freq[None, :]
    return jnp.cos(ang), jnp.sin(ang)


def apply_rope(x, cos, sin):
    x32 = x.astype(jnp.float32)
    x1, x2 = jnp.split(x32, 2, axis=-1)
    c = cos[None, :, None, :]
    s = sin[None, :, None, :]
    return jnp.concatenate([x1 * c - x2 * s, x2 * c + x1 * s], axis=-1).astype(x.dtype)


def split_columns(proj):
    parts = []
    start = 0
    for size in SPLIT_SIZES:
        parts.append(proj[..., start:start + size])
        start += size
    return parts


def causal_depthwise_conv(x, w):
    k = w.shape[0]
    return lax.conv_general_dilated(x, w[:, None, :], window_strides=(1,), padding=((k - 1, 0),),
                                    dimension_numbers=('NWC', 'WIO', 'NWC'),
                                    feature_group_count=x.shape[-1])


def chunk_gated_delta_rule(q, k, v, beta, g):
    b, t, h, dk = q.shape
    dv = v.shape[-1]
    n = t // DN_CHUNK
    c = DN_CHUNK
    to_chunks4 = lambda a: a.reshape(b, n, c, h, a.shape[-1]).transpose(1, 0, 3, 2, 4)
    to_chunks3 = lambda a: a.reshape(b, n, c, h).transpose(1, 0, 3, 2)
    qc = to_chunks4(q * (dk ** -0.5))
    kc = to_chunks4(k)
    vc = to_chunks4(v)
    bc = to_chunks3(beta)
    gc = jnp.cumsum(to_chunks3(g), axis=-1)
    tril = jnp.tril(jnp.ones((c, c), dtype=bool))
    strict = jnp.tril(jnp.ones((c, c), dtype=bool), -1)
    decay = jnp.exp(jnp.where(tril, gc[..., :, None] - gc[..., None, :], -jnp.inf))
    k_beta = kc * bc[..., None]
    v_beta = vc * bc[..., None]
    lmat = jnp.where(strict, jnp.einsum('nbhid,nbhjd->nbhij', k_beta, kc) * decay, 0.0)
    eye = jnp.eye(c, dtype=jnp.float32)
    tmat = lax.linalg.triangular_solve(eye + lmat, jnp.broadcast_to(eye, lmat.shape),
                                       left_side=True, lower=True, unit_diagonal=True)
    u = jnp.einsum('nbhij,nbhjd->nbhid', tmat, v_beta)
    w = jnp.einsum('nbhij,nbhjd->nbhid', tmat, k_beta * jnp.exp(gc)[..., None])
    attn_intra = jnp.where(tril, jnp.einsum('nbhid,nbhjd->nbhij', qc, kc) * decay, 0.0)

    def step(state, xs):
        q_i, k_i, u_i, w_i, g_i, a_i = xs
        v_new = u_i - jnp.einsum('bhck,bhkv->bhcv', w_i, state)
        o = (jnp.einsum('bhck,bhkv->bhcv', q_i * jnp.exp(g_i)[..., None], state)
             + jnp.einsum('bhij,bhjv->bhiv', a_i, v_new))
        g_last = g_i[..., -1:]
        state = (state * jnp.exp(g_last)[..., None]
                 + jnp.einsum('bhck,bhcv->bhkv', k_i * jnp.exp(g_last - g_i)[..., None], v_new))
        return state, o

    state0 = jnp.zeros((b, h, dk, dv), dtype=jnp.float32)
    _, o = lax.scan(step, state0, (qc, kc, u, w, gc, attn_intra))
    return o.transpose(1, 0, 3, 2, 4).reshape(b, t, h, dv)


def deltanet_branch(qa, ka, va, za, ba, aa, conv_w, a_log, dt_bias, o_norm):
    b, t, _ = qa.shape
    qkv = jax.nn.silu(causal_depthwise_conv(jnp.concatenate([qa, ka, va], axis=-1), conv_w))
    q, k, v = jnp.split(qkv, 3, axis=-1)
    q = l2_normalize(q.reshape(b, t, DN_HEADS, DN_DK))
    k = l2_normalize(k.reshape(b, t, DN_HEADS, DN_DK))
    v = v.reshape(b, t, DN_HEADS, DN_DV).astype(jnp.float32)
    beta = jax.nn.sigmoid(ba.astype(jnp.float32))
    g = -jnp.exp(a_log.astype(jnp.float32)) * jax.nn.softplus(aa.astype(jnp.float32) + dt_bias.astype(jnp.float32))
    o = chunk_gated_delta_rule(q, k, v, beta, g)
    o = rms_norm(o, o_norm) * jax.nn.silu(za.reshape(b, t, DN_HEADS, DN_DV))
    return o.reshape(b, t, DN_WIDTH)


def pooling_branch(u, z, pool_w, pool_scale):
    b, t, _ = u.shape
    u32 = u.astype(jnp.float32)
    cs = jnp.cumsum(u32, axis=1)
    pos_count = jnp.arange(1, t + 1, dtype=jnp.int32)
    groups = []
    for gi, win in enumerate(POOL_WINDOWS):
        sl = slice(gi * POOL_GROUP, (gi + 1) * POOL_GROUP)
        cs_g = cs[..., sl]
        lagged = jnp.pad(cs_g, ((0, 0), (win, 0), (0, 0)))[:, :t]
        count = jnp.minimum(pos_count, win).astype(jnp.float32)[None, :, None]
        groups.append((cs_g - lagged) / count - u32[..., sl])
    pooled = jnp.stack(groups, axis=2)
    mixed = jnp.einsum('btgc,gcd->btgd', pooled.astype(pool_w.dtype), pool_w).reshape(b, t, POOL_WIDTH)
    return mixed * pool_scale * jax.nn.silu(z)


def sparse_attention_branch(qc, kc, vc, zc, iq, ik, iw, q_norm, k_norm, cos_a, sin_a, cos_i, sin_i):
    b, t, _ = qc.shape
    q = apply_rope(rms_norm(qc.reshape(b, t, SA_HEADS, SA_HEAD_DIM), q_norm), cos_a, sin_a)
    k = apply_rope(rms_norm(kc.reshape(b, t, SA_HEADS, SA_HEAD_DIM), k_norm), cos_a, sin_a)
    v = vc.reshape(b, t, SA_HEADS, SA_HEAD_DIM)
    qi = apply_rope(iq.reshape(b, t, IDX_HEADS, IDX_DIM), cos_i, sin_i)
    ki = apply_rope(ik.reshape(b, t, 1, IDX_DIM), cos_i, sin_i)[:, :, 0].astype(jnp.float32)
    wi = iw.astype(jnp.float32) * (IDX_HEADS ** -0.5 * IDX_DIM ** -0.5)
    topk = min(TOPK_MAX, t // 4)
    nb = t // Q_BLOCK
    to_blocks = lambda a: a.reshape((b, nb, Q_BLOCK) + a.shape[2:]).swapaxes(0, 1)
    key_pos = jnp.arange(t, dtype=jnp.int32)
    gather_rows = jax.vmap(lambda src, idx: src[idx])

    def attend(xs):
        q_b, qi_b, wi_b, start = xs
        q_pos = start + jnp.arange(Q_BLOCK, dtype=jnp.int32)
        causal = key_pos[None, :] <= q_pos[:, None]
        dots = jnp.einsum('bqhd,bsd->bqhs', qi_b.astype(jnp.float32), ki)
        score = jnp.einsum('bqh,bqhs->bqs', wi_b, jax.nn.relu(dots))
        score = jnp.where(causal[None], score, -jnp.inf)
        _, idx = lax.top_k(score, topk)
        k_sel = gather_rows(k, idx)
        v_sel = gather_rows(v, idx)
        logits = jnp.einsum('bqhd,bqkhd->bhqk', q_b.astype(jnp.float32), k_sel.astype(jnp.float32)) * (SA_HEAD_DIM ** -0.5)
        valid = idx <= q_pos[None, :, None]
        logits = jnp.where(valid[:, None], logits, -jnp.inf)
        p = jax.nn.softmax(logits, axis=-1)
        return jnp.einsum('bhqk,bqkhd->bqhd', p.astype(v_sel.dtype), v_sel)

    starts = jnp.arange(nb, dtype=jnp.int32) * Q_BLOCK
    o = lax.map(attend, (to_blocks(q), to_blocks(qi), to_blocks(wi), starts))
    o = o.swapaxes(0, 1).reshape(b, t, SA_WIDTH)
    return o * jax.nn.silu(zc)


def hybrid_layer(x, norm_g, w_in, gate_b, conv_w, a_log, dt_bias, dn_onorm, pool_w, pool_scale,
                 q_norm, k_norm, w_branch, w_out, cos_a, sin_a, cos_i, sin_i):
    b, t, _ = x.shape
    h = rms_norm(x, norm_g)
    proj = jnp.einsum('btd,de->bte', h, w_in)
    (qa, ka, va, za, ba, aa, ub, zb, qc, kc, vc, zc, iq, ik, iw, gates) = split_columns(proj)
    ya = deltanet_branch(qa, ka, va, za, ba, aa, conv_w, a_log, dt_bias, dn_onorm)
    yb = pooling_branch(ub, zb, pool_w, pool_scale)
    yc = sparse_attention_branch(qc, kc, vc, zc, iq, ik, iw, q_norm, k_norm, cos_a, sin_a, cos_i, sin_i)
    branches = jnp.stack([ya, yb, yc], axis=2).astype(w_branch.dtype)
    projected = jnp.einsum('btnc,ncd->btnd', branches, w_branch)
    gate = jax.nn.sigmoid(gates.reshape(b, t, N_BRANCH, D_MODEL).astype(jnp.float32) + gate_b.astype(jnp.float32))
    merged = jnp.sum(gate * projected, axis=2).astype(w_out.dtype)
    return x + jnp.einsum('btd,de->bte', merged, w_out).astype(x.dtype)


def setup_inputs(seed: int = 0) -> dict:
    key = jax.random.key(seed)
    ks = jax.random.split(key, 16)
    f32 = jnp.float32
    x = jax.random.normal(ks[0], (BATCH, SEQ, D_MODEL), f32)
    norm_g = 1.0 + 0.02 * jax.random.normal(ks[1], (DEPTH, D_MODEL), f32)
    w_in = jax.random.normal(ks[2], (DEPTH, D_MODEL, IN_WIDTH), f32) * D_MODEL ** -0.5
    gate_b = 0.02 * jax.random.normal(ks[3], (DEPTH, N_BRANCH, D_MODEL), f32)
    conv_w = jax.random.normal(ks[4], (DEPTH, DN_CONV, 3 * DN_WIDTH), f32) * DN_CONV ** -0.5
    a_log = jnp.log(jax.random.uniform(ks[5], (DEPTH, DN_HEADS), f32, minval=1.0, maxval=16.0))
    dt = jnp.exp(jax.random.uniform(ks[6], (DEPTH, DN_HEADS), f32, minval=float(np.log(1e-3)), maxval=float(np.log(1e-1))))
    dt_bias = dt + jnp.log(-jnp.expm1(-dt))
    dn_onorm = 1.0 + 0.02 * jax.random.normal(ks[7], (DEPTH, DN_DV), f32)
    pool_w = jax.random.normal(ks[8], (DEPTH, len(POOL_WINDOWS), POOL_GROUP, POOL_GROUP), f32) * POOL_GROUP ** -0.5
    pool_scale = 1.0 + 0.1 * jax.random.normal(ks[9], (DEPTH, POOL_WIDTH), f32)
    q_norm = 1.0 + 0.02 * jax.random.normal(ks[10], (DEPTH, SA_HEAD_DIM), f32)
    k_norm = 1.0 + 0.02 * jax.random.normal(ks[11], (DEPTH, SA_HEAD_DIM), f32)
    w_branch = jax.random.normal(ks[12], (DEPTH, N_BRANCH, BRANCH_WIDTH, D_MODEL), f32) * BRANCH_WIDTH ** -0.5
    w_out = jax.random.normal(ks[13], (DEPTH, D_MODEL, D_MODEL), f32) * D_MODEL ** -0.5
    return {'x': x, 'norm_g': norm_g, 'w_in': w_in, 'gate_b': gate_b, 'conv_w': conv_w,
            'a_log': a_log, 'dt_bias': dt_bias, 'dn_onorm': dn_onorm, 'pool_w': pool_w,
            'pool_scale': pool_scale, 'q_norm': q_norm, 'k_norm': k_norm,
            'w_branch': w_branch, 'w_out': w_out}


def reference(x, norm_g, w_in, gate_b, conv_w, a_log, dt_bias, dn_onorm, pool_w, pool_scale,
              q_norm, k_norm, w_branch, w_out):
    t = x.shape[1]
    cos_a, sin_a = rope_tables(t, SA_HEAD_DIM)
    cos_i, sin_i = rope_tables(t, IDX_DIM)
    for layer in range(DEPTH):
        x = hybrid_layer(x, norm_g[layer], w_in[layer], gate_b[layer], conv_w[layer], a_log[layer],
                         dt_bias[layer], dn_onorm[layer], pool_w[layer], pool_scale[layer],
                         q_norm[layer], k_norm[layer], w_branch[layer], w_out[layer],
                         cos_a, sin_a, cos_i, sin_i)
    return x
```

```cpp
#include <hip/hip_runtime.h>
#include <hip/hip_cooperative_groups.h>
#include <cstdio>
#include <cstdint>
#include <cmath>
namespace cg = cooperative_groups;
constexpr int BATCH = 8, SEQ = 2048, DM = 1024, MTOK = BATCH * SEQ;
constexpr int INW = 8524;
constexpr int N1 = 5632;
constexpr int NG = 3072;
constexpr float NORM_EPS = 1e-6f;
constexpr size_t MiB = 1u << 20;
constexpr size_t WS_CTL = 0;
constexpr size_t CTL_BYTES = 4096;
constexpr size_t WS_COSA = 1 * MiB, WS_SINA = WS_COSA + 512 * 1024;
constexpr size_t WS_COSI = 2 * MiB, WS_SINI = WS_COSI + 256 * 1024;
constexpr size_t WS_DEC = 2 * MiB + 512 * 1024;
constexpr size_t WS_MISC = 3 * MiB;
constexpr size_t WS_WG = 4 * MiB;
constexpr size_t WS_WBR = 10 * MiB;
constexpr size_t WS_WO = 13 * MiB;
constexpr size_t WS_POOLW = 15 * MiB;
constexpr size_t WS_MASK = 16 * MiB;
constexpr size_t WS_R1 = 20 * MiB;
constexpr size_t WS_H = WS_R1;
constexpr size_t WS_WIN1 = WS_R1 + 32 * MiB;
constexpr size_t WS_SCAN = WS_R1;
constexpr size_t WS_G0 = WS_R1, WS_G1 = WS_R1 + 32 * MiB;
constexpr size_t WS_R2 = 93 * MiB;
constexpr size_t WS_AQKV = WS_R2;
constexpr size_t WS_H2 = WS_R2;
constexpr size_t WS_MERGED = WS_R2;
constexpr size_t WS_R3 = 141 * MiB;
constexpr size_t WS_CQKV = WS_R3;
constexpr size_t WS_G2 = WS_R3;
constexpr size_t WS_AZ = 189 * MiB, WS_BZ = 205 * MiB, WS_CZ = 221 * MiB, WS_BU = 237 * MiB;
constexpr size_t WS_CIDX = 253 * MiB;
constexpr size_t WS_END = 263 * MiB;
constexpr int SCAN_UNIT_BYTES = 73728;
constexpr int SU_W = 0, SU_QG = 16384, SU_KDT = 32768, SU_UT = 49152, SU_A = 65536;
namespace pg8 {
#define PG8_LAS __attribute__((address_space(3)))
typedef unsigned short bf16_t;
typedef short bf16x8 __attribute__((ext_vector_type(8)));
typedef float f32x4 __attribute__((ext_vector_type(4)));
typedef unsigned u32x4 __attribute__((ext_vector_type(4)));
constexpr int BM = 256, BK = 64, HALF = 128, HTB = HALF * BK * 2  , STAGE_BYTES = 8 * HTB, NXCD = 8, WGM = 8;

__host__ __device__ __forceinline__ int lds_byte(int r, int c) { const int st = (r >> 4) * 2 + (c >> 5), rr = r & 15, cc = c & 31, ob = rr * 64 + cc * 2; return st * 1024 + (ob ^ (((ob >> 9) & 1) << 5)); }
__host__ __device__ __forceinline__ void stage_rc(int b, int& R, int& C) { const int st = b / 1024, sb = b % 1024, swz = sb ^ (((sb >> 9) & 1) << 5); R = (st >> 1) * 16 + swz / 64; C = (st & 1) * 32 + (swz % 64) / 2; }
__host__ __device__ __forceinline__ int perm32(int rho) { const int n = rho >> 4, i = rho & 15; return 8 * (i >> 2) + 4 * n + (i & 3); }

struct Unit { int pm, pn; };
struct Gemm { const bf16_t* A; const bf16_t* Bt; int M, N, K; };

struct StaticOrder {
    int nM, nN, nwg, G, c;
    __host__ __device__ void init(int M, int N, int G_, int c_) { nM = M / BM; nN = N / BM; nwg = nM * nN; G = G_; c = c_; }
    __host__ __device__ bool next(int i, Unit& u) const {
        const long L = (long)i * G + c; if (L >= nwg) return false;
        int wgid = (int)L; { const int q = nwg / NXCD, r = nwg % NXCD, xcd = wgid % NXCD, off = wgid / NXCD; wgid = (xcd < r ? xcd * (q + 1) : r * (q + 1) + (xcd - r) * q) + off; }
        const int nig = WGM * nN, gid = wgid / nig, fm = gid * WGM, gsz = (nM - fm) < WGM ? (nM - fm) : WGM;
        u.pm = fm + ((wgid % nig) % gsz); u.pn = (wgid % nig) / gsz; return true;
    }
    __device__ __forceinline__ void a_ready(const Unit&) const {}
    __device__ __forceinline__ void done(const Unit&) const {}
};

__device__ __forceinline__ unsigned cvt_pk_bf16(float lo, float hi) { unsigned r; asm volatile("v_cvt_pk_bf16_f32 %0, %1, %2" : "=v"(r) : "v"(lo), "v"(hi)); return r; }
struct EpiProj {
    static constexpr bool PERM = true, AFTER_DRAIN = false;
    unsigned char* ws;
    __device__ __forceinline__ void operator()(const f32x4 (&acc)[2][2][4][2], const Unit& u, int wr, int wc, int fr, int fq) const {
        const int pn = u.pn; const int row0 = u.pm * BM + wr * 64 + fr;
        if (pn == 21) {
            const int c = wc * 32 + 8 * fq;
            if (c < 80) {
#pragma unroll
                for (int ai = 0; ai < 2; ++ai)
#pragma unroll
                    for (int m = 0; m < 4; ++m) { const size_t row = (size_t)(row0 + ai * HALF + m * 16); const f32x4 v0 = acc[ai][0][m][0], v1 = acc[ai][0][m][1];
                        if (c < 64) { u32x4 w; w.x = cvt_pk_bf16(v0[0], v0[1]); w.y = cvt_pk_bf16(v0[2], v0[3]); w.z = cvt_pk_bf16(v1[0], v1[1]); w.w = cvt_pk_bf16(v1[2], v1[3]);
                            *(u32x4*)((bf16_t*)(ws + WS_CIDX) + row * 320 + 256 + c) = w; }
                        else { float* mp = (float*)(ws + WS_MISC) + row * 16 + (c - 64); *(f32x4*)mp = v0; *(f32x4*)(mp + 4) = v1; } }
            }
            return;
        }
        size_t off; int ldc, colt;
        if (pn < 6) { off = WS_AQKV; ldc = 1536; colt = pn * 256; }
        else if (pn < 8) { off = WS_AZ; ldc = 512; colt = (pn - 6) * 256; }
        else if (pn < 10) { off = WS_BU; ldc = 512; colt = (pn - 8) * 256; }
        else if (pn < 12) { off = WS_BZ; ldc = 512; colt = (pn - 10) * 256; }
        else if (pn < 18) { off = WS_CQKV; ldc = 1536; colt = (pn - 12) * 256; }
        else if (pn < 20) { off = WS_CZ; ldc = 512; colt = (pn - 18) * 256; }
        else { off = WS_CIDX; ldc = 320; colt = 0; }
        bf16_t* base = (bf16_t*)(ws + off); const int col0 = colt + wc * 32 + 8 * fq;
#pragma unroll
        for (int ai = 0; ai < 2; ++ai)
#pragma unroll
            for (int m = 0; m < 4; ++m) { bf16_t* rowp = base + (size_t)(row0 + ai * HALF + m * 16) * ldc + col0;
#pragma unroll
                for (int bj = 0; bj < 2; ++bj) { const f32x4 v0 = acc[ai][bj][m][0], v1 = acc[ai][bj][m][1];
                    u32x4 w; w.x = cvt_pk_bf16(v0[0], v0[1]); w.y = cvt_pk_bf16(v0[2], v0[3]); w.z = cvt_pk_bf16(v1[0], v1[1]); w.w = cvt_pk_bf16(v1[2], v1[3]);
                    *(u32x4*)(rowp + bj * HALF) = w; } }
    }
};
__device__ __forceinline__ float sigm(float x) { return 1.0f / (1.0f + __expf(-x)); }
struct EpiGate {
    static constexpr bool PERM = true, AFTER_DRAIN = false;
    unsigned char* ws; const float* gb;
    __device__ __forceinline__ void operator()(const f32x4 (&acc)[2][2][4][2], const Unit& u, int wr, int wc, int fr, int fq) const {
        const int pn = u.pn, br = pn >> 2; const int row0 = u.pm * BM + wr * 64 + fr;
        bf16_t* base = (bf16_t*)(ws + (br == 0 ? WS_G0 : (br == 1 ? WS_G1 : WS_G2)));
        const int col0 = (pn & 3) * 256 + wc * 32 + 8 * fq; const float* bp = gb + br * 1024 + col0;
        f32x4 bv[2][2];
#pragma unroll
        for (int bj = 0; bj < 2; ++bj)
#pragma unroll
            for (int n = 0; n < 2; ++n) bv[bj][n] = *(const f32x4*)(bp + bj * HALF + 4 * n);
#pragma unroll
        for (int ai = 0; ai < 2; ++ai)
#pragma unroll
            for (int m = 0; m < 4; ++m) { bf16_t* rowp = base + (size_t)(row0 + ai * HALF + m * 16) * 1024 + col0;
#pragma unroll
                for (int bj = 0; bj < 2; ++bj) { const f32x4 v0 = acc[ai][bj][m][0] + bv[bj][0], v1 = acc[ai][bj][m][1] + bv[bj][1];
                    u32x4 w; w.x = cvt_pk_bf16(sigm(v0[0]), sigm(v0[1])); w.y = cvt_pk_bf16(sigm(v0[2]), sigm(v0[3])); w.z = cvt_pk_bf16(sigm(v1[0]), sigm(v1[1])); w.w = cvt_pk_bf16(sigm(v1[2]), sigm(v1[3]));
                    *(u32x4*)(rowp + bj * HALF) = w; } }
    }
};
__device__ __forceinline__ float bflo(unsigned w) { return __uint_as_float(w << 16); }
__device__ __forceinline__ float bfhi(unsigned w) { return __uint_as_float(w & 0xffff0000u); }
struct EpiMerge {
    static constexpr bool PERM = true, AFTER_DRAIN = false;
    const bf16_t* G; bf16_t* mg; int first;
    __device__ __forceinline__ void operator()(const f32x4 (&acc)[2][2][4][2], const Unit& u, int wr, int wc, int fr, int fq) const {
        const int row0 = u.pm * BM + wr * 64 + fr; const int col0 = u.pn * 256 + wc * 32 + 8 * fq;
#pragma unroll
        for (int ai = 0; ai < 2; ++ai)
#pragma unroll
            for (int m = 0; m < 4; ++m) { const size_t ro = (size_t)(row0 + ai * HALF + m * 16) * 1024 + col0;
#pragma unroll
                for (int bj = 0; bj < 2; ++bj) { const f32x4 v0 = acc[ai][bj][m][0], v1 = acc[ai][bj][m][1];
                    const u32x4 g = *(const u32x4*)(G + ro + bj * HALF);
                    float o[8] = {bflo(g.x) * v0[0], bfhi(g.x) * v0[1], bflo(g.y) * v0[2], bfhi(g.y) * v0[3], bflo(g.z) * v1[0], bfhi(g.z) * v1[1], bflo(g.w) * v1[2], bfhi(g.w) * v1[3]};
                    if (!first) { const u32x4 p = *(const u32x4*)(mg + ro + bj * HALF);
                        o[0] += bflo(p.x); o[1] += bfhi(p.x); o[2] += bflo(p.y); o[3] += bfhi(p.y); o[4] += bflo(p.z); o[5] += bfhi(p.z); o[6] += bflo(p.w); o[7] += bfhi(p.w); }
                    u32x4 w; w.x = cvt_pk_bf16(o[0], o[1]); w.y = cvt_pk_bf16(o[2], o[3]); w.z = cvt_pk_bf16(o[4], o[5]); w.w = cvt_pk_bf16(o[6], o[7]);
                    *(u32x4*)(mg + ro + bj * HALF) = w; } }
    }
};
struct EpiOut {
    static constexpr bool PERM = false, AFTER_DRAIN = false;
    const float* xin; float* out;
    __device__ __forceinline__ void operator()(const f32x4 (&acc)[2][2][4][2], const Unit& u, int wr, int wc, int fr, int fq) const {
        const int row0 = u.pm * BM + wr * 64 + fr; const int col0 = u.pn * 256 + wc * 32 + 4 * fq;
#pragma unroll
        for (int ai = 0; ai < 2; ++ai)
#pragma unroll
            for (int m = 0; m < 4; ++m) { const size_t ro = (size_t)(row0 + ai * HALF + m * 16) * 1024 + col0;
#pragma unroll
                for (int bj = 0; bj < 2; ++bj)
#pragma unroll
                    for (int n = 0; n < 2; ++n) { const size_t o = ro + bj * HALF + n * 16; const f32x4 xv = *(const f32x4*)(xin + o); *(f32x4*)(out + o) = xv + acc[ai][bj][m][n]; } }
    }
};
template <class Epi, class Sched, bool ALIGN_EPI = false, bool SP2 = false>
__device__ __forceinline__ void gemm_phase(PG8_LAS unsigned char* lds, const Gemm g, const Sched& S, const Epi& E) {
    int tid_ = threadIdx.x; asm volatile("" : "+v"(tid_)); const int tid = tid_, wid = __builtin_amdgcn_readfirstlane(tid >> 6), lane = tid & 63, wr = wid >> 2, wc = wid & 3, fr = lane & 15, fq = lane >> 4;
    const int K = g.K, nt = K / BK;
    unsigned voffA[2], voffB[2];
#pragma unroll
    for (int i = 0; i < 2; ++i) { int R, C; stage_rc(tid * 16 + i * 8192, R, C); const int Rb = Epi::PERM ? ((R & ~31) + perm32(R & 31)) : R;
        voffA[i] = (unsigned)(R * K + C) * 2u; voffB[i] = (unsigned)(Rb * K + C) * 2u; }
    const size_t kstep = (size_t)(BK * 2);
    const size_t hstep = (size_t)HALF * K * 2;
    const size_t tstep = 2 * hstep;
    const unsigned ldsw = (unsigned)wid * 1024u;
    const int aoff = lds_byte(wr * 64 + fr, fq * 8), boff = lds_byte(wc * 32 + fr, fq * 8);
#define PG8_SA(b, h) (((b) * 2 + (h)) * HTB)
#define PG8_SB(b, h) ((4 + (b) * 2 + (h)) * HTB)
#define PG8_STAGE(bufoff, gbase, voff) do { _Pragma("unroll") for (int _i = 0; _i < 2; ++_i) \
        __builtin_amdgcn_global_load_lds((const unsigned*)((const char*)(gbase) + (voff)[_i]), (PG8_LAS unsigned*)(lds + (bufoff) + ldsw + _i * 8192), 16, 0, 0); } while (0)
#define PG8_LDA(dst, b, h) do { _Pragma("unroll") for (int m = 0; m < 4; ++m) _Pragma("unroll") for (int k = 0; k < 2; ++k) dst[m][k] = *(const PG8_LAS bf16x8*)(lds + PG8_SA(b, h) + aoff + m * 2048 + k * 1024); } while (0)
#define PG8_LDB(dst, b, h) do { _Pragma("unroll") for (int n = 0; n < 2; ++n) _Pragma("unroll") for (int k = 0; k < 2; ++k) dst[n][k] = *(const PG8_LAS bf16x8*)(lds + PG8_SB(b, h) + boff + n * 2048 + k * 1024); } while (0)
#define PG8_MMA(ai, bj, At, Bt) do { __builtin_amdgcn_s_setprio(1); _Pragma("unroll") for (int m = 0; m < 4; ++m) _Pragma("unroll") for (int n = 0; n < 2; ++n) _Pragma("unroll") for (int k = 0; k < 2; ++k) \
        acc[ai][bj][m][n] = __builtin_amdgcn_mfma_f32_16x16x32_bf16(Bt[n][k], At[m][k], acc[ai][bj][m][n], 0, 0, 0); __builtin_amdgcn_s_setprio(0); } while (0)
#define PG8_WAIT_V(n) asm volatile("s_waitcnt vmcnt(" #n ")" ::: "memory")
#define PG8_WAIT_L(n) asm volatile("s_waitcnt lgkmcnt(" #n ")" ::: "memory")
#define PG8_BAR __builtin_amdgcn_s_barrier()
#define PG8_SCHED __builtin_amdgcn_sched_barrier(0)
    Unit cur, nxt; int ui = 0;
    if (!S.next(0, cur)) return;
    f32x4 acc[2][2][4][2];
#pragma unroll
    for (int a = 0; a < 2; ++a)
#pragma unroll
        for (int b = 0; b < 2; ++b)
#pragma unroll
            for (int m = 0; m < 4; ++m)
#pragma unroll
                for (int n = 0; n < 2; ++n) acc[a][b][m][n] = (f32x4){0.f, 0.f, 0.f, 0.f};
    bf16x8 At[4][2], B0[2][2], B1[2][2];
    const char* cA = (const char*)g.A + (size_t)cur.pm * tstep; const char* cB = (const char*)g.Bt + (size_t)cur.pn * tstep;
    S.a_ready(cur);
    if constexpr (SP2) {
        PG8_STAGE(PG8_SB(0, 0), cB, voffB); PG8_STAGE(PG8_SB(0, 1), cB + hstep, voffB); PG8_STAGE(PG8_SA(0, 0), cA, voffA); PG8_STAGE(PG8_SA(0, 1), cA + hstep, voffA);
        if (wr == 1) PG8_BAR;
        PG8_WAIT_V(2); PG8_BAR;
        PG8_STAGE(PG8_SB(1, 0), cB + kstep, voffB); PG8_STAGE(PG8_SA(1, 0), cA + kstep, voffA); PG8_STAGE(PG8_SB(1, 1), cB + hstep + kstep, voffB);
        PG8_WAIT_V(6); PG8_BAR;
    } else {
        PG8_STAGE(PG8_SB(0, 0), cB, voffB); PG8_STAGE(PG8_SA(0, 0), cA, voffA); PG8_STAGE(PG8_SB(0, 1), cB + hstep, voffB); PG8_STAGE(PG8_SA(0, 1), cA + hstep, voffA);
        if (wr == 1) PG8_BAR;
        PG8_WAIT_V(4); PG8_BAR;
        PG8_STAGE(PG8_SB(1, 0), cB + kstep, voffB); PG8_STAGE(PG8_SA(1, 0), cA + kstep, voffA); PG8_STAGE(PG8_SB(1, 1), cB + hstep + kstep, voffB);
        PG8_WAIT_V(6); PG8_BAR;
    }
    for (;;) {
        const bool has_next = S.next(ui + 1, nxt);
        const char* nA = has_next ? (const char*)g.A + (size_t)nxt.pm * tstep : cA; const char* nB = has_next ? (const char*)g.Bt + (size_t)nxt.pn * tstep : cB;
        for (int t = 0; t < nt; t += 2) {
            const bool last = (t == nt - 2);
            const char* a1 = cA + (size_t)(t + 1) * kstep;
            const char* a2 = last ? nA : cA + (size_t)(t + 2) * kstep; const char* b2 = last ? nB : cB + (size_t)(t + 2) * kstep;
            const char* a3 = a2 + kstep; const char* b3 = b2 + kstep;
            if (last && has_next) S.a_ready(nxt);
            if constexpr (SP2) {
            PG8_LDB(B0, 0, 0); PG8_LDB(B1, 0, 1); PG8_SCHED; PG8_LDA(At, 0, 0); PG8_STAGE(PG8_SA(1, 1), a1 + hstep, voffA);
            PG8_WAIT_V(8); PG8_WAIT_L(0); PG8_BAR; PG8_MMA(0, 0, At, B0); PG8_MMA(0, 1, At, B1); PG8_BAR; PG8_SCHED;
            PG8_LDA(At, 0, 1); PG8_STAGE(PG8_SB(0, 0), b2, voffB); PG8_STAGE(PG8_SB(0, 1), b2 + hstep, voffB); PG8_STAGE(PG8_SA(0, 0), a2, voffA);
            PG8_WAIT_V(8); PG8_WAIT_L(0); PG8_BAR; PG8_MMA(1, 0, At, B0); PG8_MMA(1, 1, At, B1); PG8_BAR; PG8_SCHED;
            PG8_LDB(B0, 1, 0); PG8_LDB(B1, 1, 1); PG8_SCHED; PG8_LDA(At, 1, 0); PG8_STAGE(PG8_SA(0, 1), a2 + hstep, voffA);
            PG8_WAIT_V(8); PG8_WAIT_L(0); PG8_BAR; PG8_MMA(0, 0, At, B0); PG8_MMA(0, 1, At, B1); PG8_BAR; PG8_SCHED;
            PG8_LDA(At, 1, 1); PG8_STAGE(PG8_SB(1, 0), b3, voffB); PG8_STAGE(PG8_SB(1, 1), b3 + hstep, voffB); PG8_STAGE(PG8_SA(1, 0), a3, voffA);
            PG8_WAIT_V(8); PG8_WAIT_L(0); PG8_BAR; PG8_MMA(1, 0, At, B0); PG8_MMA(1, 1, At, B1); PG8_BAR; PG8_SCHED;
            } else {
            PG8_LDB(B0, 0, 0); PG8_SCHED; PG8_LDA(At, 0, 0); PG8_STAGE(PG8_SA(1, 1), a1 + hstep, voffA);
            PG8_WAIT_L(8); PG8_BAR; PG8_WAIT_L(0); PG8_MMA(0, 0, At, B0); PG8_BAR; PG8_SCHED;
            PG8_LDB(B1, 0, 1); PG8_STAGE(PG8_SB(0, 0), b2, voffB);
            PG8_BAR; PG8_WAIT_L(0); PG8_MMA(0, 1, At, B1); PG8_BAR;
            PG8_LDA(At, 0, 1); PG8_STAGE(PG8_SA(0, 0), a2, voffA);
            PG8_BAR; PG8_WAIT_L(0); PG8_MMA(1, 0, At, B0); PG8_BAR; PG8_SCHED;
            PG8_STAGE(PG8_SB(0, 1), b2 + hstep, voffB);
            PG8_WAIT_V(6); PG8_BAR; PG8_MMA(1, 1, At, B1); PG8_BAR;
            PG8_LDB(B0, 1, 0); PG8_SCHED; PG8_LDA(At, 1, 0); PG8_STAGE(PG8_SA(0, 1), a2 + hstep, voffA);
            PG8_WAIT_L(8); PG8_BAR; PG8_WAIT_L(0); PG8_MMA(0, 0, At, B0); PG8_BAR; PG8_SCHED;
            PG8_LDB(B1, 1, 1); PG8_STAGE(PG8_SB(1, 0), b3, voffB);
            PG8_BAR; PG8_WAIT_L(0); PG8_MMA(0, 1, At, B1); PG8_BAR;
            PG8_LDA(At, 1, 1); PG8_STAGE(PG8_SA(1, 0), a3, voffA);
            PG8_BAR; PG8_WAIT_L(0); PG8_MMA(1, 0, At, B0); PG8_BAR; PG8_SCHED;
            PG8_STAGE(PG8_SB(1, 1), b3 + hstep, voffB);
            PG8_WAIT_V(6); PG8_BAR; PG8_MMA(1, 1, At, B1); PG8_BAR;
            }
        }
        if constexpr (ALIGN_EPI) { if (wr == 0) PG8_BAR; }
        if constexpr (!Epi::AFTER_DRAIN) { E(acc, cur, wr, wc, fr, fq); S.done(cur); }
        if (!has_next) break;
#pragma unroll
        for (int a = 0; a < 2; ++a)
#pragma unroll
            for (int b = 0; b < 2; ++b)
#pragma unroll
                for (int m = 0; m < 4; ++m)
#pragma unroll
                    for (int n = 0; n < 2; ++n) acc[a][b][m][n] = (f32x4){0.f, 0.f, 0.f, 0.f};
        cur = nxt; cA = nA; cB = nB; ++ui;
        if constexpr (ALIGN_EPI) { if (wr == 1) PG8_BAR; }
    }
    PG8_WAIT_V(0);
    if constexpr (!ALIGN_EPI) { if (wr == 0) PG8_BAR; }
    PG8_BAR;
    if constexpr (Epi::AFTER_DRAIN) { E.fused(acc, cur, wr, wc, fr, fq, lds, wid, lane); S.done(cur); }
#undef PG8_SA
#undef PG8_SB
#undef PG8_STAGE
#undef PG8_LDA
#undef PG8_LDB
#undef PG8_MMA
#undef PG8_WAIT_V
#undef PG8_WAIT_L
#undef PG8_BAR
#undef PG8_SCHED
}
}

#define DI __device__ __forceinline__
typedef unsigned short bf16_t;
typedef short bf16x8 __attribute__((ext_vector_type(8)));
typedef short bf16x4 __attribute__((ext_vector_type(4)));
typedef float f32x4 __attribute__((ext_vector_type(4)));
typedef unsigned u32x4 __attribute__((ext_vector_type(4)));
typedef unsigned u32x2 __attribute__((ext_vector_type(2)));
constexpr int NTHR = 512, NWAVE = 8;
constexpr int LDS_BYTES = 155648;
constexpr int LDS_SLOT = 155648 - 64;

DI float bf2f(bf16_t v) { return __uint_as_float(((unsigned)v) << 16); }
DI unsigned f2bf(float f) { unsigned u = __float_as_uint(f); return (u + 0x7fffu + ((u >> 16) & 1u)) >> 16; }
DI unsigned pk2(float lo, float hi) { return f2bf(lo) | (f2bf(hi) << 16); }
DI float lo_f(unsigned w) { return __uint_as_float(w << 16); }
DI float hi_f(unsigned w) { return __uint_as_float(w & 0xffff0000u); }
DI float siluf(float x) { return x / (1.0f + __expf(-x)); }
DI float sigmf(float x) { return 1.0f / (1.0f + __expf(-x)); }
DI float wave_sum(float v) {
#pragma unroll
    for (int o = 1; o < 64; o <<= 1) v += __shfl_xor(v, o);
    return v;
}
DI float row16_sum(float v) {
#pragma unroll
    for (int o = 1; o < 16; o <<= 1) v += __shfl_xor(v, o);
    return v;
}
DI f32x4 mfma16(bf16x8 a, bf16x8 b, f32x4 c) { return __builtin_amdgcn_mfma_f32_16x16x32_bf16(a, b, c, 0, 0, 0); }
DI bf16x8 ld16(const unsigned char* p) { return *(const bf16x8*)p; }
DI bf16x8 ld8x2(const unsigned char* p0, const unsigned char* p1) {
    const bf16x4 a = *(const bf16x4*)p0, b = *(const bf16x4*)p1;
    return __builtin_shufflevector(a, b, 0, 1, 2, 3, 4, 5, 6, 7);
}
DI bf16x8 packf(const f32x4 a, const f32x4 b) {
    u32x4 w; w.x = pk2(a[0], a[1]); w.y = pk2(a[2], a[3]); w.z = pk2(b[0], b[1]); w.w = pk2(b[2], b[3]);
    return __builtin_bit_cast(bf16x8, w);
}
DI u32x2 pack4(const f32x4 a) { u32x2 w; w.x = pk2(a[0], a[1]); w.y = pk2(a[2], a[3]); return w; }

__constant__ float INV_A[64] = {1.000000000e+00f, 8.659643531e-01f, 7.498942614e-01f, 6.493816376e-01f, 5.623413324e-01f, 4.869675338e-01f, 4.216965139e-01f, 3.651741147e-01f, 3.162277639e-01f, 2.738419771e-01f, 2.371373773e-01f, 2.053525001e-01f, 1.778279394e-01f, 1.539926529e-01f, 1.333521307e-01f, 1.154782027e-01f, 1.000000015e-01f, 8.659642935e-02f, 7.498941571e-02f, 6.493816525e-02f, 5.623413250e-02f, 4.869675264e-02f, 4.216965288e-02f, 3.651741147e-02f, 3.162277490e-02f, 2.738419734e-02f, 2.371373773e-02f, 2.053525113e-02f, 1.778279431e-02f, 1.539926510e-02f, 1.333521493e-02f, 1.154782064e-02f, 9.999999776e-03f, 8.659643121e-03f, 7.498941850e-03f, 6.493816152e-03f, 5.623413250e-03f, 4.869675264e-03f, 4.216964822e-03f, 3.651741194e-03f, 3.162277630e-03f, 2.738419687e-03f, 2.371373586e-03f, 2.053524833e-03f, 1.778279431e-03f, 1.539926510e-03f, 1.333521446e-03f, 1.154781901e-03f, 1.000000047e-03f, 8.659643354e-04f, 7.498942432e-04f, 6.493816618e-04f, 5.623413017e-04f, 4.869675322e-04f, 4.216965172e-04f, 3.651741426e-04f, 3.162277571e-04f, 2.738419571e-04f, 2.371373703e-04f, 2.053525095e-04f, 1.778279402e-04f, 1.539926452e-04f, 1.333521504e-04f, 1.154782003e-04f};
__constant__ float INV_I[32] = {1.000000000e+00f, 7.498942614e-01f, 5.623413324e-01f, 4.216965139e-01f, 3.162277639e-01f, 2.371373773e-01f, 1.778279394e-01f, 1.333521307e-01f, 1.000000015e-01f, 7.498941571e-02f, 5.623413250e-02f, 4.216965288e-02f, 3.162277490e-02f, 2.371373773e-02f, 1.778279431e-02f, 1.333521493e-02f, 9.999999776e-03f, 7.498941850e-03f, 5.623413250e-03f, 4.216964822e-03f, 3.162277630e-03f, 2.371373586e-03f, 1.778279431e-03f, 1.333521446e-03f, 1.000000047e-03f, 7.498942432e-04f, 5.623413017e-04f, 4.216965172e-04f, 3.162277571e-04f, 2.371373703e-04f, 1.778279402e-04f, 1.333521504e-04f};
struct Params {
    const float* x; const float* norm_g; const float* w_in; const float* gate_b; const float* conv_w; const float* a_log; const float* dt_bias;
    const float* dn_onorm; const float* pool_w; const float* pool_scale; const float* q_norm; const float* k_norm; const float* w_branch; const float* w_out;
    float* out; unsigned char* ws;
    int ph_lo, ph_hi;
};

DI int next_unit(unsigned* ctr, unsigned char* lds) {
    volatile int* slot = (volatile int*)(lds + LDS_SLOT);
    __syncthreads();
    if (threadIdx.x == 0) *slot = (int)atomicAdd(ctr, 1u);
    __syncthreads();
    return *slot;
}

DI int src_col(int mode, int n) {
    if (mode == 0) {
        if (n < 2048) return n;
        if (n < 5440) return n + 8;
        if (n < 5444) return 2048 + (n - 5440);
        if (n < 5448) return 2052 + (n - 5444);
        if (n < 5452) return n;
        return -1;
    }
    if (mode == 1) return 5452 + n;
    return n;
}
DI void transpose_item(const float* W, int ldw, int K, bf16_t* WT, int mode, float* scr, int item, int nblk, int lane) {
    const int kb = item / nblk, nb = item % nblk, k0 = 64 * kb, n0 = 32 * nb;
    const int sc = src_col(mode, n0 + (lane & 31));
#pragma unroll 8
    for (int i = 0; i < 32; ++i) { const int kk = 2 * i + (lane >> 5); scr[kk * 33 + (lane & 31)] = (sc >= 0) ? W[(size_t)(k0 + kk) * ldw + sc] : 0.f; }
    asm volatile("s_waitcnt lgkmcnt(0)" ::: "memory");
    const int c = lane & 7;
#pragma unroll
    for (int j = 0; j < 4; ++j) { const int n = (lane >> 3) + 8 * j; const float* s = scr + (8 * c) * 33 + n;
        u32x4 o; o.x = pk2(s[0 * 33], s[1 * 33]); o.y = pk2(s[2 * 33], s[3 * 33]); o.z = pk2(s[4 * 33], s[5 * 33]); o.w = pk2(s[6 * 33], s[7 * 33]);
        *(u32x4*)(WT + (size_t)(n0 + n) * K + k0 + 8 * c) = o; }
    asm volatile("s_waitcnt lgkmcnt(0)" ::: "memory");
}
DI void rms_row(const float* xrow, const float* g, bf16_t* orow, int lane) {
    const f32x4* xr = (const f32x4*)xrow + lane; const f32x4* gr = (const f32x4*)g + lane;
    f32x4 v[4]; float s = 0.f;
#pragma unroll
    for (int j = 0; j < 4; ++j) { v[j] = xr[64 * j]; s += (v[j].x * v[j].x + v[j].y * v[j].y) + (v[j].z * v[j].z + v[j].w * v[j].w); }
    const float rstd = 1.0f / sqrtf(wave_sum(s) * (1.0f / DM) + NORM_EPS);
    u32x2* o8 = (u32x2*)orow + lane;
#pragma unroll
    for (int j = 0; j < 4; ++j) { const f32x4 gg = gr[64 * j]; u32x2 w; w.x = pk2(v[j].x * rstd * gg.x, v[j].y * rstd * gg.y); w.y = pk2(v[j].z * rstd * gg.z, v[j].w * rstd * gg.w); o8[64 * j] = w; }
}
DI void phase0(const Params& p, int layer, const float* xin, unsigned char* lds) {
    int tid_ = threadIdx.x; asm volatile("" : "+v"(tid_)); const int tid = tid_, lane = tid & 63, wave = tid >> 6;
    const int gw = blockIdx.x * NWAVE + wave, NGW = gridDim.x * NWAVE;
    float* scr = (float*)(lds + wave * 8704);
    unsigned char* ws = p.ws;
    const float* win = p.w_in + (size_t)layer * DM * INW;
    const float* wbr = p.w_branch + (size_t)layer * 3 * 512 * 1024;
    const float* wo = p.w_out + (size_t)layer * 1024 * 1024;
    const float* pw = p.pool_w + (size_t)layer * 4 * 128 * 128;
    constexpr int I_1 = 16 * (N1 / 32), I_G = 16 * (NG / 32), I_B = 8 * 32, I_O = 16 * 32, I_P = 2 * 4;
    constexpr int NITEMS = I_1 + I_G + 3 * I_B + I_O + 4 * I_P;
    for (int it = gw; it < NITEMS; it += NGW) {
        int r = it;
        if (r < I_1) { transpose_item(win, INW, 1024, (bf16_t*)(ws + WS_WIN1), 0, scr, r, N1 / 32, lane); continue; } r -= I_1;
        if (r < I_G) { transpose_item(win, INW, 1024, (bf16_t*)(ws + WS_WG), 1, scr, r, NG / 32, lane); continue; } r -= I_G;
        if (r < 3 * I_B) { const int br = r / I_B; transpose_item(wbr + (size_t)br * 512 * 1024, 1024, 512, (bf16_t*)(ws + WS_WBR) + (size_t)br * 1024 * 512, 2, scr, r % I_B, 32, lane); continue; } r -= 3 * I_B;
        if (r < I_O) { transpose_item(wo, 1024, 1024, (bf16_t*)(ws + WS_WO), 2, scr, r, 32, lane); continue; } r -= I_O;
        { const int g = r / I_P; transpose_item(pw + (size_t)g * 128 * 128, 128, 128, (bf16_t*)(ws + WS_POOLW) + (size_t)g * 128 * 128, 2, scr, r % I_P, 4, lane); }
    }
    const float* ng = p.norm_g + layer * DM;
    for (int m = gw; m < MTOK; m += NGW) rms_row(xin + (size_t)m * DM, ng, (bf16_t*)(ws + WS_H) + (size_t)m * DM, lane);
    if (layer == 0) {
        const int gt = blockIdx.x * NTHR + tid, NGT = gridDim.x * NTHR;
        for (int i = gt; i < SEQ * 96; i += NGT) {
            const int t = i / 96, j = i % 96;
            const float inv = (j < 64) ? INV_A[j] : INV_I[j - 64];
            const float ang = (float)t * inv;
            double rev = (double)ang * 0.15915494309189535; rev -= floor(rev);
            const float rf = (float)rev;
            const float c = __builtin_amdgcn_cosf(rf), s = __builtin_amdgcn_sinf(rf);
            if (j < 64) { ((float*)(ws + WS_COSA))[t * 64 + j] = c; ((float*)(ws + WS_SINA))[t * 64 + j] = s; }
            else { ((float*)(ws + WS_COSI))[t * 32 + (j - 64)] = c; ((float*)(ws + WS_SINI))[t * 32 + (j - 64)] = s; }
        }
    }
}

constexpr int DP_Q = 0, DP_K = 17408, DP_KBT = 34816, DP_VT = 53248, DP_KDT = 71680, DP_L = 90112, DP_TF = 106752, DP_T = 123392, DP_GC = 132608, DP_BETA = 132864;
constexpr int QP = 272;
constexpr int TP = 144;
DI void dn_prep_unit(const Params& p, int layer, int unit, unsigned char* lds) {
    int tid_ = threadIdx.x; asm volatile("" : "+v"(tid_)); const int tid = tid_, lane = tid & 63, wave = tid >> 6, fr = lane & 15, fq = lane >> 4;
    const int c = unit & 31, h = (unit >> 5) & 3, b = unit >> 7;
    unsigned char* ws = p.ws;
    const size_t tok0 = (size_t)b * SEQ + (size_t)c * 64;
    float* sGc = (float*)(lds + DP_GC); float* sBeta = (float*)(lds + DP_BETA);
    float* sL = (float*)(lds + DP_L); float* sTf = (float*)(lds + DP_TF);
    unsigned char* su = ws + WS_SCAN + (size_t)unit * SCAN_UNIT_BYTES;
    if (wave == 0) {
        const float* mp = (const float*)(ws + WS_MISC) + (tok0 + lane) * 16;
        const float ba = mp[h], aa = mp[4 + h];
        const float al = p.a_log[layer * 4 + h], dtb = p.dt_bias[layer * 4 + h];
        const float xx = aa + dtb;
        const float sp = fmaxf(xx, 0.f) + log1pf(__expf(-fabsf(xx)));
        float g = -__expf(al) * sp;
        float cs = g;
#pragma unroll
        for (int o = 1; o < 64; o <<= 1) { const float n = __shfl_up(cs, o); if (lane >= o) cs += n; }
        sGc[lane] = cs; sBeta[lane] = sigmf(ba);
    }
    __syncthreads();
    const float gl = sGc[63];
    {
        const bf16_t* aq = (const bf16_t*)(ws + WS_AQKV);
        const float* cw = p.conv_w + (size_t)layer * 4 * 1536;
#pragma unroll
        for (int part = 0; part < 3; ++part) {
            const int ch0 = part * 512 + h * 128 + lane, ch1 = ch0 + 64;
            float w0[4], w1[4];
#pragma unroll
            for (int j = 0; j < 4; ++j) { w0[j] = cw[j * 1536 + ch0]; w1[j] = cw[j * 1536 + ch1]; }
            float xa[3], xb[3];
            const int tl0 = 8 * wave;
#pragma unroll
            for (int j = 0; j < 3; ++j) { const int tg = c * 64 + tl0 - 3 + j;
                if (tg >= 0) { const bf16_t* rp = aq + ((size_t)b * SEQ + tg) * 1536; xa[j] = bf2f(rp[ch0]); xb[j] = bf2f(rp[ch1]); } else { xa[j] = 0.f; xb[j] = 0.f; } }
#pragma unroll
            for (int i = 0; i < 8; ++i) {
                const int tl = tl0 + i; const bf16_t* rp = aq + (tok0 + tl) * 1536;
                const float ca = bf2f(rp[ch0]), cb = bf2f(rp[ch1]);
                float ya = w0[0] * xa[0] + w0[1] * xa[1] + w0[2] * xa[2] + w0[3] * ca;
                float yb = w1[0] * xb[0] + w1[1] * xb[1] + w1[2] * xb[2] + w1[3] * cb;
                xa[0] = xa[1]; xa[1] = xa[2]; xa[2] = ca; xb[0] = xb[1]; xb[1] = xb[2]; xb[2] = cb;
                ya = siluf(ya); yb = siluf(yb);
                const float beta = sBeta[tl], gct = sGc[tl];
                if (part < 2) {
                    const float ss = wave_sum(ya * ya + yb * yb);
                    const float rn = 1.0f / sqrtf(ss + NORM_EPS);
                    ya *= rn; yb *= rn;
                    if (part == 0) {
                        *(bf16_t*)(lds + DP_Q + tl * QP + lane * 2) = (bf16_t)f2bf(ya); *(bf16_t*)(lds + DP_Q + tl * QP + (lane + 64) * 2) = (bf16_t)f2bf(yb);
                    } else {
                        *(bf16_t*)(lds + DP_K + tl * QP + lane * 2) = (bf16_t)f2bf(ya); *(bf16_t*)(lds + DP_K + tl * QP + (lane + 64) * 2) = (bf16_t)f2bf(yb);
                        const float s1 = beta * __expf(gct), s2 = __expf(gl - gct);
                        *(bf16_t*)(lds + DP_KBT + lane * TP + tl * 2) = (bf16_t)f2bf(ya * s1); *(bf16_t*)(lds + DP_KBT + (lane + 64) * TP + tl * 2) = (bf16_t)f2bf(yb * s1);
                        *(bf16_t*)(lds + DP_KDT + lane * TP + tl * 2) = (bf16_t)f2bf(ya * s2); *(bf16_t*)(lds + DP_KDT + (lane + 64) * TP + tl * 2) = (bf16_t)f2bf(yb * s2);
                    }
                } else {
                    *(bf16_t*)(lds + DP_VT + lane * TP + tl * 2) = (bf16_t)f2bf(ya * beta); *(bf16_t*)(lds + DP_VT + (lane + 64) * TP + tl * 2) = (bf16_t)f2bf(yb * beta);
                }
            }
        }
    }
    __syncthreads();
#pragma unroll 1
    for (int i4 = 0; i4 < 4; ++i4) {
        const int id = wave + 8 * i4;
        if (id < 16) {
            const int mt = id >> 2, nt = id & 3;
            f32x4 acc = {0.f, 0.f, 0.f, 0.f};
            if (nt <= mt) {
#pragma unroll
                for (int s = 0; s < 4; ++s) acc = mfma16(ld16(lds + DP_K + (16 * mt + fr) * QP + (32 * s + 8 * fq) * 2), ld16(lds + DP_K + (16 * nt + fr) * QP + (32 * s + 8 * fq) * 2), acc);
            }
            const int j = 16 * nt + fr; const float gj = sGc[j];
#pragma unroll
            for (int jj = 0; jj < 4; ++jj) { const int i = 16 * mt + 4 * fq + jj;
                float v = 0.f; if (j < i) v = sBeta[i] * acc[jj] * __expf(sGc[i] - gj);
                sL[i * 65 + j] = v; }
        } else {
            const int mt = (id - 16) >> 2, nt = (id - 16) & 3;
            f32x4 acc = {0.f, 0.f, 0.f, 0.f};
            if (nt <= mt) {
#pragma unroll
                for (int s = 0; s < 4; ++s) acc = mfma16(ld16(lds + DP_K + (16 * nt + fr) * QP + (32 * s + 8 * fq) * 2), ld16(lds + DP_Q + (16 * mt + fr) * QP + (32 * s + 8 * fq) * 2), acc);
            }
            const int i = 16 * mt + fr; const float gi = sGc[i];
            f32x4 o;
#pragma unroll
            for (int jj = 0; jj < 4; ++jj) { const int j = 16 * nt + 4 * fq + jj;
                float v = 0.f; if (j <= i) v = acc[jj] * 0.08838834764831845f * __expf(gi - sGc[j]);
                o[jj] = v; }
            *(u32x2*)(su + SU_A + (i * 64 + 16 * nt + 4 * fq) * 2) = pack4(o);
        }
    }
    __syncthreads();
    if (wave == 0) {
#pragma unroll 1
        for (int i = 0; i < 64; ++i) {
            float acc = (i == lane) ? 1.f : 0.f;
#pragma unroll 4
            for (int j = 0; j < i; ++j) acc -= sL[i * 65 + j] * sTf[j * 65 + lane];
            sTf[i * 65 + lane] = acc;
            *(bf16_t*)(lds + DP_T + i * TP + lane * 2) = (bf16_t)f2bf(acc);
        }
    } else {
        for (int ch = tid - 64; ch < 1024; ch += 448) {
            const int row = ch >> 4, c8 = (ch & 15) * 8;
            const u32x4 q = *(const u32x4*)(lds + DP_Q + row * QP + c8 * 2);
            const float sc = __expf(sGc[row]) * 0.08838834764831845f;
            u32x4 o; o.x = pk2(lo_f(q.x) * sc, hi_f(q.x) * sc); o.y = pk2(lo_f(q.y) * sc, hi_f(q.y) * sc); o.z = pk2(lo_f(q.z) * sc, hi_f(q.z) * sc); o.w = pk2(lo_f(q.w) * sc, hi_f(q.w) * sc);
            *(u32x4*)(su + SU_QG + (row * 128 + c8) * 2) = o;
        }
        for (int ch = tid - 64; ch < 1024; ch += 448) {
            const int row = ch >> 3, c8 = (ch & 7) * 8;
            *(u32x4*)(su + SU_KDT + (row * 64 + c8) * 2) = *(const u32x4*)(lds + DP_KDT + row * TP + c8 * 2);
        }
        if (tid == 64) ((float*)(ws + WS_DEC))[unit] = __expf(gl);
    }
    __syncthreads();
#pragma unroll 1
    for (int i8 = 0; i8 < 8; ++i8) {
        const int id = wave + 8 * i8;
        if (id < 32) {
            const int mt = id >> 3, nt = id & 7;
            f32x4 acc = {0.f, 0.f, 0.f, 0.f};
#pragma unroll
            for (int s = 0; s < 2; ++s) acc = mfma16(ld16(lds + DP_T + (16 * mt + fr) * TP + (32 * s + 8 * fq) * 2), ld16(lds + DP_VT + (16 * nt + fr) * TP + (32 * s + 8 * fq) * 2), acc);
            *(u32x2*)(su + SU_UT + ((16 * nt + fr) * 64 + 16 * mt + 4 * fq) * 2) = pack4(acc);
        } else {
            const int mt = (id - 32) >> 3, nt = (id - 32) & 7;
            f32x4 acc = {0.f, 0.f, 0.f, 0.f};
#pragma unroll
            for (int s = 0; s < 2; ++s) acc = mfma16(ld16(lds + DP_KBT + (16 * nt + fr) * TP + (32 * s + 8 * fq) * 2), ld16(lds + DP_T + (16 * mt + fr) * TP + (32 * s + 8 * fq) * 2), acc);
            *(u32x2*)(su + SU_W + ((16 * mt + fr) * 128 + 16 * nt + 4 * fq) * 2) = pack4(acc);
        }
    }
}

constexpr int PL_U = 0, PL_P = 40960;
DI void pool_unit(const Params& p, int layer, int unit, unsigned char* lds) {
    int tid_ = threadIdx.x; asm volatile("" : "+v"(tid_)); const int tid = tid_, lane = tid & 63, wave = tid >> 6, fr = lane & 15, fq = lane >> 4;
    const int g = unit & 3, tt = (unit >> 2) & 31, b = unit >> 7;
    unsigned char* ws = p.ws;
    const int t0 = tt * 64, win = 2 << g;
    float* sU = (float*)(lds + PL_U);
    const bf16_t* bu = (const bf16_t*)(ws + WS_BU);
    for (int e = tid; e < 79 * 128; e += NTHR) { const int r = e >> 7, cc = e & 127; const int t = t0 - 15 + r;
        sU[r * 128 + cc] = (t >= 0) ? bf2f(bu[((size_t)b * SEQ + t) * 512 + g * 128 + cc]) : 0.f; }
    __syncthreads();
    for (int e = tid; e < 64 * 128; e += NTHR) { const int tl = e >> 7, cc = e & 127; const int t = t0 + tl;
        const int cnt = (t + 1 < win) ? (t + 1) : win;
        float s = 0.f;
        for (int i = 0; i < cnt; ++i) s += sU[(tl + 15 - i) * 128 + cc];
        const float pv = s / (float)cnt - sU[(tl + 15) * 128 + cc];
        *(bf16_t*)(lds + PL_P + tl * QP + cc * 2) = (bf16_t)f2bf(pv); }
    __syncthreads();
    const bf16_t* pw = (const bf16_t*)(ws + WS_POOLW) + (size_t)g * 128 * 128;
    const int mt = wave & 3, nh = wave >> 2;
    const float* psc = p.pool_scale + layer * 512 + g * 128;
    bf16_t* bz = (bf16_t*)(ws + WS_BZ);
#pragma unroll
    for (int n4 = 0; n4 < 4; ++n4) {
        const int nt = nh * 4 + n4;
        f32x4 acc = {0.f, 0.f, 0.f, 0.f};
#pragma unroll
        for (int s = 0; s < 4; ++s) acc = mfma16(*(const bf16x8*)(pw + (16 * nt + fr) * 128 + 32 * s + 8 * fq), ld16(lds + PL_P + (16 * mt + fr) * QP + (32 * s + 8 * fq) * 2), acc);
        const int d0 = 16 * nt + 4 * fq; bf16_t* zp = bz + ((size_t)b * SEQ + t0 + 16 * mt + fr) * 512 + g * 128 + d0;
        const u32x2 zz = *(const u32x2*)zp; const f32x4 sc = *(const f32x4*)(psc + d0);
        f32x4 o; o[0] = acc[0] * sc[0] * siluf(lo_f(zz.x)); o[1] = acc[1] * sc[1] * siluf(hi_f(zz.x)); o[2] = acc[2] * sc[2] * siluf(lo_f(zz.y)); o[3] = acc[3] * sc[3] * siluf(hi_f(zz.y));
        *(u32x2*)zp = pack4(o);
    }
}

DI void sa_prep_unit(const Params& p, int layer, int unit, unsigned char* lds) {
    int tid_ = threadIdx.x; asm volatile("" : "+v"(tid_)); const int tid = tid_, lane = tid & 63, wave = tid >> 6;
    unsigned char* ws = p.ws;
    bf16_t* cq = (bf16_t*)(ws + WS_CQKV);
    const float* cosA = (const float*)(ws + WS_COSA); const float* sinA = (const float*)(ws + WS_SINA);
    const float gq0 = p.q_norm[layer * 128 + lane], gq1 = p.q_norm[layer * 128 + lane + 64];
    const float gk0 = p.k_norm[layer * 128 + lane], gk1 = p.k_norm[layer * 128 + lane + 64];
#pragma unroll 2
    for (int i = 0; i < 64; ++i) {
        const int rid = wave * 64 + i;
        const int tl = rid >> 3, qk = (rid >> 2) & 1, hh = rid & 3;
        const size_t tok = (size_t)unit * 64 + tl; const int t = (int)(tok & (SEQ - 1));
        bf16_t* rp = cq + tok * 1536 + qk * 512 + hh * 128;
        const float x1 = bf2f(rp[lane]), x2 = bf2f(rp[lane + 64]);
        const float ss = wave_sum(x1 * x1 + x2 * x2);
        const float rstd = 1.0f / sqrtf(ss * (1.0f / 128.0f) + NORM_EPS);
        const float y1 = x1 * rstd * (qk ? gk0 : gq0), y2 = x2 * rstd * (qk ? gk1 : gq1);
        const float cs = cosA[t * 64 + lane], sn = sinA[t * 64 + lane];
        rp[lane] = (bf16_t)f2bf(y1 * cs - y2 * sn); rp[lane + 64] = (bf16_t)f2bf(y2 * cs + y1 * sn);
    }
}

constexpr int IX_K = 0;
DI unsigned sortable(float f) { const unsigned u = __float_as_uint(f + 0.0f); return u ^ ((u >> 31) ? 0xffffffffu : 0x80000000u); }
DI void indexer_unit(const Params& p, int unit, unsigned char* lds) {
    int tid_ = threadIdx.x; asm volatile("" : "+v"(tid_)); const int tid = tid_, lane = tid & 63, wave = tid >> 6, fr = lane & 15, fq = lane >> 4;
    const int b = unit & 7, qb = 63 - (unit >> 3);
    unsigned char* ws = p.ws;
    const int t0 = qb * 32, tw = t0 + 4 * wave;
    const int tq = tw + fq;
    unsigned* mask = (unsigned*)(ws + WS_MASK) + ((size_t)b * SEQ + tq) * 64;
    if (t0 < 256) {
#pragma unroll
        for (int k = 0; k < 4; ++k) { const int wd = 16 * k + fr; const int lo = 32 * wd;
            unsigned m = 0u; if (tq >= lo + 31) m = 0xffffffffu; else if (tq >= lo) m = (2u << (tq - lo)) - 1u;
            mask[wd] = m; }
        return;
    }
    const bf16_t* cidx = (const bf16_t*)(ws + WS_CIDX);
    const float* cosI = (const float*)(ws + WS_COSI); const float* sinI = (const float*)(ws + WS_SINI);
    bf16x8 a0, a1;
    {
        const int ql = fr >> 2, hh = fr & 3; const int t = tw + ql;
        const bf16_t* qp = cidx + ((size_t)b * SEQ + t) * 320 + hh * 64;
        const u32x4 x1 = *(const u32x4*)(qp + 8 * fq), x2 = *(const u32x4*)(qp + 32 + 8 * fq);
        const f32x4 c0 = *(const f32x4*)(cosI + t * 32 + 8 * fq), c1 = *(const f32x4*)(cosI + t * 32 + 8 * fq + 4);
        const f32x4 s0 = *(const f32x4*)(sinI + t * 32 + 8 * fq), s1 = *(const f32x4*)(sinI + t * 32 + 8 * fq + 4);
        const float xa[8] = {lo_f(x1.x), hi_f(x1.x), lo_f(x1.y), hi_f(x1.y), lo_f(x1.z), hi_f(x1.z), lo_f(x1.w), hi_f(x1.w)};
        const float xb[8] = {lo_f(x2.x), hi_f(x2.x), lo_f(x2.y), hi_f(x2.y), lo_f(x2.z), hi_f(x2.z), lo_f(x2.w), hi_f(x2.w)};
        const float cc[8] = {c0[0], c0[1], c0[2], c0[3], c1[0], c1[1], c1[2], c1[3]};
        const float sn[8] = {s0[0], s0[1], s0[2], s0[3], s1[0], s1[1], s1[2], s1[3]};
        u32x4 w0, w1;
        w0.x = pk2(xa[0] * cc[0] - xb[0] * sn[0], xa[1] * cc[1] - xb[1] * sn[1]); w0.y = pk2(xa[2] * cc[2] - xb[2] * sn[2], xa[3] * cc[3] - xb[3] * sn[3]);
        w0.z = pk2(xa[4] * cc[4] - xb[4] * sn[4], xa[5] * cc[5] - xb[5] * sn[5]); w0.w = pk2(xa[6] * cc[6] - xb[6] * sn[6], xa[7] * cc[7] - xb[7] * sn[7]);
        w1.x = pk2(xb[0] * cc[0] + xa[0] * sn[0], xb[1] * cc[1] + xa[1] * sn[1]); w1.y = pk2(xb[2] * cc[2] + xa[2] * sn[2], xb[3] * cc[3] + xa[3] * sn[3]);
        w1.z = pk2(xb[4] * cc[4] + xa[4] * sn[4], xb[5] * cc[5] + xa[5] * sn[5]); w1.w = pk2(xb[6] * cc[6] + xa[6] * sn[6], xb[7] * cc[7] + xa[7] * sn[7]);
        a0 = __builtin_bit_cast(bf16x8, w0); a1 = __builtin_bit_cast(bf16x8, w1);
    }
    float wi[4];
    { const float* mp = (const float*)(ws + WS_MISC) + ((size_t)b * SEQ + tq) * 16 + 8;
#pragma unroll
      for (int j = 0; j < 4; ++j) wi[j] = mp[j] * 0.0625f; }
    unsigned sc[128];
    const int tmax = t0 + 31;
#pragma unroll
    for (int r = 0; r < 8; ++r) {
        if (r * 256 <= tmax) {
            __syncthreads();
            {
                const int key = tid >> 1, hf = tid & 1; const int t = r * 256 + key;
                const bf16_t* kp = cidx + ((size_t)b * SEQ + t) * 320 + 256;
                const u32x4 xa0 = *(const u32x4*)(kp + 16 * hf), xa1 = *(const u32x4*)(kp + 16 * hf + 8), xb0 = *(const u32x4*)(kp + 32 + 16 * hf), xb1 = *(const u32x4*)(kp + 32 + 16 * hf + 8);
                const unsigned xa[8] = {xa0.x, xa0.y, xa0.z, xa0.w, xa1.x, xa1.y, xa1.z, xa1.w};
                const unsigned xb[8] = {xb0.x, xb0.y, xb0.z, xb0.w, xb1.x, xb1.y, xb1.z, xb1.w};
                unsigned o1[8], o2[8];
#pragma unroll
                for (int q = 0; q < 8; ++q) {
                    const float c0 = cosI[t * 32 + 16 * hf + 2 * q], c1 = cosI[t * 32 + 16 * hf + 2 * q + 1], s0 = sinI[t * 32 + 16 * hf + 2 * q], s1 = sinI[t * 32 + 16 * hf + 2 * q + 1];
                    const float a_lo = lo_f(xa[q]), a_hi = hi_f(xa[q]), b_lo = lo_f(xb[q]), b_hi = hi_f(xb[q]);
                    o1[q] = pk2(a_lo * c0 - b_lo * s0, a_hi * c1 - b_hi * s1);
                    o2[q] = pk2(b_lo * c0 + a_lo * s0, b_hi * c1 + a_hi * s1);
                }
                u32x4 v; unsigned char* dp = lds + IX_K + key * TP;
                v.x = o1[0]; v.y = o1[1]; v.z = o1[2]; v.w = o1[3]; *(u32x4*)(dp + (16 * hf) * 2) = v;
                v.x = o1[4]; v.y = o1[5]; v.z = o1[6]; v.w = o1[7]; *(u32x4*)(dp + (16 * hf + 8) * 2) = v;
                v.x = o2[0]; v.y = o2[1]; v.z = o2[2]; v.w = o2[3]; *(u32x4*)(dp + (32 + 16 * hf) * 2) = v;
                v.x = o2[4]; v.y = o2[5]; v.z = o2[6]; v.w = o2[7]; *(u32x4*)(dp + (32 + 16 * hf + 8) * 2) = v;
            }
            __syncthreads();
#pragma unroll
            for (int tt = 0; tt < 16; ++tt) {
                const int i = r * 16 + tt;
                const unsigned char* kp = lds + IX_K + (16 * tt + fr) * TP + (8 * fq) * 2;
                f32x4 acc = {0.f, 0.f, 0.f, 0.f};
                acc = mfma16(a0, ld16(kp), acc);
                acc = mfma16(a1, ld16(kp + 64), acc);
                const float s = wi[0] * fmaxf(acc[0], 0.f) + wi[1] * fmaxf(acc[1], 0.f) + wi[2] * fmaxf(acc[2], 0.f) + wi[3] * fmaxf(acc[3], 0.f);
                const int key = 16 * i + fr;
                sc[i] = (key <= tq) ? sortable(s) : 0u;
            }
        } else {
#pragma unroll
            for (int tt = 0; tt < 16; ++tt) sc[r * 16 + tt] = 0u;
        }
    }
    unsigned thr = 0u;
#pragma unroll 1
    for (int bit = 31; bit >= 0; --bit) {
        const unsigned cand = thr | (1u << bit);
        int cnt = 0;
#pragma unroll
        for (int i = 0; i < 128; ++i) cnt += (sc[i] >= cand) ? 1 : 0;
#pragma unroll
        for (int o = 1; o < 16; o <<= 1) cnt += __shfl_xor(cnt, o);
        if (cnt >= 256) thr = cand;
    }
    int ngt = 0;
#pragma unroll
    for (int i = 0; i < 128; ++i) ngt += (sc[i] > thr) ? 1 : 0;
#pragma unroll
    for (int o = 1; o < 16; o <<= 1) ngt += __shfl_xor(ngt, o);
    const int need = 256 - ngt;
    int run = 0;
    unsigned w4[4] = {0u, 0u, 0u, 0u};
    const unsigned lowmask = (1u << fr) - 1u;
#pragma unroll
    for (int i = 0; i < 128; ++i) {
        const bool eq = (sc[i] == thr);
        const unsigned long long be = __ballot(eq);
        const unsigned eqrow = (unsigned)(be >> (16 * fq)) & 0xffffu;
        const int rank = run + __popc(eqrow & lowmask);
        const bool sel = (sc[i] > thr) || (eq && rank < need);
        run += __popc(eqrow);
        const unsigned long long bs = __ballot(sel);
        const unsigned selrow = (unsigned)(bs >> (16 * fq)) & 0xffffu;
        if (fr == ((i >> 1) & 15)) w4[i >> 5] |= selrow << (16 * (i & 1));
    }
#pragma unroll
    for (int k = 0; k < 4; ++k) mask[16 * k + fr] = w4[k];
}

constexpr int SB_W = 0, SB_QG = 17408, SB_KDT = 34816, SB_A = 53248, SB_BYTES = 62464, SB_RED = 2 * 62464;
DI void scan_unit(const Params& p, int layer, int unit, unsigned char* lds) {
    int tid_ = threadIdx.x; asm volatile("" : "+v"(tid_)); const int tid = tid_, lane = tid & 63, wave = tid >> 6, fr = lane & 15, fq = lane >> 4;
    const int h = unit & 3, b = unit >> 2;
    unsigned char* ws = p.ws;
    const unsigned char* su0 = ws + WS_SCAN + (size_t)((b * 4 + h) * 32) * SCAN_UNIT_BYTES;
    const float* dec = (const float*)(ws + WS_DEC) + (b * 4 + h) * 32;
    bf16_t* az = (bf16_t*)(ws + WS_AZ);
    float* red = (float*)(lds + SB_RED);
    const int dvc = h * 128 + 16 * wave + fr;
    const float onw = p.dn_onorm[layer * 128 + 16 * wave + fr];
    const int r16 = tid >> 4, c16 = tid & 15, r8 = tid >> 3, c8 = tid & 7;
    u32x4 pw0, pw1, pq0, pq1, pk0, pk1, pa0; u32x2 pu[4]; bf16_t pz[16];
#define SCAN_PREFETCH(cc) do { const unsigned char* su = su0 + (size_t)(cc) * SCAN_UNIT_BYTES; \
        pw0 = *(const u32x4*)(su + SU_W + tid * 16); pw1 = *(const u32x4*)(su + SU_W + 8192 + tid * 16); \
        pq0 = *(const u32x4*)(su + SU_QG + tid * 16); pq1 = *(const u32x4*)(su + SU_QG + 8192 + tid * 16); \
        pk0 = *(const u32x4*)(su + SU_KDT + tid * 16); pk1 = *(const u32x4*)(su + SU_KDT + 8192 + tid * 16); \
        pa0 = *(const u32x4*)(su + SU_A + tid * 16); \
        _Pragma("unroll") for (int mt = 0; mt < 4; ++mt) pu[mt] = *(const u32x2*)(su + SU_UT + ((16 * wave + fr) * 64 + 16 * mt + 4 * fq) * 2); \
        _Pragma("unroll") for (int mt = 0; mt < 4; ++mt) _Pragma("unroll") for (int jj = 0; jj < 4; ++jj) \
            pz[mt * 4 + jj] = az[((size_t)b * SEQ + (cc) * 64 + 16 * mt + 4 * fq + jj) * 512 + dvc]; } while (0)
#define SCAN_STORE(bufp) do { unsigned char* bp = (bufp); \
        *(u32x4*)(bp + SB_W + r16 * QP + c16 * 16) = pw0; *(u32x4*)(bp + SB_W + (r16 + 32) * QP + c16 * 16) = pw1; \
        *(u32x4*)(bp + SB_QG + r16 * QP + c16 * 16) = pq0; *(u32x4*)(bp + SB_QG + (r16 + 32) * QP + c16 * 16) = pq1; \
        *(u32x4*)(bp + SB_KDT + r8 * TP + c8 * 16) = pk0; *(u32x4*)(bp + SB_KDT + (r8 + 64) * TP + c8 * 16) = pk1; \
        *(u32x4*)(bp + SB_A + r8 * TP + c8 * 16) = pa0; } while (0)
    f32x4 st[8];
#pragma unroll
    for (int m = 0; m < 8; ++m) st[m] = (f32x4){0.f, 0.f, 0.f, 0.f};
    SCAN_PREFETCH(0);
    SCAN_STORE(lds);
    u32x2 cu[4]; bf16_t cz[16];
#pragma unroll
    for (int i = 0; i < 4; ++i) cu[i] = pu[i];
#pragma unroll
    for (int i = 0; i < 16; ++i) cz[i] = pz[i];
    __syncthreads();
#pragma unroll 1
    for (int c = 0; c < 32; ++c) {
        const int cur = c & 1;
        const unsigned char* bp = lds + cur * SB_BYTES;
        const float dg = dec[c];
        if (c + 1 < 32) SCAN_PREFETCH(c + 1);
        bf16x8 sb[4];
#pragma unroll
        for (int s = 0; s < 4; ++s) sb[s] = packf(st[2 * s], st[2 * s + 1]);
        f32x4 vn[4];
#pragma unroll
        for (int mt = 0; mt < 4; ++mt) {
            f32x4 acc = {0.f, 0.f, 0.f, 0.f};
#pragma unroll
            for (int s = 0; s < 4; ++s) { const unsigned char* ap = bp + SB_W + (16 * mt + fr) * QP + (32 * s + 4 * fq) * 2; acc = mfma16(ld8x2(ap, ap + 32), sb[s], acc); }
            vn[mt][0] = lo_f(cu[mt].x) - acc[0]; vn[mt][1] = hi_f(cu[mt].x) - acc[1]; vn[mt][2] = lo_f(cu[mt].y) - acc[2]; vn[mt][3] = hi_f(cu[mt].y) - acc[3];
        }
        bf16x8 vb[2];
#pragma unroll
        for (int s2 = 0; s2 < 2; ++s2) vb[s2] = packf(vn[2 * s2], vn[2 * s2 + 1]);
        f32x4 o[4];
#pragma unroll
        for (int mt = 0; mt < 4; ++mt) {
            f32x4 acc = {0.f, 0.f, 0.f, 0.f};
#pragma unroll
            for (int s = 0; s < 4; ++s) { const unsigned char* ap = bp + SB_QG + (16 * mt + fr) * QP + (32 * s + 4 * fq) * 2; acc = mfma16(ld8x2(ap, ap + 32), sb[s], acc); }
#pragma unroll
            for (int s2 = 0; s2 < 2; ++s2) { const unsigned char* ap = bp + SB_A + (16 * mt + fr) * TP + (32 * s2 + 4 * fq) * 2; acc = mfma16(ld8x2(ap, ap + 32), vb[s2], acc); }
            o[mt] = acc;
        }
#pragma unroll
        for (int m = 0; m < 8; ++m) {
            f32x4 acc = st[m] * dg;
#pragma unroll
            for (int s2 = 0; s2 < 2; ++s2) { const unsigned char* ap = bp + SB_KDT + (16 * m + fr) * TP + (32 * s2 + 4 * fq) * 2; acc = mfma16(ld8x2(ap, ap + 32), vb[s2], acc); }
            st[m] = acc;
        }
#pragma unroll
        for (int mt = 0; mt < 4; ++mt)
#pragma unroll
            for (int jj = 0; jj < 4; ++jj) { const float ssq = row16_sum(o[mt][jj] * o[mt][jj]); if (fr == 0) red[(cur * 8 + wave) * 64 + 16 * mt + 4 * fq + jj] = ssq; }
        if (c + 1 < 32) SCAN_STORE(lds + (cur ^ 1) * SB_BYTES);
        __syncthreads();
#pragma unroll
        for (int mt = 0; mt < 4; ++mt)
#pragma unroll
            for (int jj = 0; jj < 4; ++jj) {
                const int row = 16 * mt + 4 * fq + jj;
                float tot = 0.f;
#pragma unroll
                for (int w8 = 0; w8 < 8; ++w8) tot += red[(cur * 8 + w8) * 64 + row];
                const float rstd = 1.0f / sqrtf(tot * (1.0f / 128.0f) + NORM_EPS);
                const float y = o[mt][jj] * rstd * onw * siluf(bf2f(cz[mt * 4 + jj]));
                az[((size_t)b * SEQ + c * 64 + row) * 512 + dvc] = (bf16_t)f2bf(y);
            }
        if (c + 1 < 32) {
#pragma unroll
            for (int i = 0; i < 4; ++i) cu[i] = pu[i];
#pragma unroll
            for (int i = 0; i < 16; ++i) cz[i] = pz[i];
        }
    }
#undef SCAN_PREFETCH
#undef SCAN_STORE
}

constexpr int AT_K = 0, AT_VT = 17408;
DI void attn_unit(const Params& p, int unit, unsigned char* lds) {
    int tid_ = threadIdx.x; asm volatile("" : "+v"(tid_)); const int tid = tid_, lane = tid & 63, wave = tid >> 6, fr = lane & 15, fq = lane >> 4;
    const int qb = 15 - (unit >> 5), bh = unit & 31, b = bh >> 2, hh = bh & 3;
    unsigned char* ws = p.ws;
    const bf16_t* cq = (const bf16_t*)(ws + WS_CQKV);
    const int q0 = qb * 128, tq = q0 + 16 * wave + fr;
    const size_t tokq = (size_t)b * SEQ + tq;
    const unsigned* mrow = (const unsigned*)(ws + WS_MASK) + tokq * 64;
    bf16x8 qf[4];
#pragma unroll
    for (int s = 0; s < 4; ++s) qf[s] = *(const bf16x8*)(cq + tokq * 1536 + hh * 128 + 32 * s + 8 * fq);
    f32x4 oacc[8];
#pragma unroll
    for (int i = 0; i < 8; ++i) oacc[i] = (f32x4){0.f, 0.f, 0.f, 0.f};
    float mrun = -INFINITY, lrun = 0.f;
    const int nkt = (q0 + 128) / 64;
    const int kr = tid >> 4, kc = tid & 15, vk = 2 * (tid & 31), vp = tid >> 5;
    u32x4 gk0, gk1, gv0, gv1;
#define ATT_PREFETCH(kt) do { const size_t kb = (size_t)b * SEQ + (size_t)(kt) * 64; \
        gk0 = *(const u32x4*)(cq + (kb + kr) * 1536 + 512 + hh * 128 + kc * 8); gk1 = *(const u32x4*)(cq + (kb + kr + 32) * 1536 + 512 + hh * 128 + kc * 8); \
        gv0 = *(const u32x4*)(cq + (kb + vk) * 1536 + 1024 + hh * 128 + vp * 8); gv1 = *(const u32x4*)(cq + (kb + vk + 1) * 1536 + 1024 + hh * 128 + vp * 8); } while (0)
    ATT_PREFETCH(0);
    const float scl = 0.08838834764831845f * 1.4426950408889634f;
#pragma unroll 1
    for (int kt = 0; kt < nkt; ++kt) {
        __syncthreads();
        *(u32x4*)(lds + AT_K + kr * QP + kc * 16) = gk0; *(u32x4*)(lds + AT_K + (kr + 32) * QP + kc * 16) = gk1;
        {
            const unsigned a[4] = {gv0.x, gv0.y, gv0.z, gv0.w}, c4[4] = {gv1.x, gv1.y, gv1.z, gv1.w};
#pragma unroll
            for (int e = 0; e < 4; ++e) {
                *(unsigned*)(lds + AT_VT + (8 * vp + 2 * e) * TP + vk * 2) = (a[e] & 0xffffu) | (c4[e] << 16);
                *(unsigned*)(lds + AT_VT + (8 * vp + 2 * e + 1) * TP + vk * 2) = (a[e] >> 16) | (c4[e] & 0xffff0000u);
            }
        }
        const u32x2 mw = *(const u32x2*)(mrow + 2 * kt);
        __syncthreads();
        if (kt + 1 < nkt) ATT_PREFETCH(kt + 1);
        f32x4 sacc[4];
#pragma unroll
        for (int nt = 0; nt < 4; ++nt) {
            f32x4 acc = {0.f, 0.f, 0.f, 0.f};
#pragma unroll
            for (int s = 0; s < 4; ++s) acc = mfma16(ld16(lds + AT_K + (16 * nt + fr) * QP + (32 * s + 8 * fq) * 2), qf[s], acc);
            sacc[nt] = acc;
        }
        float mx = -INFINITY;
#pragma unroll
        for (int nt = 0; nt < 4; ++nt)
#pragma unroll
            for (int jj = 0; jj < 4; ++jj) { const int kk = 16 * nt + 4 * fq + jj; const unsigned wsel = (kk < 32) ? mw.x : mw.y;
                const bool on = (wsel >> (kk & 31)) & 1u;
                const float v = on ? sacc[nt][jj] * scl : -INFINITY; sacc[nt][jj] = v; mx = fmaxf(mx, v); }
        mx = fmaxf(mx, __shfl_xor(mx, 16)); mx = fmaxf(mx, __shfl_xor(mx, 32));
        const float mnew = fmaxf(mrun, mx);
        const float msafe = (mnew == -INFINITY) ? 0.f : mnew;
        const float alpha = __builtin_amdgcn_exp2f(mrun - msafe);
        mrun = mnew;
        float ps = 0.f;
#pragma unroll
        for (int nt = 0; nt < 4; ++nt)
#pragma unroll
            for (int jj = 0; jj < 4; ++jj) { const float pv = __builtin_amdgcn_exp2f(sacc[nt][jj] - msafe); sacc[nt][jj] = pv; ps += pv; }
        lrun = lrun * alpha + ps;
        bf16x8 pb[2];
#pragma unroll
        for (int s2 = 0; s2 < 2; ++s2) pb[s2] = packf(sacc[2 * s2], sacc[2 * s2 + 1]);
#pragma unroll
        for (int nd = 0; nd < 8; ++nd) {
            f32x4 acc = oacc[nd] * alpha;
#pragma unroll
            for (int s2 = 0; s2 < 2; ++s2) { const unsigned char* ap = lds + AT_VT + (16 * nd + fr) * TP + (32 * s2 + 4 * fq) * 2; acc = mfma16(ld8x2(ap, ap + 32), pb[s2], acc); }
            oacc[nd] = acc;
        }
    }
#undef ATT_PREFETCH
    lrun += __shfl_xor(lrun, 16); lrun += __shfl_xor(lrun, 32);
    const float inv = 1.0f / lrun;
    bf16_t* czp = (bf16_t*)(ws + WS_CZ) + tokq * 512 + hh * 128;
#pragma unroll
    for (int nd = 0; nd < 8; ++nd) {
        bf16_t* zp = czp + 16 * nd + 4 * fq;
        const u32x2 zz = *(const u32x2*)zp;
        f32x4 o; o[0] = oacc[nd][0] * inv * siluf(lo_f(zz.x)); o[1] = oacc[nd][1] * inv * siluf(hi_f(zz.x)); o[2] = oacc[nd][2] * inv * siluf(lo_f(zz.y)); o[3] = oacc[nd][3] * inv * siluf(hi_f(zz.y));
        *(u32x2*)zp = pack4(o);
    }
}

DI void rms_unit(const Params& p, int layer, const float* xin, int unit) {
    int tid_ = threadIdx.x; asm volatile("" : "+v"(tid_)); const int lane = tid_ & 63, wave = tid_ >> 6;
    const float* ng = p.norm_g + layer * DM;
    for (int i = 0; i < 32; ++i) { const size_t m = (size_t)unit * 256 + wave * 32 + i; rms_row(xin + m * DM, ng, (bf16_t*)(p.ws + WS_H2) + m * DM, lane); }
}

#ifndef GEMM_ALIGN
#define GEMM_ALIGN true
#endif
#ifndef GEMM_SP2
#define GEMM_SP2 true
#endif
#ifndef MK_SPLIT
#define MK_SPLIT 0
#endif
constexpr int NPHASE = 14;
constexpr int P2_IDX = 512, P2_DN = 1024, P2_POOL = 1024, P2_SA = 256, P2_TOTAL = P2_IDX + P2_DN + P2_POOL + P2_SA;
constexpr int P3_SCAN = 32, P3_ATT = 512, P3_RMS = 64, P3_TOTAL = P3_SCAN + P3_ATT + P3_RMS;

__global__ void __launch_bounds__(NTHR, 2) hybrid_fwd(Params p) {
    extern __shared__ __attribute__((aligned(16))) unsigned char lds[];
    unsigned char* ws = p.ws;
    unsigned* ctl = (unsigned*)(ws + WS_CTL);
    const int G = gridDim.x;
    PG8_LAS unsigned char* glds = (PG8_LAS unsigned char*)lds;
#if MK_SPLIT
#define SEAM(k) do { } while (0)
#else
    cg::grid_group grid = cg::this_grid();
#define SEAM(k) do { if (p.ph_lo <= (k) && (k) + 1 < p.ph_hi) grid.sync(); } while (0)
#endif
#define IN(k) (p.ph_lo <= (k) && (k) < p.ph_hi)
#pragma unroll 1
    for (int layer = 0; layer < 2; ++layer) {
        const int pb = layer * 7;
        const float* xin = layer == 0 ? p.x : (const float*)p.out;
        if (IN(pb + 0)) {
#ifndef NO_P0
 phase0(p, layer, xin, lds);
#endif
 }
        SEAM(pb + 0);
        if (IN(pb + 1)) {
            pg8::Gemm g{(const bf16_t*)(ws + WS_H), (const bf16_t*)(ws + WS_WIN1), MTOK, N1, 1024}; pg8::StaticOrder S; S.init(MTOK, N1, G, (int)blockIdx.x);
            pg8::EpiProj E{ws};

#ifndef NO_G1
 pg8::gemm_phase<pg8::EpiProj, pg8::StaticOrder, GEMM_ALIGN, GEMM_SP2>(glds, g, S, E);
#endif

        }
        SEAM(pb + 1);
        if (IN(pb + 2)) {
            unsigned* ctr = ctl + (layer * 2 + 0) * 64;
            for (;;) {
                const int u = next_unit(ctr, lds);
                if (u >= P2_TOTAL) break;
                if (u < P2_IDX) {
#ifndef NO_IDX
 indexer_unit(p, u, lds);
#endif
 }
                else if (u < P2_IDX + P2_DN) {
#ifndef NO_DN
 dn_prep_unit(p, layer, u - P2_IDX, lds);
#endif
 }
                else if (u < P2_IDX + P2_DN + P2_POOL) {
#ifndef NO_POOL
 pool_unit(p, layer, u - P2_IDX - P2_DN, lds);
#endif
 }
                else {
#ifndef NO_SA
 sa_prep_unit(p, layer, u - P2_IDX - P2_DN - P2_POOL, lds);
#endif
 }
            }
        }
        SEAM(pb + 2);
        if (IN(pb + 3)) {
            unsigned* ctr = ctl + (layer * 2 + 1) * 64;
            for (;;) {
                const int u = next_unit(ctr, lds);
                if (u >= P3_TOTAL) break;
                if (u < P3_SCAN) {
#ifndef NO_SCAN
 scan_unit(p, layer, u, lds);
#endif
 }
                else if (u < P3_SCAN + P3_ATT) {
#ifndef NO_ATT
 attn_unit(p, u - P3_SCAN, lds);
#endif
 }
                else rms_unit(p, layer, xin, u - P3_SCAN - P3_ATT);
            }
        }
        SEAM(pb + 3);
        if (IN(pb + 4)) {
            pg8::Gemm g{(const bf16_t*)(ws + WS_H2), (const bf16_t*)(ws + WS_WG), MTOK, NG, 1024}; pg8::StaticOrder S; S.init(MTOK, NG, G, (int)blockIdx.x);
            pg8::EpiGate E{ws, p.gate_b + layer * 3072};

#ifndef NO_G4
 pg8::gemm_phase<pg8::EpiGate, pg8::StaticOrder, GEMM_ALIGN, GEMM_SP2>(glds, g, S, E);
#endif

        }
        SEAM(pb + 4);
        if (IN(pb + 5)) {
#pragma unroll 1
            for (int br = 0; br < 3; ++br) {
                const bf16_t* Y = (const bf16_t*)(ws + (br == 0 ? WS_AZ : (br == 1 ? WS_BZ : WS_CZ)));
                const bf16_t* Gp = (const bf16_t*)(ws + (br == 0 ? WS_G0 : (br == 1 ? WS_G1 : WS_G2)));
                pg8::Gemm g{Y, (const bf16_t*)(ws + WS_WBR) + (size_t)br * 1024 * 512, MTOK, 1024, 512}; pg8::StaticOrder S; S.init(MTOK, 1024, G, (int)blockIdx.x);
                pg8::EpiMerge E{Gp, (bf16_t*)(ws + WS_MERGED), br == 0 ? 1 : 0};

#ifndef NO_G5
 pg8::gemm_phase<pg8::EpiMerge, pg8::StaticOrder, GEMM_ALIGN, GEMM_SP2>(glds, g, S, E);
#endif

                __syncthreads();
            }
        }
        SEAM(pb + 5);
        if (IN(pb + 6)) {
            pg8::Gemm g{(const bf16_t*)(ws + WS_MERGED), (const bf16_t*)(ws + WS_WO), MTOK, 1024, 1024}; pg8::StaticOrder S; S.init(MTOK, 1024, G, (int)blockIdx.x);
            pg8::EpiOut E{xin, p.out};

#ifndef NO_G6
 pg8::gemm_phase<pg8::EpiOut, pg8::StaticOrder, GEMM_ALIGN, GEMM_SP2>(glds, g, S, E);
#endif

        }
        SEAM(pb + 6);
    }
#undef IN
#undef SEAM
}

extern "C" void kernel_launch(void* const* d_in, const int* in_sizes, int n_in, void* d_out, int out_size, void* d_ws, size_t ws_size, hipStream_t stream) {
    static int grid = 0;
    if (grid == 0) {
        if (n_in != 14 || in_sizes[0] != MTOK * DM || out_size != MTOK * DM || ws_size < WS_END) { fprintf(stderr, "kernel_launch: unexpected shapes / workspace (%d inputs, ws %zu)\n", n_in, ws_size); grid = -1; return; }
        int dev = 0, cus = 0, per_cu = 0;
        if (hipGetDevice(&dev) != hipSuccess || hipDeviceGetAttribute(&cus, hipDeviceAttributeMultiprocessorCount, dev) != hipSuccess) { grid = -1; return; }
        if (hipFuncSetAttribute((const void*)hybrid_fwd, hipFuncAttributeMaxDynamicSharedMemorySize, LDS_BYTES) != hipSuccess) { fprintf(stderr, "kernel_launch: hipFuncSetAttribute failed\n"); grid = -1; return; }
        if (hipOccupancyMaxActiveBlocksPerMultiprocessor(&per_cu, (const void*)hybrid_fwd, NTHR, LDS_BYTES) != hipSuccess || per_cu < 1) { fprintf(stderr, "kernel_launch: occupancy query says %d\n", per_cu); per_cu = 1; }
        (void)hipGetLastError();
        grid = cus * per_cu;
    }
    if (grid < 0) return;
    (void)hipMemsetAsync((char*)d_ws + WS_CTL, 0, CTL_BYTES, stream);
    Params p{};
    p.x = (const float*)d_in[0]; p.norm_g = (const float*)d_in[1]; p.w_in = (const float*)d_in[2]; p.gate_b = (const float*)d_in[3]; p.conv_w = (const float*)d_in[4];
    p.a_log = (const float*)d_in[5]; p.dt_bias = (const float*)d_in[6]; p.dn_onorm = (const float*)d_in[7]; p.pool_w = (const float*)d_in[8]; p.pool_scale = (const float*)d_in[9];
    p.q_norm = (const float*)d_in[10]; p.k_norm = (const float*)d_in[11]; p.w_branch = (const float*)d_in[12]; p.w_out = (const float*)d_in[13];
    p.out = (float*)d_out; p.ws = (unsigned char*)d_ws;
#if MK_SPLIT
    for (int ph = 0; ph < NPHASE; ++ph) { p.ph_lo = ph; p.ph_hi = ph + 1; hipLaunchKernelGGL(hybrid_fwd, dim3(grid), dim3(NTHR), LDS_BYTES, stream, p); }
#else
    p.ph_lo = 0; p.ph_hi = NPHASE;
    void* args[] = {&p};
    const hipError_t e = hipLaunchCooperativeKernel((const void*)hybrid_fwd, dim3(grid), dim3(NTHR), args, LDS_BYTES, stream);
    if (e != hipSuccess) fprintf(stderr, "kernel_launch: cooperative launch failed: %s (grid %d)\n", hipGetErrorString(e), grid);
#endif
}
```

```cpp
#include <hip/hip_runtime.h>
#include <hip/hip_cooperative_groups.h>
#include <cstdio>
#include <cstdint>
#include <cmath>
namespace cg = cooperative_groups;
constexpr int BATCH = 8, SEQ = 2048, DM = 1024, MTOK = BATCH * SEQ;
constexpr int INW = 8524;
constexpr int N1 = 5632;
constexpr int NG = 3072;
constexpr float NORM_EPS = 1e-6f;
constexpr size_t MiB = 1u << 20;
constexpr size_t WS_CTL = 0;
constexpr size_t CTL_BYTES = 32768;
constexpr size_t WS_COSA = 1 * MiB, WS_SINA = WS_COSA + 512 * 1024;
constexpr size_t WS_COSI = 2 * MiB, WS_SINI = WS_COSI + 256 * 1024;
constexpr size_t WS_DEC = 2 * MiB + 512 * 1024;
constexpr size_t WS_MISC = 3 * MiB;
constexpr size_t WS_WG = 4 * MiB;
constexpr size_t WS_WBR = 10 * MiB;
constexpr size_t WS_WO = 13 * MiB;
constexpr size_t WS_POOLW = 15 * MiB;
constexpr size_t WS_MASK = 16 * MiB;
constexpr size_t WS_R1 = 20 * MiB;
constexpr size_t WS_H = WS_R1;
constexpr size_t WS_WIN1 = WS_R1 + 32 * MiB;
constexpr size_t WS_SCAN = WS_R1;
constexpr size_t WS_G0 = WS_R1, WS_G1 = WS_R1 + 32 * MiB;
constexpr size_t WS_R2 = 93 * MiB;
constexpr size_t WS_AQKV = WS_R2;
constexpr size_t WS_H2 = WS_R2;
constexpr size_t WS_MERGED = WS_G0;
constexpr size_t WS_R3 = 141 * MiB;
constexpr size_t WS_CQKV = WS_R3;
constexpr size_t WS_G2 = WS_R3;
constexpr size_t WS_AZ = 189 * MiB, WS_BZ = 205 * MiB, WS_CZ = 221 * MiB, WS_BU = 237 * MiB;
constexpr size_t WS_CIDX = 253 * MiB;
constexpr size_t WS_END = 263 * MiB;
constexpr int SCAN_UNIT_BYTES = 73728;
constexpr int SU_W = 0, SU_QG = 16384, SU_KDT = 32768, SU_UT = 49152, SU_A = 65536;
namespace pg8 {
#define PG8_LAS __attribute__((address_space(3)))
typedef unsigned short bf16_t;
typedef short bf16x8 __attribute__((ext_vector_type(8)));
typedef float f32x4 __attribute__((ext_vector_type(4)));
typedef unsigned u32x4 __attribute__((ext_vector_type(4)));
constexpr int BM = 256, BK = 64, HALF = 128, HTB = HALF * BK * 2  , STAGE_BYTES = 8 * HTB, NXCD = 8, WGM = 8;

__host__ __device__ __forceinline__ int lds_byte(int r, int c) { const int st = (r >> 4) * 2 + (c >> 5), rr = r & 15, cc = c & 31, ob = rr * 64 + cc * 2; return st * 1024 + (ob ^ (((ob >> 9) & 1) << 5)); }
__host__ __device__ __forceinline__ void stage_rc(int b, int& R, int& C) { const int st = b / 1024, sb = b % 1024, swz = sb ^ (((sb >> 9) & 1) << 5); R = (st >> 1) * 16 + swz / 64; C = (st & 1) * 32 + (swz % 64) / 2; }
__host__ __device__ __forceinline__ int perm32(int rho) { const int n = rho >> 4, i = rho & 15; return 8 * (i >> 2) + 4 * n + (i & 3); }

struct Unit { int pm, pn; };
struct Gemm { const bf16_t* A; const bf16_t* Bt; int M, N, K; };

struct StaticOrder {
    int nM, nN, nwg, G, c;
    __host__ __device__ void init(int M, int N, int G_, int c_) { nM = M / BM; nN = N / BM; nwg = nM * nN; G = G_; c = c_; }
    __host__ __device__ bool next(int i, Unit& u) const {
        const long L = (long)i * G + c; if (L >= nwg) return false;
        int wgid = (int)L; { const int q = nwg / NXCD, r = nwg % NXCD, xcd = wgid % NXCD, off = wgid / NXCD; wgid = (xcd < r ? xcd * (q + 1) : r * (q + 1) + (xcd - r) * q) + off; }
        const int nig = WGM * nN, gid = wgid / nig, fm = gid * WGM, gsz = (nM - fm) < WGM ? (nM - fm) : WGM;
        u.pm = fm + ((wgid % nig) % gsz); u.pn = (wgid % nig) / gsz; return true;
    }
    __device__ __forceinline__ void a_ready(const Unit&) const {}
    __device__ __forceinline__ void done(const Unit&) const {}
};

__device__ __forceinline__ unsigned cvt_pk_bf16(float lo, float hi) { unsigned r; asm volatile("s_nop 1\n\tv_cvt_pk_bf16_f32 %0, %1, %2" : "=v"(r) : "v"(lo), "v"(hi)); return r; }
struct EpiProj {
    static constexpr bool PERM = true, AFTER_DRAIN = false;
    unsigned char* ws;
    __device__ __forceinline__ void operator()(const f32x4 (&acc)[2][2][4][2], const Unit& u, int wr, int wc, int fr, int fq) const {
        const int pn = u.pn; const int row0 = u.pm * BM + wr * 64 + fr;
        if (pn == 21) {
            const int c = wc * 32 + 8 * fq;
            if (c < 80) {
#pragma unroll
                for (int ai = 0; ai < 2; ++ai)
#pragma unroll
                    for (int m = 0; m < 4; ++m) { const size_t row = (size_t)(row0 + ai * HALF + m * 16); const f32x4 v0 = acc[ai][0][m][0], v1 = acc[ai][0][m][1];
                        if (c < 64) { u32x4 w; w.x = cvt_pk_bf16(v0[0], v0[1]); w.y = cvt_pk_bf16(v0[2], v0[3]); w.z = cvt_pk_bf16(v1[0], v1[1]); w.w = cvt_pk_bf16(v1[2], v1[3]);
                            *(u32x4*)((bf16_t*)(ws + WS_CIDX) + row * 320 + 256 + c) = w; }
                        else { float* mp = (float*)(ws + WS_MISC) + row * 16 + (c - 64); *(f32x4*)mp = v0; *(f32x4*)(mp + 4) = v1; } }
            }
            return;
        }
        size_t off; int ldc, colt;
        if (pn < 6) { off = WS_AQKV; ldc = 1536; colt = pn * 256; }
        else if (pn < 8) { off = WS_AZ; ldc = 512; colt = (pn - 6) * 256; }
        else if (pn < 10) { off = WS_BU; ldc = 512; colt = (pn - 8) * 256; }
        else if (pn < 12) { off = WS_BZ; ldc = 512; colt = (pn - 10) * 256; }
        else if (pn < 18) { off = WS_CQKV; ldc = 1536; colt = (pn - 12) * 256; }
        else if (pn < 20) { off = WS_CZ; ldc = 512; colt = (pn - 18) * 256; }
        else { off = WS_CIDX; ldc = 320; colt = 0; }
        bf16_t* base = (bf16_t*)(ws + off); const int col0 = colt + wc * 32 + 8 * fq;
#pragma unroll
        for (int ai = 0; ai < 2; ++ai)
#pragma unroll
            for (int m = 0; m < 4; ++m) { bf16_t* rowp = base + (size_t)(row0 + ai * HALF + m * 16) * ldc + col0;
#pragma unroll
                for (int bj = 0; bj < 2; ++bj) { const f32x4 v0 = acc[ai][bj][m][0], v1 = acc[ai][bj][m][1];
                    u32x4 w; w.x = cvt_pk_bf16(v0[0], v0[1]); w.y = cvt_pk_bf16(v0[2], v0[3]); w.z = cvt_pk_bf16(v1[0], v1[1]); w.w = cvt_pk_bf16(v1[2], v1[3]);
                    *(u32x4*)(rowp + bj * HALF) = w; } }
    }
};
__device__ __forceinline__ float sigm(float x) { return __builtin_amdgcn_rcpf(1.0f + __expf(-x)); }
struct EpiGate {
    static constexpr bool PERM = true, AFTER_DRAIN = false;
    unsigned char* ws; const float* gb;
    __device__ __forceinline__ void operator()(const f32x4 (&acc)[2][2][4][2], const Unit& u, int wr, int wc, int fr, int fq) const {
        const int pn = u.pn, br = pn >> 2; const int row0 = u.pm * BM + wr * 64 + fr;
        bf16_t* base = (bf16_t*)(ws + (br == 0 ? WS_G0 : (br == 1 ? WS_G1 : WS_G2)));
        const int col0 = (pn & 3) * 256 + wc * 32 + 8 * fq; const float* bp = gb + br * 1024 + col0;
        f32x4 bv[2][2];
#pragma unroll
        for (int bj = 0; bj < 2; ++bj)
#pragma unroll
            for (int n = 0; n < 2; ++n) bv[bj][n] = *(const f32x4*)(bp + bj * HALF + 4 * n);
#pragma unroll
        for (int ai = 0; ai < 2; ++ai)
#pragma unroll
            for (int m = 0; m < 4; ++m) { bf16_t* rowp = base + (size_t)(row0 + ai * HALF + m * 16) * 1024 + col0;
#pragma unroll
                for (int bj = 0; bj < 2; ++bj) { const f32x4 v0 = acc[ai][bj][m][0] + bv[bj][0], v1 = acc[ai][bj][m][1] + bv[bj][1];
                    u32x4 w; w.x = cvt_pk_bf16(sigm(v0[0]), sigm(v0[1])); w.y = cvt_pk_bf16(sigm(v0[2]), sigm(v0[3])); w.z = cvt_pk_bf16(sigm(v1[0]), sigm(v1[1])); w.w = cvt_pk_bf16(sigm(v1[2]), sigm(v1[3]));
                    *(u32x4*)(rowp + bj * HALF) = w; } }
    }
};
__device__ __forceinline__ float bflo(unsigned w) { return __uint_as_float(w << 16); }
__device__ __forceinline__ float bfhi(unsigned w) { return __uint_as_float(w & 0xffff0000u); }
struct GateOrder {
    int G, c;
    __device__ __forceinline__ void init(int G_, int c_) { G = G_; c = c_; }
    __device__ __forceinline__ bool next(int i, Unit& u) const {
        const int t = i / 3, br = i - 3 * t; int L = t * G + c; if (L >= 256) return false;
        if (G == 256) L = (L & 7) * 32 + (L >> 3);
        u.pm = L >> 2; u.pn = br * 4 + (L & 3); return true;
    }
    __device__ __forceinline__ void a_ready(const Unit&) const {}
    __device__ __forceinline__ void done(const Unit&) const {}
};
struct MergeOrder {
    int G, c;
    __device__ __forceinline__ void init(int G_, int c_) { G = G_; c = c_; }
    __device__ __forceinline__ bool next(int i, Unit& u) const {
        const int t = i / 3, br = i - 3 * t; int L = t * G + c; if (L >= 256) return false;
        if (G == 256) L = (L & 7) * 32 + (L >> 3);
        u.pm = br * 64 + (L >> 2); u.pn = br * 4 + (L & 3); return true;
    }
    __device__ __forceinline__ void a_ready(const Unit&) const {}
    __device__ __forceinline__ void done(const Unit&) const {}
};
struct EpiMerge {
    static constexpr bool PERM = true, AFTER_DRAIN = false;
    unsigned char* ws;
    __device__ __forceinline__ void operator()(const f32x4 (&acc)[2][2][4][2], const Unit& u, int wr, int wc, int fr, int fq) const {
        const int br = u.pm >> 6, pm = u.pm & 63, pn = u.pn & 3; const bool first = (br == 0);
        const bf16_t* G = (const bf16_t*)(ws + (br == 0 ? WS_G0 : (br == 1 ? WS_G1 : WS_G2))); bf16_t* mg = (bf16_t*)(ws + WS_MERGED);
        const int row0 = pm * BM + wr * 64 + fr; const int col0 = pn * 256 + wc * 32 + 8 * fq;
#pragma unroll
        for (int ai = 0; ai < 2; ++ai) {
            u32x4 gv[4][2], pv[4][2];
#pragma unroll
            for (int m = 0; m < 4; ++m)
#pragma unroll
                for (int bj = 0; bj < 2; ++bj) { const size_t o = (size_t)(row0 + ai * HALF + m * 16) * 1024 + col0 + bj * HALF;
                    gv[m][bj] = *(const u32x4*)(G + o); pv[m][bj] = first ? (u32x4){0u, 0u, 0u, 0u} : *(const u32x4*)(mg + o); }
            __builtin_amdgcn_sched_barrier(0);
#pragma unroll
            for (int m = 0; m < 4; ++m)
#pragma unroll
                for (int bj = 0; bj < 2; ++bj) { const size_t ro = (size_t)(row0 + ai * HALF + m * 16) * 1024 + col0 + bj * HALF;
                    const f32x4 v0 = acc[ai][bj][m][0], v1 = acc[ai][bj][m][1]; const u32x4 g = gv[m][bj], p = pv[m][bj];
                    u32x4 w;
                    w.x = cvt_pk_bf16(bflo(p.x) + bflo(g.x) * v0[0], bfhi(p.x) + bfhi(g.x) * v0[1]); w.y = cvt_pk_bf16(bflo(p.y) + bflo(g.y) * v0[2], bfhi(p.y) + bfhi(g.y) * v0[3]);
                    w.z = cvt_pk_bf16(bflo(p.z) + bflo(g.z) * v1[0], bfhi(p.z) + bfhi(g.z) * v1[1]); w.w = cvt_pk_bf16(bflo(p.w) + bflo(g.w) * v1[2], bfhi(p.w) + bfhi(g.w) * v1[3]);
                    *(u32x4*)(mg + ro) = w; }
            __builtin_amdgcn_sched_barrier(0);
        }
    }
};
struct EpiOut {
    static constexpr bool PERM = false, AFTER_DRAIN = false;
    const float* xin; float* out;
    __device__ __forceinline__ void operator()(const f32x4 (&acc)[2][2][4][2], const Unit& u, int wr, int wc, int fr, int fq) const {
        const int row0 = u.pm * BM + wr * 64 + fr; const int col0 = u.pn * 256 + wc * 32 + 4 * fq;
#pragma unroll
        for (int ai = 0; ai < 2; ++ai) {
            f32x4 xv[4][2][2];
#pragma unroll
            for (int m = 0; m < 4; ++m)
#pragma unroll
                for (int bj = 0; bj < 2; ++bj)
#pragma unroll
                    for (int n = 0; n < 2; ++n) xv[m][bj][n] = *(const f32x4*)(xin + (size_t)(row0 + ai * HALF + m * 16) * 1024 + col0 + bj * HALF + n * 16);
            __builtin_amdgcn_sched_barrier(0);
#pragma unroll
            for (int m = 0; m < 4; ++m)
#pragma unroll
                for (int bj = 0; bj < 2; ++bj)
#pragma unroll
                    for (int n = 0; n < 2; ++n) *(f32x4*)(out + (size_t)(row0 + ai * HALF + m * 16) * 1024 + col0 + bj * HALF + n * 16) = xv[m][bj][n] + acc[ai][bj][m][n];
            __builtin_amdgcn_sched_barrier(0);
        }
    }
};
template <class Epi, class Sched, bool ALIGN_EPI = false, bool SP2 = false>
__device__ __forceinline__ void gemm_phase(PG8_LAS unsigned char* lds, const Gemm g, const Sched& S, const Epi& E) {
    int tid_ = threadIdx.x; asm volatile("" : "+v"(tid_)); const int tid = tid_, wid = __builtin_amdgcn_readfirstlane(tid >> 6), lane = tid & 63, wr = wid >> 2, wc = wid & 3, fr = lane & 15, fq = lane >> 4;
    const int K = g.K, nt = K / BK;
    unsigned voffA[2], voffB[2];
#pragma unroll
    for (int i = 0; i < 2; ++i) { int R, C; stage_rc(tid * 16 + i * 8192, R, C); const int Rb = Epi::PERM ? ((R & ~31) + perm32(R & 31)) : R;
        voffA[i] = (unsigned)(R * K + C) * 2u; voffB[i] = (unsigned)(Rb * K + C) * 2u; }
    const size_t kstep = (size_t)(BK * 2);
    const size_t hstep = (size_t)HALF * K * 2;
    const size_t tstep = 2 * hstep;
    const unsigned ldsw = (unsigned)wid * 1024u;
    const int aoff = lds_byte(wr * 64 + fr, fq * 8), boff = lds_byte(wc * 32 + fr, fq * 8);
#define PG8_SA(b, h) (((b) * 2 + (h)) * HTB)
#define PG8_SB(b, h) ((4 + (b) * 2 + (h)) * HTB)
#define PG8_STAGE(bufoff, gbase, voff) do { _Pragma("unroll") for (int _i = 0; _i < 2; ++_i) \
        __builtin_amdgcn_global_load_lds((const unsigned*)((const char*)(gbase) + (voff)[_i]), (PG8_LAS unsigned*)(lds + (bufoff) + ldsw + _i * 8192), 16, 0, 0); } while (0)
#define PG8_LDA(dst, b, h) do { _Pragma("unroll") for (int m = 0; m < 4; ++m) _Pragma("unroll") for (int k = 0; k < 2; ++k) dst[m][k] = *(const PG8_LAS bf16x8*)(lds + PG8_SA(b, h) + aoff + m * 2048 + k * 1024); } while (0)
#define PG8_LDB(dst, b, h) do { _Pragma("unroll") for (int n = 0; n < 2; ++n) _Pragma("unroll") for (int k = 0; k < 2; ++k) dst[n][k] = *(const PG8_LAS bf16x8*)(lds + PG8_SB(b, h) + boff + n * 2048 + k * 1024); } while (0)
#define PG8_MMA(ai, bj, At, Bt) do { __builtin_amdgcn_s_setprio(1); _Pragma("unroll") for (int m = 0; m < 4; ++m) _Pragma("unroll") for (int n = 0; n < 2; ++n) _Pragma("unroll") for (int k = 0; k < 2; ++k) \
        acc[ai][bj][m][n] = __builtin_amdgcn_mfma_f32_16x16x32_bf16(Bt[n][k], At[m][k], acc[ai][bj][m][n], 0, 0, 0); __builtin_amdgcn_s_setprio(0); } while (0)
#define PG8_WAIT_V(n) asm volatile("s_waitcnt vmcnt(" #n ")" ::: "memory")
#define PG8_WAIT_L(n) asm volatile("s_waitcnt lgkmcnt(" #n ")" ::: "memory")
#define PG8_BAR __builtin_amdgcn_s_barrier()
#define PG8_SCHED __builtin_amdgcn_sched_barrier(0)
    Unit cur, nxt; int ui = 0;
    if (!S.next(0, cur)) return;
    f32x4 acc[2][2][4][2];
#pragma unroll
    for (int a = 0; a < 2; ++a)
#pragma unroll
        for (int b = 0; b < 2; ++b)
#pragma unroll
            for (int m = 0; m < 4; ++m)
#pragma unroll
                for (int n = 0; n < 2; ++n) acc[a][b][m][n] = (f32x4){0.f, 0.f, 0.f, 0.f};
    bf16x8 At[4][2], B0[2][2], B1[2][2];
    const char* cA = (const char*)g.A + (size_t)cur.pm * tstep; const char* cB = (const char*)g.Bt + (size_t)cur.pn * tstep;
    S.a_ready(cur);
    if constexpr (SP2) {
        PG8_STAGE(PG8_SB(0, 0), cB, voffB); PG8_STAGE(PG8_SB(0, 1), cB + hstep, voffB); PG8_STAGE(PG8_SA(0, 0), cA, voffA); PG8_STAGE(PG8_SA(0, 1), cA + hstep, voffA);
        if (wr == 1) PG8_BAR;
        PG8_WAIT_V(2); PG8_BAR;
        PG8_STAGE(PG8_SB(1, 0), cB + kstep, voffB); PG8_STAGE(PG8_SA(1, 0), cA + kstep, voffA); PG8_STAGE(PG8_SB(1, 1), cB + hstep + kstep, voffB);
        PG8_WAIT_V(6); PG8_BAR;
    } else {
        PG8_STAGE(PG8_SB(0, 0), cB, voffB); PG8_STAGE(PG8_SA(0, 0), cA, voffA); PG8_STAGE(PG8_SB(0, 1), cB + hstep, voffB); PG8_STAGE(PG8_SA(0, 1), cA + hstep, voffA);
        if (wr == 1) PG8_BAR;
        PG8_WAIT_V(4); PG8_BAR;
        PG8_STAGE(PG8_SB(1, 0), cB + kstep, voffB); PG8_STAGE(PG8_SA(1, 0), cA + kstep, voffA); PG8_STAGE(PG8_SB(1, 1), cB + hstep + kstep, voffB);
        PG8_WAIT_V(6); PG8_BAR;
    }
    for (;;) {
        const bool has_next = S.next(ui + 1, nxt);
        const char* nA = has_next ? (const char*)g.A + (size_t)nxt.pm * tstep : cA; const char* nB = has_next ? (const char*)g.Bt + (size_t)nxt.pn * tstep : cB;
        for (int t = 0; t < nt; t += 2) {
            const bool last = (t == nt - 2);
            const char* a1 = cA + (size_t)(t + 1) * kstep;
            const char* a2 = last ? nA : cA + (size_t)(t + 2) * kstep; const char* b2 = last ? nB : cB + (size_t)(t + 2) * kstep;
            const char* a3 = a2 + kstep; const char* b3 = b2 + kstep;
            if (last && has_next) S.a_ready(nxt);
            if constexpr (SP2) {
            PG8_LDB(B0, 0, 0); PG8_LDB(B1, 0, 1); PG8_SCHED; PG8_LDA(At, 0, 0); PG8_STAGE(PG8_SA(1, 1), a1 + hstep, voffA);
            PG8_WAIT_V(8); PG8_WAIT_L(0); PG8_BAR; PG8_MMA(0, 0, At, B0); PG8_MMA(0, 1, At, B1); PG8_BAR; PG8_SCHED;
            PG8_LDA(At, 0, 1); PG8_STAGE(PG8_SB(0, 0), b2, voffB); PG8_STAGE(PG8_SB(0, 1), b2 + hstep, voffB); PG8_STAGE(PG8_SA(0, 0), a2, voffA);
            PG8_WAIT_V(8); PG8_WAIT_L(0); PG8_BAR; PG8_MMA(1, 0, At, B0); PG8_MMA(1, 1, At, B1); PG8_BAR; PG8_SCHED;
            PG8_LDB(B0, 1, 0); PG8_LDB(B1, 1, 1); PG8_SCHED; PG8_LDA(At, 1, 0); PG8_STAGE(PG8_SA(0, 1), a2 + hstep, voffA);
            PG8_WAIT_V(8); PG8_WAIT_L(0); PG8_BAR; PG8_MMA(0, 0, At, B0); PG8_MMA(0, 1, At, B1); PG8_BAR; PG8_SCHED;
            PG8_LDA(At, 1, 1); PG8_STAGE(PG8_SB(1, 0), b3, voffB); PG8_STAGE(PG8_SB(1, 1), b3 + hstep, voffB); PG8_STAGE(PG8_SA(1, 0), a3, voffA);
            PG8_WAIT_V(8); PG8_WAIT_L(0); PG8_BAR; PG8_MMA(1, 0, At, B0); PG8_MMA(1, 1, At, B1); PG8_BAR; PG8_SCHED;
            } else {
            PG8_LDB(B0, 0, 0); PG8_SCHED; PG8_LDA(At, 0, 0); PG8_STAGE(PG8_SA(1, 1), a1 + hstep, voffA);
            PG8_WAIT_L(8); PG8_BAR; PG8_WAIT_L(0); PG8_MMA(0, 0, At, B0); PG8_BAR; PG8_SCHED;
            PG8_LDB(B1, 0, 1); PG8_STAGE(PG8_SB(0, 0), b2, voffB);
            PG8_BAR; PG8_WAIT_L(0); PG8_MMA(0, 1, At, B1); PG8_BAR;
            PG8_LDA(At, 0, 1); PG8_STAGE(PG8_SA(0, 0), a2, voffA);
            PG8_BAR; PG8_WAIT_L(0); PG8_MMA(1, 0, At, B0); PG8_BAR; PG8_SCHED;
            PG8_STAGE(PG8_SB(0, 1), b2 + hstep, voffB);
            PG8_WAIT_V(6); PG8_BAR; PG8_MMA(1, 1, At, B1); PG8_BAR;
            PG8_LDB(B0, 1, 0); PG8_SCHED; PG8_LDA(At, 1, 0); PG8_STAGE(PG8_SA(0, 1), a2 + hstep, voffA);
            PG8_WAIT_L(8); PG8_BAR; PG8_WAIT_L(0); PG8_MMA(0, 0, At, B0); PG8_BAR; PG8_SCHED;
            PG8_LDB(B1, 1, 1); PG8_STAGE(PG8_SB(1, 0), b3, voffB);
            PG8_BAR; PG8_WAIT_L(0); PG8_MMA(0, 1, At, B1); PG8_BAR;
            PG8_LDA(At, 1, 1); PG8_STAGE(PG8_SA(1, 0), a3, voffA);
            PG8_BAR; PG8_WAIT_L(0); PG8_MMA(1, 0, At, B0); PG8_BAR; PG8_SCHED;
            PG8_STAGE(PG8_SB(1, 1), b3 + hstep, voffB);
            PG8_WAIT_V(6); PG8_BAR; PG8_MMA(1, 1, At, B1); PG8_BAR;
            }
        }
        if constexpr (ALIGN_EPI) { if (wr == 0) PG8_BAR; }
        if constexpr (!Epi::AFTER_DRAIN) { E(acc, cur, wr, wc, fr, fq); S.done(cur); }
        if (!has_next) break;
#pragma unroll
        for (int a = 0; a < 2; ++a)
#pragma unroll
            for (int b = 0; b < 2; ++b)
#pragma unroll
                for (int m = 0; m < 4; ++m)
#pragma unroll
                    for (int n = 0; n < 2; ++n) acc[a][b][m][n] = (f32x4){0.f, 0.f, 0.f, 0.f};
        cur = nxt; cA = nA; cB = nB; ++ui;
        if constexpr (ALIGN_EPI) { if (wr == 1) PG8_BAR; }
    }
    PG8_WAIT_V(0);
    if constexpr (!ALIGN_EPI) { if (wr == 0) PG8_BAR; }
    PG8_BAR;
    if constexpr (Epi::AFTER_DRAIN) { E.fused(acc, cur, wr, wc, fr, fq, lds, wid, lane); S.done(cur); }
#undef PG8_SA
#undef PG8_SB
#undef PG8_STAGE
#undef PG8_LDA
#undef PG8_LDB
#undef PG8_MMA
#undef PG8_WAIT_V
#undef PG8_WAIT_L
#undef PG8_BAR
#undef PG8_SCHED
}
}

#define DI __device__ __forceinline__
typedef unsigned short bf16_t;
typedef short bf16x8 __attribute__((ext_vector_type(8)));
typedef short bf16x4 __attribute__((ext_vector_type(4)));
typedef float f32x4 __attribute__((ext_vector_type(4)));
typedef unsigned u32x4 __attribute__((ext_vector_type(4)));
typedef unsigned u32x2 __attribute__((ext_vector_type(2)));
constexpr int NTHR = 512, NWAVE = 8;
constexpr int LDS_BYTES = 155648;
constexpr int LDS_SLOT = 155648 - 64;

DI float bf2f(bf16_t v) { return __uint_as_float(((unsigned)v) << 16); }
DI unsigned f2bf(float f) { unsigned u = __float_as_uint(f); return (u + 0x7fffu + ((u >> 16) & 1u)) >> 16; }
DI unsigned pk2(float lo, float hi) { return f2bf(lo) | (f2bf(hi) << 16); }
DI float lo_f(unsigned w) { return __uint_as_float(w << 16); }
DI float hi_f(unsigned w) { return __uint_as_float(w & 0xffff0000u); }
DI float siluf(float x) { return x * __builtin_amdgcn_rcpf(1.0f + __expf(-x)); }
DI float sigmf(float x) { return __builtin_amdgcn_rcpf(1.0f + __expf(-x)); }
#define DPPF(v, ctrl) __builtin_bit_cast(float, __builtin_amdgcn_update_dpp(0, __builtin_bit_cast(int, (v)), (ctrl), 0xf, 0xf, true))
#define DPPI(v, ctrl) __builtin_amdgcn_update_dpp(0, (v), (ctrl), 0xf, 0xf, true)
DI float row16_sum(float v) {
    v += DPPF(v, 0xB1); v += DPPF(v, 0x4E); v += DPPF(v, 0x141); v += DPPF(v, 0x140);
    return v;
}
DI int row16_sumi(int v) {
    v += DPPI(v, 0xB1); v += DPPI(v, 0x4E); v += DPPI(v, 0x141); v += DPPI(v, 0x140);
    return v;
}
DI float wave_sum(float v) {
    v = row16_sum(v);
    v += __shfl_xor(v, 16); v += __shfl_xor(v, 32);
    return v;
}
DI f32x4 mfma16(bf16x8 a, bf16x8 b, f32x4 c) { return __builtin_amdgcn_mfma_f32_16x16x32_bf16(a, b, c, 0, 0, 0); }
DI bf16x8 ld16(const unsigned char* p) { return *(const bf16x8*)p; }
DI bf16x8 ld8x2(const unsigned char* p0, const unsigned char* p1) {
    const bf16x4 a = *(const bf16x4*)p0, b = *(const bf16x4*)p1;
    return __builtin_shufflevector(a, b, 0, 1, 2, 3, 4, 5, 6, 7);
}
DI bf16x8 packf(const f32x4 a, const f32x4 b) {
    u32x4 w; w.x = pk2(a[0], a[1]); w.y = pk2(a[2], a[3]); w.z = pk2(b[0], b[1]); w.w = pk2(b[2], b[3]);
    return __builtin_bit_cast(bf16x8, w);
}
DI u32x2 pack4(const f32x4 a) { u32x2 w; w.x = pk2(a[0], a[1]); w.y = pk2(a[2], a[3]); return w; }

#define LAS __attribute__((address_space(3)))
#define XB_TMO      128
#define XB_XCNT(j)  (256  + 64 * (j))
#define XB_XSUB(j)  (1280 + 64 * (j))
#define XB_XGEN(j)  (2304 + 64 * (j))
#define XB_TOP      3328
#define XB_TOPGEN   3392
#define XCD_BAR_WORDS 3456
#define XB_SPIN_CAP (1u << 18)

__device__ __forceinline__ unsigned xb_ld(unsigned* p)              { return __hip_atomic_load(p, __ATOMIC_RELAXED, __HIP_MEMORY_SCOPE_AGENT); }
__device__ __forceinline__ unsigned xb_add(unsigned* p, unsigned v) { return __hip_atomic_fetch_add(p, v, __ATOMIC_RELAXED, __HIP_MEMORY_SCOPE_AGENT); }
__device__ __forceinline__ unsigned xb_xcc_id() { return (unsigned)__builtin_amdgcn_s_getreg((3 << 11) | 20) & 0xFu; }
#define XB_SPIN(cond, bar) do { unsigned _sp = 0; while (cond) { __builtin_amdgcn_s_sleep(1); \
    if ((++_sp & 255u) == 0u) { if (xb_ld(&(bar)[XB_TMO])) break; if (_sp > XB_SPIN_CAP) { atomicAdd(&(bar)[XB_TMO], 1u); break; } } } } while (0)

struct XcdBarrier {
    unsigned* bar; unsigned x;
    volatile LAS unsigned* st;
};

__device__ __forceinline__ XcdBarrier xcd_barrier_post(unsigned* bar, volatile LAS unsigned* st) {
    XcdBarrier b; b.bar = bar; b.x = xb_xcc_id(); b.st = st;
    if (threadIdx.x == 0) (void)xb_add(&bar[XB_XCNT(b.x)], 1u);
    return b;
}
__device__ __forceinline__ void xcd_barrier_complete(unsigned* bar, unsigned x, unsigned& nloc, unsigned& nx) {
    const unsigned G = gridDim.x * gridDim.y * gridDim.z;
    unsigned sum, cnt, mine, sp = 0u;
    for (;;) {
        sum = 0u; cnt = 0u; mine = 0u;
#pragma unroll
        for (unsigned j = 0; j < 16; ++j) { const unsigned c = xb_ld(&bar[XB_XCNT(j)]); sum += c; cnt += (c > 0u) ? 1u : 0u; mine = (j == x) ? c : mine; }
        if (sum == G) break;
        __builtin_amdgcn_s_sleep(1);
        if ((++sp & 255u) == 0u) { if (xb_ld(&bar[XB_TMO])) break; if (sp > XB_SPIN_CAP) { atomicAdd(&bar[XB_TMO], 1u); break; } }
    }
    nloc = mine > 0u ? mine : 1u; nx = cnt > 0u ? cnt : 1u;
}

__device__ __forceinline__ void xcd_barrier(const XcdBarrier& b) {
    asm volatile("s_waitcnt vmcnt(0)" ::: "memory");
    __syncthreads();
    if (threadIdx.x == 0) {
        unsigned* bar = b.bar;
        __builtin_amdgcn_s_waitcnt(0);
        unsigned nloc = b.st[0], nx = b.st[1];
        if (nloc == 0u) { xcd_barrier_complete(bar, b.x, nloc, nx); b.st[0] = nloc; b.st[1] = nx; }
        const unsigned old = xb_add(&bar[XB_XSUB(b.x)], 1u);
        const unsigned gen = old / nloc;
        if (old + 1u == (gen + 1u) * nloc) {
            __builtin_amdgcn_fence(__ATOMIC_RELEASE, "agent");
            asm volatile("s_waitcnt vmcnt(0)" ::: "memory");
            const unsigned og = xb_add(&bar[XB_TOP], 1u);
            const unsigned tg = og / nx;
            if (og + 1u == (tg + 1u) * nx) xb_add(&bar[XB_TOPGEN], 1u);
            else XB_SPIN(xb_ld(&bar[XB_TOPGEN]) == tg, bar);
            __builtin_amdgcn_fence(__ATOMIC_ACQUIRE, "agent");
            xb_add(&bar[XB_XGEN(b.x)], 1u);
            asm volatile("s_waitcnt vmcnt(0)" ::: "memory");
        } else {
            XB_SPIN(xb_ld(&bar[XB_XGEN(b.x)]) == gen, bar);
            __builtin_amdgcn_fence(__ATOMIC_ACQUIRE, "agent");
            asm volatile("s_waitcnt vmcnt(0)" ::: "memory");
        }
    }
    __syncthreads();
}

__constant__ float INV_A[64] = {1.000000000e+00f, 8.659643531e-01f, 7.498942614e-01f, 6.493816376e-01f, 5.623413324e-01f, 4.869675338e-01f, 4.216965139e-01f, 3.651741147e-01f, 3.162277639e-01f, 2.738419771e-01f, 2.371373773e-01f, 2.053525001e-01f, 1.778279394e-01f, 1.539926529e-01f, 1.333521307e-01f, 1.154782027e-01f, 1.000000015e-01f, 8.659642935e-02f, 7.498941571e-02f, 6.493816525e-02f, 5.623413250e-02f, 4.869675264e-02f, 4.216965288e-02f, 3.651741147e-02f, 3.162277490e-02f, 2.738419734e-02f, 2.371373773e-02f, 2.053525113e-02f, 1.778279431e-02f, 1.539926510e-02f, 1.333521493e-02f, 1.154782064e-02f, 9.999999776e-03f, 8.659643121e-03f, 7.498941850e-03f, 6.493816152e-03f, 5.623413250e-03f, 4.869675264e-03f, 4.216964822e-03f, 3.651741194e-03f, 3.162277630e-03f, 2.738419687e-03f, 2.371373586e-03f, 2.053524833e-03f, 1.778279431e-03f, 1.539926510e-03f, 1.333521446e-03f, 1.154781901e-03f, 1.000000047e-03f, 8.659643354e-04f, 7.498942432e-04f, 6.493816618e-04f, 5.623413017e-04f, 4.869675322e-04f, 4.216965172e-04f, 3.651741426e-04f, 3.162277571e-04f, 2.738419571e-04f, 2.371373703e-04f, 2.053525095e-04f, 1.778279402e-04f, 1.539926452e-04f, 1.333521504e-04f, 1.154782003e-04f};
__constant__ float INV_I[32] = {1.000000000e+00f, 7.498942614e-01f, 5.623413324e-01f, 4.216965139e-01f, 3.162277639e-01f, 2.371373773e-01f, 1.778279394e-01f, 1.333521307e-01f, 1.000000015e-01f, 7.498941571e-02f, 5.623413250e-02f, 4.216965288e-02f, 3.162277490e-02f, 2.371373773e-02f, 1.778279431e-02f, 1.333521493e-02f, 9.999999776e-03f, 7.498941850e-03f, 5.623413250e-03f, 4.216964822e-03f, 3.162277630e-03f, 2.371373586e-03f, 1.778279431e-03f, 1.333521446e-03f, 1.000000047e-03f, 7.498942432e-04f, 5.623413017e-04f, 4.216965172e-04f, 3.162277571e-04f, 2.371373703e-04f, 1.778279402e-04f, 1.333521504e-04f};
struct Params {
    const float* x; const float* norm_g; const float* w_in; const float* gate_b; const float* conv_w; const float* a_log; const float* dt_bias;
    const float* dn_onorm; const float* pool_w; const float* pool_scale; const float* q_norm; const float* k_norm; const float* w_branch; const float* w_out;
    float* out; unsigned char* ws;
    int ph_lo, ph_hi;
};

DI int next_unit(unsigned* ctr, unsigned char* lds) {
    volatile int* slot = (volatile int*)(lds + LDS_SLOT);
    __syncthreads();
    if (threadIdx.x == 0) *slot = (int)atomicAdd(ctr, 1u);
    __syncthreads();
    return *slot;
}

DI int src_col(int mode, int n) {
    if (mode == 0) {
        if (n < 2048) return n;
        if (n < 5440) return n + 8;
        if (n < 5444) return 2048 + (n - 5440);
        if (n < 5448) return 2052 + (n - 5444);
        if (n < 5452) return n;
        return -1;
    }
    if (mode == 1) return 5452 + n;
    return n;
}
DI void transpose_item(const float* W, int ldw, int K, bf16_t* WT, int mode, float* scr, int item, int nblk, int lane) {
    const int kb = item / nblk, nb = item % nblk, k0 = 64 * kb, n0 = 32 * nb;
    const int sc = src_col(mode, n0 + (lane & 31));
    const int scc = sc < 0 ? 0 : sc;
    float tv[32];
#pragma unroll
    for (int i = 0; i < 32; ++i) { const int kk = 2 * i + (lane >> 5); tv[i] = W[(size_t)(k0 + kk) * ldw + scc]; }
    __builtin_amdgcn_sched_barrier(0);
#pragma unroll
    for (int i = 0; i < 32; ++i) { const int kk = 2 * i + (lane >> 5); scr[kk * 33 + (lane & 31)] = (sc >= 0) ? tv[i] : 0.f; }
    asm volatile("s_waitcnt lgkmcnt(0)" ::: "memory");
    const int c = lane & 7;
#pragma unroll
    for (int j = 0; j < 4; ++j) { const int n = (lane >> 3) + 8 * j; const float* s = scr + (8 * c) * 33 + n;
        u32x4 o; o.x = pk2(s[0 * 33], s[1 * 33]); o.y = pk2(s[2 * 33], s[3 * 33]); o.z = pk2(s[4 * 33], s[5 * 33]); o.w = pk2(s[6 * 33], s[7 * 33]);
        *(u32x4*)(WT + (size_t)(n0 + n) * K + k0 + 8 * c) = o; }
    asm volatile("s_waitcnt lgkmcnt(0)" ::: "memory");
}
DI void rms_row(const float* xrow, const float* g, bf16_t* orow, int lane) {
    const f32x4* xr = (const f32x4*)xrow + lane; const f32x4* gr = (const f32x4*)g + lane;
    f32x4 v[4]; float s = 0.f;
#pragma unroll
    for (int j = 0; j < 4; ++j) { v[j] = xr[64 * j]; s += (v[j].x * v[j].x + v[j].y * v[j].y) + (v[j].z * v[j].z + v[j].w * v[j].w); }
    const float rstd = 1.0f / sqrtf(wave_sum(s) * (1.0f / DM) + NORM_EPS);
    u32x2* o8 = (u32x2*)orow + lane;
#pragma unroll
    for (int j = 0; j < 4; ++j) { const f32x4 gg = gr[64 * j]; u32x2 w; w.x = pk2(v[j].x * rstd * gg.x, v[j].y * rstd * gg.y); w.y = pk2(v[j].z * rstd * gg.z, v[j].w * rstd * gg.w); o8[64 * j] = w; }
}
template <int NR> DI void rms_rows(const float* xrow, const float* g, bf16_t* orow, int lane) {
    const f32x4* xr = (const f32x4*)xrow + lane; const f32x4* gr = (const f32x4*)g + lane;
    f32x4 v[NR][4], gg[4];
#pragma unroll
    for (int r = 0; r < NR; ++r)
#pragma unroll
        for (int j = 0; j < 4; ++j) v[r][j] = xr[r * (DM / 4) + 64 * j];
#pragma unroll
    for (int j = 0; j < 4; ++j) gg[j] = gr[64 * j];
    __builtin_amdgcn_sched_barrier(0);
    float s[NR];
#pragma unroll
    for (int r = 0; r < NR; ++r) { s[r] = 0.f;
#pragma unroll
        for (int j = 0; j < 4; ++j) s[r] += (v[r][j].x * v[r][j].x + v[r][j].y * v[r][j].y) + (v[r][j].z * v[r][j].z + v[r][j].w * v[r][j].w); }
#pragma unroll
    for (int r = 0; r < NR; ++r) s[r] = wave_sum(s[r]);
#pragma unroll
    for (int r = 0; r < NR; ++r) { const float rstd = __builtin_amdgcn_rsqf(s[r] * (1.0f / DM) + NORM_EPS);
        u32x2* o8 = (u32x2*)(orow + r * DM) + lane;
#pragma unroll
        for (int j = 0; j < 4; ++j) { u32x2 w; w.x = pk2(v[r][j].x * rstd * gg[j].x, v[r][j].y * rstd * gg[j].y); w.y = pk2(v[r][j].z * rstd * gg[j].z, v[r][j].w * rstd * gg[j].w); o8[64 * j] = w; } }
}
DI void rms_row2(const float* xrow, const float* g, bf16_t* orow, int lane) { rms_rows<2>(xrow, g, orow, lane); }
DI void phase0(const Params& p, int layer, const float* xin, unsigned char* lds) {
    int tid_ = threadIdx.x; asm volatile("" : "+v"(tid_)); const int tid = tid_, lane = tid & 63, wave = tid >> 6;
    const int gw = blockIdx.x * NWAVE + wave, NGW = gridDim.x * NWAVE;
    float* scr = (float*)(lds + wave * 8704);
    unsigned char* ws = p.ws;
    const float* win = p.w_in + (size_t)layer * DM * INW;
    const float* wbr = p.w_branch + (size_t)layer * 3 * 512 * 1024;
    const float* wo = p.w_out + (size_t)layer * 1024 * 1024;
    const float* pw = p.pool_w + (size_t)layer * 4 * 128 * 128;
    constexpr int I_1 = 16 * (N1 / 32), I_G = 16 * (NG / 32), I_B = 8 * 32, I_O = 16 * 32, I_P = 2 * 4;
    constexpr int NITEMS = I_1 + I_G + 3 * I_B + I_O + 4 * I_P;
    for (int it = gw; it < NITEMS; it += NGW) {
        int r = it;
        if (r < I_1) { transpose_item(win, INW, 1024, (bf16_t*)(ws + WS_WIN1), 0, scr, r, N1 / 32, lane); continue; } r -= I_1;
        if (r < I_G) { transpose_item(win, INW, 1024, (bf16_t*)(ws + WS_WG), 1, scr, r, NG / 32, lane); continue; } r -= I_G;
        if (r < 3 * I_B) { const int br = r / I_B; transpose_item(wbr + (size_t)br * 512 * 1024, 1024, 512, (bf16_t*)(ws + WS_WBR) + (size_t)br * 1024 * 512, 2, scr, r % I_B, 32, lane); continue; } r -= 3 * I_B;
        if (r < I_O) { transpose_item(wo, 1024, 1024, (bf16_t*)(ws + WS_WO), 2, scr, r, 32, lane); continue; } r -= I_O;
        { const int g = r / I_P; transpose_item(pw + (size_t)g * 128 * 128, 128, 128, (bf16_t*)(ws + WS_POOLW) + (size_t)g * 128 * 128, 2, scr, r % I_P, 4, lane); }
    }
    const float* ng = p.norm_g + layer * DM;
    for (int m = 4 * gw; m < MTOK; m += 4 * NGW) rms_rows<4>(xin + (size_t)m * DM, ng, (bf16_t*)(ws + WS_H) + (size_t)m * DM, lane);
    if (layer == 0) {
        const int gt = blockIdx.x * NTHR + tid, NGT = gridDim.x * NTHR;
        for (int i = gt; i < SEQ * 96; i += NGT) {
            const int t = i / 96, j = i % 96;
            const float inv = (j < 64) ? INV_A[j] : INV_I[j - 64];
            const float ang = (float)t * inv;
            double rev = (double)ang * 0.15915494309189535; rev -= floor(rev);
            const float rf = (float)rev;
            const float c = __builtin_amdgcn_cosf(rf), s = __builtin_amdgcn_sinf(rf);
            if (j < 64) { ((float*)(ws + WS_COSA))[t * 64 + j] = c; ((float*)(ws + WS_SINA))[t * 64 + j] = s; }
            else { ((float*)(ws + WS_COSI))[t * 32 + (j - 64)] = c; ((float*)(ws + WS_SINI))[t * 32 + (j - 64)] = s; }
        }
    }
}

constexpr int DP_Q = 0, DP_K = 17408, DP_KBT = 34816, DP_VT = 53248, DP_KDT = 71680, DP_L = 90112, DP_TF = 106752, DP_T = 123392, DP_GC = 132608, DP_BETA = 132864, DP_P = 133120;
constexpr int QP = 272;
constexpr int TP = 144;
DI void dn_prep_unit(const Params& p, int layer, int unit, unsigned char* lds) {
    int tid_ = threadIdx.x; asm volatile("" : "+v"(tid_)); const int tid = tid_, lane = tid & 63, wave = tid >> 6, fr = lane & 15, fq = lane >> 4;
    const int c = unit & 31, h = (unit >> 5) & 3, b = unit >> 7;
    unsigned char* ws = p.ws;
    const size_t tok0 = (size_t)b * SEQ + (size_t)c * 64;
    float* sGc = (float*)(lds + DP_GC); float* sBeta = (float*)(lds + DP_BETA);
    float* sL = (float*)(lds + DP_L); float* sTf = (float*)(lds + DP_TF);
    unsigned char* su = ws + WS_SCAN + (size_t)unit * SCAN_UNIT_BYTES;
    const bf16_t* aq = (const bf16_t*)(ws + WS_AQKV);
    const float* cw = p.conv_w + (size_t)layer * 4 * 1536;
    const int tl0 = 8 * wave;
        float raA[3][11], rbA[3][11], w0A[3][4], w1A[3][4];
#pragma unroll
        for (int part = 0; part < 3; ++part) {
            const int ch0 = part * 512 + h * 128 + lane, ch1 = ch0 + 64;
#pragma unroll
            for (int j = 0; j < 4; ++j) { w0A[part][j] = cw[j * 1536 + ch0]; w1A[part][j] = cw[j * 1536 + ch1]; }
#pragma unroll
            for (int j = 0; j < 11; ++j) { const int tg = c * 64 + tl0 - 3 + j;
                const int tgc = tg < 0 ? 0 : tg; const bf16_t* rp = aq + ((size_t)b * SEQ + tgc) * 1536;
                const float va = bf2f(rp[ch0]), vb = bf2f(rp[ch1]); raA[part][j] = tg >= 0 ? va : 0.f; rbA[part][j] = tg >= 0 ? vb : 0.f; }
        }
    if (wave == 0) {
        const float* mp = (const float*)(ws + WS_MISC) + (tok0 + lane) * 16;
        const float ba = mp[h], aa = mp[4 + h];
        const float al = p.a_log[layer * 4 + h], dtb = p.dt_bias[layer * 4 + h];
        const float xx = aa + dtb;
        const float sp = fmaxf(xx, 0.f) + log1pf(__expf(-fabsf(xx)));
        float g = -__expf(al) * sp;
        float cs = g;
#pragma unroll
        for (int o = 1; o < 64; o <<= 1) { const float n = __shfl_up(cs, o); if (lane >= o) cs += n; }
        sGc[lane] = cs; sBeta[lane] = sigmf(ba);
    }
    __syncthreads();
    const float gl = sGc[63];
    {
        __builtin_amdgcn_sched_barrier(0);
#pragma unroll
        for (int part = 0; part < 3; ++part) {
            const float (&ra)[11] = raA[part]; const float (&rb)[11] = rbA[part]; const float (&w0)[4] = w0A[part]; const float (&w1)[4] = w1A[part];
            float yav[8], ybv[8];
#pragma unroll
            for (int i = 0; i < 8; ++i) {
                yav[i] = siluf(w0[0] * ra[i] + w0[1] * ra[i + 1] + w0[2] * ra[i + 2] + w0[3] * ra[i + 3]);
                ybv[i] = siluf(w1[0] * rb[i] + w1[1] * rb[i + 1] + w1[2] * rb[i + 2] + w1[3] * rb[i + 3]);
            }
            float rnv[8];
            if (part < 2) {
#pragma unroll
                for (int i = 0; i < 8; ++i) rnv[i] = yav[i] * yav[i] + ybv[i] * ybv[i];
#pragma unroll
                for (int i = 0; i < 8; ++i) rnv[i] = 1.0f / sqrtf(wave_sum(rnv[i]) + NORM_EPS);
            }
#pragma unroll
            for (int i = 0; i < 8; ++i) {
                const int tl = tl0 + i;
                float ya = yav[i], yb = ybv[i];
                const float beta = sBeta[tl], gct = sGc[tl];
                if (part < 2) {
                    const float rn = rnv[i];
                    ya *= rn; yb *= rn;
                    if (part == 0) {
                        *(bf16_t*)(lds + DP_Q + tl * QP + lane * 2) = (bf16_t)f2bf(ya); *(bf16_t*)(lds + DP_Q + tl * QP + (lane + 64) * 2) = (bf16_t)f2bf(yb);
                    } else {
                        *(bf16_t*)(lds + DP_K + tl * QP + lane * 2) = (bf16_t)f2bf(ya); *(bf16_t*)(lds + DP_K + tl * QP + (lane + 64) * 2) = (bf16_t)f2bf(yb);
                        const float s1 = beta * __expf(gct), s2 = __expf(gl - gct);
                        *(bf16_t*)(lds + DP_KBT + lane * TP + tl * 2) = (bf16_t)f2bf(ya * s1); *(bf16_t*)(lds + DP_KBT + (lane + 64) * TP + tl * 2) = (bf16_t)f2bf(yb * s1);
                        *(bf16_t*)(lds + DP_KDT + lane * TP + tl * 2) = (bf16_t)f2bf(ya * s2); *(bf16_t*)(lds + DP_KDT + (lane + 64) * TP + tl * 2) = (bf16_t)f2bf(yb * s2);
                    }
                } else {
                    *(bf16_t*)(lds + DP_VT + lane * TP + tl * 2) = (bf16_t)f2bf(ya * beta); *(bf16_t*)(lds + DP_VT + (lane + 64) * TP + tl * 2) = (bf16_t)f2bf(yb * beta);
                }
            }
        }
    }
    __syncthreads();
#pragma unroll 1
    for (int i4 = 0; i4 < 4; ++i4) {
        const int id = wave + 8 * i4;
        if (id < 16) {
            const int mt = id >> 2, nt = id & 3;
            f32x4 acc = {0.f, 0.f, 0.f, 0.f};
            if (nt <= mt) {
#pragma unroll
                for (int s = 0; s < 4; ++s) acc = mfma16(ld16(lds + DP_K + (16 * mt + fr) * QP + (32 * s + 8 * fq) * 2), ld16(lds + DP_K + (16 * nt + fr) * QP + (32 * s + 8 * fq) * 2), acc);
            }
            const int j = 16 * nt + fr; const float gj = sGc[j];
#pragma unroll
            for (int jj = 0; jj < 4; ++jj) { const int i = 16 * mt + 4 * fq + jj;
                float v = 0.f; if (j < i) v = sBeta[i] * acc[jj] * __expf(sGc[i] - gj);
                sL[i * 65 + j] = v; }
        } else {
            const int mt = (id - 16) >> 2, nt = (id - 16) & 3;
            f32x4 acc = {0.f, 0.f, 0.f, 0.f};
            if (nt <= mt) {
#pragma unroll
                for (int s = 0; s < 4; ++s) acc = mfma16(ld16(lds + DP_K + (16 * nt + fr) * QP + (32 * s + 8 * fq) * 2), ld16(lds + DP_Q + (16 * mt + fr) * QP + (32 * s + 8 * fq) * 2), acc);
            }
            const int i = 16 * mt + fr; const float gi = sGc[i];
            f32x4 o;
#pragma unroll
            for (int jj = 0; jj < 4; ++jj) { const int j = 16 * nt + 4 * fq + jj;
                float v = 0.f; if (j <= i) v = acc[jj] * 0.08838834764831845f * __expf(gi - sGc[j]);
                o[jj] = v; }
            *(u32x2*)(su + SU_A + (i * 64 + 16 * nt + 4 * fq) * 2) = pack4(o);
        }
    }
    __syncthreads();
    float* sP = (float*)(lds + DP_P);
    if (wave < 4) {
        const int o = 16 * wave;
        for (int e = lane; e < 16 * 64; e += 64) { const int i = e >> 6, cc = e & 63; if (cc >= o + 16) sTf[(o + i) * 65 + cc] = 0.f; }
        if (lane < 16) {
            float lv[120];
#pragma unroll
            for (int i = 1; i < 16; ++i)
#pragma unroll
                for (int j = 0; j < i; ++j) lv[i * (i - 1) / 2 + j] = sL[(o + i) * 65 + o + j];
            float tc[16];
#pragma unroll
            for (int i = 0; i < 16; ++i) {
                float acc = (i == lane) ? 1.f : 0.f;
#pragma unroll
                for (int j = 0; j < i; ++j) acc -= lv[i * (i - 1) / 2 + j] * tc[j];
                tc[i] = acc;
            }
#pragma unroll
            for (int i = 0; i < 16; ++i) sTf[(o + i) * 65 + o + lane] = tc[i];
        }
    } else {
        for (int ch = tid - 256; ch < 1024; ch += 256) {
            const int row = ch >> 4, c8 = (ch & 15) * 8;
            const u32x4 q = *(const u32x4*)(lds + DP_Q + row * QP + c8 * 2);
            const float sc = __expf(sGc[row]) * 0.08838834764831845f;
            u32x4 o; o.x = pk2(lo_f(q.x) * sc, hi_f(q.x) * sc); o.y = pk2(lo_f(q.y) * sc, hi_f(q.y) * sc); o.z = pk2(lo_f(q.z) * sc, hi_f(q.z) * sc); o.w = pk2(lo_f(q.w) * sc, hi_f(q.w) * sc);
            *(u32x4*)(su + SU_QG + (row * 128 + c8) * 2) = o;
        }
        for (int ch = tid - 256; ch < 1024; ch += 256) {
            const int row = ch >> 3, c8 = (ch & 7) * 8;
            *(u32x4*)(su + SU_KDT + (row * 64 + c8) * 2) = *(const u32x4*)(lds + DP_KDT + row * TP + c8 * 2);
        }
        if (tid == 256) ((float*)(ws + WS_DEC))[unit] = __expf(gl);
    }
    __syncthreads();
#pragma unroll 1
    for (int I = 1; I < 4; ++I) {
        for (int e = tid; e < I * 256; e += NTHR) { const int J = e >> 8, r = (e >> 4) & 15, cc = e & 15;
            float acc = 0.f;
            for (int K = J; K < I; ++K) {
#pragma unroll
                for (int k2 = 0; k2 < 16; ++k2) acc += sL[(16 * I + r) * 65 + 16 * K + k2] * sTf[(16 * K + k2) * 65 + 16 * J + cc];
            }
            sP[r * 65 + 16 * J + cc] = acc; }
        __syncthreads();
        for (int e = tid; e < I * 256; e += NTHR) { const int J = e >> 8, r = (e >> 4) & 15, cc = e & 15;
            float acc = 0.f;
#pragma unroll
            for (int kk = 0; kk < 16; ++kk) acc += sTf[(16 * I + r) * 65 + 16 * I + kk] * sP[kk * 65 + 16 * J + cc];
            sTf[(16 * I + r) * 65 + 16 * J + cc] = -acc; }
        __syncthreads();
    }
    for (int e = tid; e < 4096; e += NTHR) { const int i = e >> 6, j = e & 63; *(bf16_t*)(lds + DP_T + i * TP + j * 2) = (bf16_t)f2bf(sTf[i * 65 + j]); }
    __syncthreads();
#pragma unroll 1
    for (int i8 = 0; i8 < 8; ++i8) {
        const int id = wave + 8 * i8;
        if (id < 32) {
            const int mt = id >> 3, nt = id & 7;
            f32x4 acc = {0.f, 0.f, 0.f, 0.f};
#pragma unroll
            for (int s = 0; s < 2; ++s) acc = mfma16(ld16(lds + DP_T + (16 * mt + fr) * TP + (32 * s + 8 * fq) * 2), ld16(lds + DP_VT + (16 * nt + fr) * TP + (32 * s + 8 * fq) * 2), acc);
            *(u32x2*)(su + SU_UT + ((16 * nt + fr) * 64 + 16 * mt + 4 * fq) * 2) = pack4(acc);
        } else {
            const int mt = (id - 32) >> 3, nt = (id - 32) & 7;
            f32x4 acc = {0.f, 0.f, 0.f, 0.f};
#pragma unroll
            for (int s = 0; s < 2; ++s) acc = mfma16(ld16(lds + DP_KBT + (16 * nt + fr) * TP + (32 * s + 8 * fq) * 2), ld16(lds + DP_T + (16 * mt + fr) * TP + (32 * s + 8 * fq) * 2), acc);
            *(u32x2*)(su + SU_W + ((16 * mt + fr) * 128 + 16 * nt + 4 * fq) * 2) = pack4(acc);
        }
    }
}

constexpr int PL_U = 0, PL_P = 40960;
DI void pool_unit(const Params& p, int layer, int unit, unsigned char* lds) {
    int tid_ = threadIdx.x; asm volatile("" : "+v"(tid_)); const int tid = tid_, lane = tid & 63, wave = tid >> 6, fr = lane & 15, fq = lane >> 4;
    const int g = unit & 3, tt = (unit >> 2) & 31, b = unit >> 7;
    unsigned char* ws = p.ws;
    const int t0 = tt * 64, win = 2 << g;
    float* sU = (float*)(lds + PL_U);
    const bf16_t* bu = (const bf16_t*)(ws + WS_BU);
    const bf16_t* pw = (const bf16_t*)(ws + WS_POOLW) + (size_t)g * 128 * 128;
    const int mt = wave & 3, nh = wave >> 2;
    const float* psc = p.pool_scale + layer * 512 + g * 128;
    bf16_t* bz = (bf16_t*)(ws + WS_BZ);
    bf16x8 bw[4][4]; u32x2 zz[4]; f32x4 scv[4];
#pragma unroll
        for (int n4 = 0; n4 < 4; ++n4) { const int nt = nh * 4 + n4;
#pragma unroll
            for (int s = 0; s < 4; ++s) bw[n4][s] = *(const bf16x8*)(pw + (16 * nt + fr) * 128 + 32 * s + 8 * fq);
            const int d0 = 16 * nt + 4 * fq;
            zz[n4] = *(const u32x2*)(bz + ((size_t)b * SEQ + t0 + 16 * mt + fr) * 512 + g * 128 + d0); scv[n4] = *(const f32x4*)(psc + d0); }
    {
        float pv[20];
#pragma unroll
        for (int k = 0; k < 20; ++k) { const int e = tid + k * NTHR; const int r = e >> 7, cc = e & 127; const int t = t0 - 15 + r;
            const int tc = t < 0 ? 0 : (t > SEQ - 1 ? SEQ - 1 : t);
            const float v = bf2f(bu[((size_t)b * SEQ + tc) * 512 + g * 128 + cc]); pv[k] = (t >= 0) ? v : 0.f; }
        __builtin_amdgcn_sched_barrier(0);
#pragma unroll
        for (int k = 0; k < 20; ++k) { const int e = tid + k * NTHR; if (e < 79 * 128) sU[e] = pv[k]; }
    }
    __syncthreads();
    for (int e = tid; e < 64 * 128; e += NTHR) { const int tl = e >> 7, cc = e & 127; const int t = t0 + tl;
        const int cnt = (t + 1 < win) ? (t + 1) : win;
        float s = 0.f;
#pragma unroll
        for (int i = 0; i < 16; ++i) { const float v = sU[(tl + 15 - i) * 128 + cc]; s += (i < cnt) ? v : 0.f; }
        const float pv = s / (float)cnt - sU[(tl + 15) * 128 + cc];
        *(bf16_t*)(lds + PL_P + tl * QP + cc * 2) = (bf16_t)f2bf(pv); }
    __syncthreads();
    {
        __builtin_amdgcn_sched_barrier(0);
#pragma unroll
        for (int n4 = 0; n4 < 4; ++n4) {
            const int nt = nh * 4 + n4;
            f32x4 acc = {0.f, 0.f, 0.f, 0.f};
#pragma unroll
            for (int s = 0; s < 4; ++s) acc = mfma16(bw[n4][s], ld16(lds + PL_P + (16 * mt + fr) * QP + (32 * s + 8 * fq) * 2), acc);
            const int d0 = 16 * nt + 4 * fq; bf16_t* zp = bz + ((size_t)b * SEQ + t0 + 16 * mt + fr) * 512 + g * 128 + d0;
            f32x4 o; o[0] = acc[0] * scv[n4][0] * siluf(lo_f(zz[n4].x)); o[1] = acc[1] * scv[n4][1] * siluf(hi_f(zz[n4].x)); o[2] = acc[2] * scv[n4][2] * siluf(lo_f(zz[n4].y)); o[3] = acc[3] * scv[n4][3] * siluf(hi_f(zz[n4].y));
            *(u32x2*)zp = pack4(o);
        }
    }
}

DI void sa_prep_unit(const Params& p, int layer, int unit, unsigned char* lds) {
    int tid_ = threadIdx.x; asm volatile("" : "+v"(tid_)); const int tid = tid_, lane = tid & 63, wave = tid >> 6;
    unsigned char* ws = p.ws;
    bf16_t* cq = (bf16_t*)(ws + WS_CQKV);
    const float* cosA = (const float*)(ws + WS_COSA); const float* sinA = (const float*)(ws + WS_SINA);
    const float gq0 = p.q_norm[layer * 128 + lane], gq1 = p.q_norm[layer * 128 + lane + 64];
    const float gk0 = p.k_norm[layer * 128 + lane], gk1 = p.k_norm[layer * 128 + lane + 64];
#pragma unroll 1
    for (int i0 = 0; i0 < 64; i0 += 16) {
        float x1[16], x2[16], cs[16], sn[16]; bf16_t* rp[16];
#pragma unroll
        for (int k = 0; k < 16; ++k) {
            const int rid = wave * 64 + i0 + k;
            const int tl = rid >> 3, qk = (rid >> 2) & 1, hh = rid & 3;
            const size_t tok = (size_t)unit * 64 + tl; const int t = (int)(tok & (SEQ - 1));
            rp[k] = cq + tok * 1536 + qk * 512 + hh * 128;
            x1[k] = bf2f(rp[k][lane]); x2[k] = bf2f(rp[k][lane + 64]);
            cs[k] = cosA[t * 64 + lane]; sn[k] = sinA[t * 64 + lane];
        }
        __builtin_amdgcn_sched_barrier(0);
        float ss[16];
#pragma unroll
        for (int k = 0; k < 16; ++k) ss[k] = x1[k] * x1[k] + x2[k] * x2[k];
#pragma unroll
        for (int k = 0; k < 16; ++k) ss[k] = wave_sum(ss[k]);
#pragma unroll
        for (int k = 0; k < 16; ++k) {
            const int qk = ((i0 + k) >> 2) & 1;
            const float rstd = 1.0f / sqrtf(ss[k] * (1.0f / 128.0f) + NORM_EPS);
            const float y1 = x1[k] * rstd * (qk ? gk0 : gq0), y2 = x2[k] * rstd * (qk ? gk1 : gq1);
            rp[k][lane] = (bf16_t)f2bf(y1 * cs[k] - y2 * sn[k]); rp[k][lane + 64] = (bf16_t)f2bf(y2 * cs[k] + y1 * sn[k]);
        }
    }
}

constexpr int IX_K = 0;
DI unsigned sortable(float f) { const unsigned u = __float_as_uint(f + 0.0f); return u ^ ((u >> 31) ? 0xffffffffu : 0x80000000u); }
DI void indexer_unit(const Params& p, int unit, unsigned char* lds) {
    int tid_ = threadIdx.x; asm volatile("" : "+v"(tid_)); const int tid = tid_, lane = tid & 63, wave = tid >> 6, fr = lane & 15, fq = lane >> 4;
    const int b = unit & 7, qb = 63 - (unit >> 3);
    unsigned char* ws = p.ws;
    const int t0 = qb * 32, tw = t0 + 4 * wave;
    const int tq = tw + fq;
    unsigned* mask = (unsigned*)(ws + WS_MASK) + ((size_t)b * SEQ + tq) * 64;
    if (t0 < 256) {
#pragma unroll
        for (int k = 0; k < 4; ++k) { const int wd = 16 * k + fr; const int lo = 32 * wd;
            unsigned m = 0u; if (tq >= lo + 31) m = 0xffffffffu; else if (tq >= lo) m = (2u << (tq - lo)) - 1u;
            mask[wd] = m; }
        return;
    }
    const bf16_t* cidx = (const bf16_t*)(ws + WS_CIDX);
    const float* cosI = (const float*)(ws + WS_COSI); const float* sinI = (const float*)(ws + WS_SINI);
    bf16x8 a0, a1;
    {
        const int ql = fr >> 2, hh = fr & 3; const int t = tw + ql;
        const bf16_t* qp = cidx + ((size_t)b * SEQ + t) * 320 + hh * 64;
        const u32x4 x1 = *(const u32x4*)(qp + 8 * fq), x2 = *(const u32x4*)(qp + 32 + 8 * fq);
        const f32x4 c0 = *(const f32x4*)(cosI + t * 32 + 8 * fq), c1 = *(const f32x4*)(cosI + t * 32 + 8 * fq + 4);
        const f32x4 s0 = *(const f32x4*)(sinI + t * 32 + 8 * fq), s1 = *(const f32x4*)(sinI + t * 32 + 8 * fq + 4);
        const float xa[8] = {lo_f(x1.x), hi_f(x1.x), lo_f(x1.y), hi_f(x1.y), lo_f(x1.z), hi_f(x1.z), lo_f(x1.w), hi_f(x1.w)};
        const float xb[8] = {lo_f(x2.x), hi_f(x2.x), lo_f(x2.y), hi_f(x2.y), lo_f(x2.z), hi_f(x2.z), lo_f(x2.w), hi_f(x2.w)};
        const float cc[8] = {c0[0], c0[1], c0[2], c0[3], c1[0], c1[1], c1[2], c1[3]};
        const float sn[8] = {s0[0], s0[1], s0[2], s0[3], s1[0], s1[1], s1[2], s1[3]};
        u32x4 w0, w1;
        w0.x = pk2(xa[0] * cc[0] - xb[0] * sn[0], xa[1] * cc[1] - xb[1] * sn[1]); w0.y = pk2(xa[2] * cc[2] - xb[2] * sn[2], xa[3] * cc[3] - xb[3] * sn[3]);
        w0.z = pk2(xa[4] * cc[4] - xb[4] * sn[4], xa[5] * cc[5] - xb[5] * sn[5]); w0.w = pk2(xa[6] * cc[6] - xb[6] * sn[6], xa[7] * cc[7] - xb[7] * sn[7]);
        w1.x = pk2(xb[0] * cc[0] + xa[0] * sn[0], xb[1] * cc[1] + xa[1] * sn[1]); w1.y = pk2(xb[2] * cc[2] + xa[2] * sn[2], xb[3] * cc[3] + xa[3] * sn[3]);
        w1.z = pk2(xb[4] * cc[4] + xa[4] * sn[4], xb[5] * cc[5] + xa[5] * sn[5]); w1.w = pk2(xb[6] * cc[6] + xa[6] * sn[6], xb[7] * cc[7] + xa[7] * sn[7]);
        a0 = __builtin_bit_cast(bf16x8, w0); a1 = __builtin_bit_cast(bf16x8, w1);
    }
    float wi[4];
    { const float* mp = (const float*)(ws + WS_MISC) + ((size_t)b * SEQ + tq) * 16 + 8;
#pragma unroll
      for (int j = 0; j < 4; ++j) wi[j] = mp[j] * 0.0625f; }
    unsigned sc[128];
    const int tmax = t0 + 31;
    const int skey = tid >> 1, hf = tid & 1;
    u32x4 xa0, xa1, xb0, xb1; f32x4 cv[4], sv[4];
#define IDX_LOAD(r) do { const int t_ = (r) * 256 + skey; const bf16_t* kp_ = cidx + ((size_t)b * SEQ + t_) * 320 + 256; \
        xa0 = *(const u32x4*)(kp_ + 16 * hf); xa1 = *(const u32x4*)(kp_ + 16 * hf + 8); xb0 = *(const u32x4*)(kp_ + 32 + 16 * hf); xb1 = *(const u32x4*)(kp_ + 32 + 16 * hf + 8); \
        _Pragma("unroll") for (int q = 0; q < 4; ++q) { cv[q] = *(const f32x4*)(cosI + t_ * 32 + 16 * hf + 4 * q); sv[q] = *(const f32x4*)(sinI + t_ * 32 + 16 * hf + 4 * q); } } while (0)
    IDX_LOAD(0);
#pragma unroll
    for (int r = 0; r < 8; ++r) {
        if (r * 256 <= tmax) {
            __syncthreads();
            {
                const unsigned xa[8] = {xa0.x, xa0.y, xa0.z, xa0.w, xa1.x, xa1.y, xa1.z, xa1.w};
                const unsigned xb[8] = {xb0.x, xb0.y, xb0.z, xb0.w, xb1.x, xb1.y, xb1.z, xb1.w};
                unsigned o1[8], o2[8];
#pragma unroll
                for (int q = 0; q < 8; ++q) {
                    const float c0 = cv[q >> 1][2 * (q & 1)], c1 = cv[q >> 1][2 * (q & 1) + 1], s0 = sv[q >> 1][2 * (q & 1)], s1 = sv[q >> 1][2 * (q & 1) + 1];
                    const float a_lo = lo_f(xa[q]), a_hi = hi_f(xa[q]), b_lo = lo_f(xb[q]), b_hi = hi_f(xb[q]);
                    o1[q] = pk2(a_lo * c0 - b_lo * s0, a_hi * c1 - b_hi * s1);
                    o2[q] = pk2(b_lo * c0 + a_lo * s0, b_hi * c1 + a_hi * s1);
                }
                u32x4 v; unsigned char* dp = lds + IX_K + skey * TP;
                v.x = o1[0]; v.y = o1[1]; v.z = o1[2]; v.w = o1[3]; *(u32x4*)(dp + (16 * hf) * 2) = v;
                v.x = o1[4]; v.y = o1[5]; v.z = o1[6]; v.w = o1[7]; *(u32x4*)(dp + (16 * hf + 8) * 2) = v;
                v.x = o2[0]; v.y = o2[1]; v.z = o2[2]; v.w = o2[3]; *(u32x4*)(dp + (32 + 16 * hf) * 2) = v;
                v.x = o2[4]; v.y = o2[5]; v.z = o2[6]; v.w = o2[7]; *(u32x4*)(dp + (32 + 16 * hf + 8) * 2) = v;
            }
            __syncthreads();
            if ((r + 1) * 256 <= tmax) IDX_LOAD(r + 1);
            __builtin_amdgcn_sched_barrier(0);
#pragma unroll
            for (int tt = 0; tt < 16; ++tt) {
                const int i = r * 16 + tt;
                const unsigned char* kp = lds + IX_K + (16 * tt + fr) * TP + (8 * fq) * 2;
                f32x4 acc = {0.f, 0.f, 0.f, 0.f};
                acc = mfma16(a0, ld16(kp), acc);
                acc = mfma16(a1, ld16(kp + 64), acc);
                const float s = wi[0] * fmaxf(acc[0], 0.f) + wi[1] * fmaxf(acc[1], 0.f) + wi[2] * fmaxf(acc[2], 0.f) + wi[3] * fmaxf(acc[3], 0.f);
                const int key = 16 * i + fr;
                sc[i] = (key <= tq) ? sortable(s) : 0u;
            }
        } else {
#pragma unroll
            for (int tt = 0; tt < 16; ++tt) sc[r * 16 + tt] = 0u;
        }
    }
#undef IDX_LOAD
    const int ngrp = (tmax >> 8) + 1;
    unsigned thr = 0u; bool fin = false;
#pragma unroll 1
    for (int bit = 31; bit >= 0; --bit) {
        const unsigned cand = thr | (1u << bit);
        int cnt = 0;
#pragma unroll
        for (int g = 0; g < 8; ++g) if (g < ngrp) {
            bool pr[16];
#pragma unroll
            for (int tt = 0; tt < 16; ++tt) pr[tt] = sc[g * 16 + tt] >= cand;
            __builtin_amdgcn_sched_barrier(0);
#pragma unroll
            for (int tt = 0; tt < 16; ++tt) cnt += pr[tt] ? 1 : 0;
            __builtin_amdgcn_sched_barrier(0);
        }
        cnt = row16_sumi(cnt);
        if (!fin && cnt >= 256) { thr = cand; fin = (cnt == 256); }
        if (__ballot(!fin) == 0ull) break;
    }
    int ngt = 0;
#pragma unroll
    for (int g = 0; g < 8; ++g) if (g < ngrp) {
        bool pr[16];
#pragma unroll
        for (int tt = 0; tt < 16; ++tt) pr[tt] = sc[g * 16 + tt] > thr;
        __builtin_amdgcn_sched_barrier(0);
#pragma unroll
        for (int tt = 0; tt < 16; ++tt) ngt += pr[tt] ? 1 : 0;
        __builtin_amdgcn_sched_barrier(0);
    }
    ngt = row16_sumi(ngt);
    const int need = 256 - ngt;
    int run = 0;
    unsigned w4[4] = {0u, 0u, 0u, 0u};
    const unsigned lowmask = (1u << fr) - 1u;
#pragma unroll
    for (int g = 0; g < 8; ++g) if (g < ngrp) {
#pragma unroll
        for (int tt = 0; tt < 16; ++tt) {
            const int i = g * 16 + tt;
            const bool eq = (sc[i] == thr);
            const unsigned long long be = __ballot(eq);
            const unsigned eqrow = (unsigned)(be >> (16 * fq)) & 0xffffu;
            const int rank = run + __popc(eqrow & lowmask);
            const bool sel = (sc[i] > thr) || (eq && rank < need);
            run += __popc(eqrow);
            const unsigned long long bs = __ballot(sel);
            const unsigned selrow = (unsigned)(bs >> (16 * fq)) & 0xffffu;
            if (fr == ((i >> 1) & 15)) w4[i >> 5] |= selrow << (16 * (i & 1));
        }
    }
#pragma unroll
    for (int k = 0; k < 4; ++k) mask[16 * k + fr] = w4[k];
}

constexpr int SB_W = 0, SB_QG = 17408, SB_KDT = 34816, SB_A = 53248, SB_BYTES = 62464, SB_RED = 2 * 62464;
DI void scan_unit(const Params& p, int layer, int unit, unsigned char* lds) {
    int tid_ = threadIdx.x; asm volatile("" : "+v"(tid_)); const int tid = tid_, lane = tid & 63, wave = tid >> 6, fr = lane & 15, fq = lane >> 4;
    const int h = unit & 3, b = unit >> 2;
    unsigned char* ws = p.ws;
    const unsigned char* su0 = ws + WS_SCAN + (size_t)((b * 4 + h) * 32) * SCAN_UNIT_BYTES;
    const float decv = ((const float*)(ws + WS_DEC))[(b * 4 + h) * 32 + (lane & 31)];
    bf16_t* az = (bf16_t*)(ws + WS_AZ);
    float* red = (float*)(lds + SB_RED);
    const int dvc = h * 128 + 16 * wave + fr;
    const float onw = p.dn_onorm[layer * 128 + 16 * wave + fr];
    const int r16 = tid >> 4, c16 = tid & 15, r8 = tid >> 3, c8 = tid & 7;
    const int c16s = c16 ^ (((r16 >> 4) & 1) << 2), c8s = c8 ^ (((r8 >> 4) & 1) << 2);
    const int prow = 8 * (fr >> 2) + (fr & 3);
    const int swz = ((fr >> 3) & 1) << 2;
    u32x4 pw0, pw1, pq0, pq1, pk0, pk1, pa0; u32x2 pu[4];
#define SCAN_PREFETCH(cc) do { const unsigned char* su = su0 + (size_t)(cc) * SCAN_UNIT_BYTES; \
        pw0 = *(const u32x4*)(su + SU_W + tid * 16); pw1 = *(const u32x4*)(su + SU_W + 8192 + tid * 16); \
        pq0 = *(const u32x4*)(su + SU_QG + tid * 16); pq1 = *(const u32x4*)(su + SU_QG + 8192 + tid * 16); \
        pk0 = *(const u32x4*)(su + SU_KDT + tid * 16); pk1 = *(const u32x4*)(su + SU_KDT + 8192 + tid * 16); \
        pa0 = *(const u32x4*)(su + SU_A + tid * 16); \
        _Pragma("unroll") for (int mt = 0; mt < 4; ++mt) pu[mt] = *(const u32x2*)(su + SU_UT + ((16 * wave + fr) * 64 + 32 * (mt >> 1) + 8 * fq + 4 * (mt & 1)) * 2); \
        } while (0)
#define SCAN_STORE(bufp) do { unsigned char* bp = (bufp); \
        *(u32x4*)(bp + SB_W + r16 * QP + c16s * 16) = pw0; *(u32x4*)(bp + SB_W + (r16 + 32) * QP + c16s * 16) = pw1; \
        *(u32x4*)(bp + SB_QG + r16 * QP + c16s * 16) = pq0; *(u32x4*)(bp + SB_QG + (r16 + 32) * QP + c16s * 16) = pq1; \
        *(u32x4*)(bp + SB_KDT + r8 * TP + c8s * 16) = pk0; *(u32x4*)(bp + SB_KDT + (r8 + 64) * TP + c8s * 16) = pk1; \
        *(u32x4*)(bp + SB_A + r8 * TP + c8s * 16) = pa0; } while (0)
    f32x4 st[8];
#pragma unroll
    for (int m = 0; m < 8; ++m) st[m] = (f32x4){0.f, 0.f, 0.f, 0.f};
    SCAN_PREFETCH(0);
    SCAN_STORE(lds);
    u32x2 cu[4];
#pragma unroll
    for (int i = 0; i < 4; ++i) cu[i] = pu[i];
    __syncthreads();
    SCAN_PREFETCH(1);
#pragma unroll 1
    for (int c = 0; c < 32; ++c) {
        const int cur = c & 1;
        const unsigned char* bp = lds + cur * SB_BYTES;
        const float dg = __builtin_bit_cast(float, __builtin_amdgcn_readlane(__builtin_bit_cast(int, decv), c));
        bf16_t cz[16];
#pragma unroll
        for (int mt = 0; mt < 4; ++mt)
#pragma unroll
            for (int jj = 0; jj < 4; ++jj) cz[mt * 4 + jj] = az[((size_t)b * SEQ + c * 64 + 32 * (mt >> 1) + 8 * fq + 4 * (mt & 1) + jj) * 512 + dvc];
        bf16x8 sb[4];
#pragma unroll
        for (int s = 0; s < 4; ++s) sb[s] = packf(st[2 * s], st[2 * s + 1]);
        bf16x8 fw[4][4];
#pragma unroll
        for (int mt = 0; mt < 4; ++mt)
#pragma unroll
            for (int s = 0; s < 4; ++s) fw[mt][s] = ld16(bp + SB_W + (32 * (mt >> 1) + 4 * (mt & 1) + prow) * QP + (((4 * s) ^ swz) + fq) * 16);
        __builtin_amdgcn_sched_barrier(0);
        f32x4 vn[4];
#pragma unroll
        for (int mt = 0; mt < 4; ++mt) vn[mt] = (f32x4){0.f, 0.f, 0.f, 0.f};
#pragma unroll
        for (int s = 0; s < 4; ++s)
#pragma unroll
            for (int mt = 0; mt < 4; ++mt) vn[mt] = mfma16(fw[mt][s], sb[s], vn[mt]);
        __builtin_amdgcn_sched_barrier(0);
#pragma unroll
        for (int mt = 0; mt < 4; ++mt)
#pragma unroll
            for (int s = 0; s < 4; ++s) fw[mt][s] = ld16(bp + SB_QG + (32 * (mt >> 1) + 4 * (mt & 1) + prow) * QP + (((4 * s) ^ swz) + fq) * 16);
#pragma unroll
        for (int mt = 0; mt < 4; ++mt) {
            vn[mt][0] = lo_f(cu[mt].x) - vn[mt][0]; vn[mt][1] = hi_f(cu[mt].x) - vn[mt][1]; vn[mt][2] = lo_f(cu[mt].y) - vn[mt][2]; vn[mt][3] = hi_f(cu[mt].y) - vn[mt][3];
        }
        bf16x8 vb[2];
#pragma unroll
        for (int s2 = 0; s2 < 2; ++s2) vb[s2] = packf(vn[2 * s2], vn[2 * s2 + 1]);
        __builtin_amdgcn_sched_barrier(0);
        f32x4 o[4];
#pragma unroll
        for (int mt = 0; mt < 4; ++mt) o[mt] = (f32x4){0.f, 0.f, 0.f, 0.f};
#pragma unroll
        for (int s = 0; s < 4; ++s)
#pragma unroll
            for (int mt = 0; mt < 4; ++mt) o[mt] = mfma16(fw[mt][s], sb[s], o[mt]);
        __builtin_amdgcn_sched_barrier(0);
#pragma unroll
        for (int mt = 0; mt < 4; ++mt)
#pragma unroll
            for (int s2 = 0; s2 < 2; ++s2) fw[mt][s2] = ld16(bp + SB_A + (32 * (mt >> 1) + 4 * (mt & 1) + prow) * TP + (((4 * s2) ^ swz) + fq) * 16);
        __builtin_amdgcn_sched_barrier(0);
#pragma unroll
        for (int s2 = 0; s2 < 2; ++s2)
#pragma unroll
            for (int mt = 0; mt < 4; ++mt) o[mt] = mfma16(fw[mt][s2], vb[s2], o[mt]);
        __builtin_amdgcn_sched_barrier(0);
#pragma unroll
        for (int m = 0; m < 8; ++m)
#pragma unroll
            for (int s2 = 0; s2 < 2; ++s2) fw[m >> 1][(m & 1) * 2 + s2] = ld16(bp + SB_KDT + (32 * (m >> 1) + 4 * (m & 1) + prow) * TP + (((4 * s2) ^ swz) + fq) * 16);
#pragma unroll
        for (int m = 0; m < 8; ++m) st[m] = st[m] * dg;
        __builtin_amdgcn_sched_barrier(0);
#pragma unroll
        for (int s2 = 0; s2 < 2; ++s2)
#pragma unroll
            for (int m = 0; m < 8; ++m) st[m] = mfma16(fw[m >> 1][(m & 1) * 2 + s2], vb[s2], st[m]);
        __builtin_amdgcn_sched_barrier(0);
        {
            f32x4 sq[4];
#pragma unroll
            for (int mt = 0; mt < 4; ++mt)
#pragma unroll
                for (int jj = 0; jj < 4; ++jj) sq[mt][jj] = row16_sum(o[mt][jj] * o[mt][jj]);
            if (fr == 0) {
#pragma unroll
                for (int mt = 0; mt < 4; ++mt) *(f32x4*)(red + (cur * 8 + wave) * 64 + 32 * (mt >> 1) + 8 * fq + 4 * (mt & 1)) = sq[mt];
            }
        }
        if (c + 1 < 32) SCAN_STORE(lds + (cur ^ 1) * SB_BYTES);
        __syncthreads();
        u32x2 nu[4];
#pragma unroll
        for (int i = 0; i < 4; ++i) nu[i] = pu[i];
        if (c + 2 < 32) SCAN_PREFETCH(c + 2);
#pragma unroll
        for (int mt = 0; mt < 4; ++mt)
#pragma unroll
            for (int jj = 0; jj < 4; ++jj) {
                const int row = 32 * (mt >> 1) + 8 * fq + 4 * (mt & 1) + jj;
                float tot = 0.f;
#pragma unroll
                for (int w8 = 0; w8 < 8; ++w8) tot += red[(cur * 8 + w8) * 64 + row];
                const float rstd = __builtin_amdgcn_rsqf(tot * (1.0f / 128.0f) + NORM_EPS);
                const float zv = bf2f(cz[mt * 4 + jj]);
                const float y = o[mt][jj] * rstd * onw * zv * __builtin_amdgcn_rcpf(1.0f + __expf(-zv));
                az[((size_t)b * SEQ + c * 64 + row) * 512 + dvc] = (bf16_t)f2bf(y);
            }
#pragma unroll
        for (int i = 0; i < 4; ++i) cu[i] = nu[i];
    }
#undef SCAN_PREFETCH
#undef SCAN_STORE
}

constexpr int AT_K = 0, AT_VT = 17408;
DI void attn_unit(const Params& p, int unit, unsigned char* lds) {
    int tid_ = threadIdx.x; asm volatile("" : "+v"(tid_)); const int tid = tid_, lane = tid & 63, wave = tid >> 6, fr = lane & 15, fq = lane >> 4;
    const int qb = 15 - (unit >> 5), bh = unit & 31, b = bh >> 2, hh = bh & 3;
    unsigned char* ws = p.ws;
    const bf16_t* cq = (const bf16_t*)(ws + WS_CQKV);
    const int q0 = qb * 128, tq = q0 + 16 * wave + fr;
    const size_t tokq = (size_t)b * SEQ + tq;
    const unsigned* mrow = (const unsigned*)(ws + WS_MASK) + tokq * 64;
    bf16x8 qf[4];
#pragma unroll
    for (int s = 0; s < 4; ++s) qf[s] = *(const bf16x8*)(cq + tokq * 1536 + hh * 128 + 32 * s + 8 * fq);
    f32x4 oacc[8];
#pragma unroll
    for (int i = 0; i < 8; ++i) oacc[i] = (f32x4){0.f, 0.f, 0.f, 0.f};
    float mrun = -INFINITY, lrun = 0.f;
    const int nkt = (q0 + 128) / 64;
    const int kr = tid >> 4, kc = tid & 15, vk = 2 * (tid & 31), vp = tid >> 5;
    const int kcs = kc ^ (((kr >> 4) & 1) << 2);
    const int prow = 8 * (fr >> 2) + (fr & 3), swz = ((fr >> 3) & 1) << 2;
    u32x4 gk0, gk1, gv0, gv1;
#define ATT_PREFETCH(kt) do { const size_t kb = (size_t)b * SEQ + (size_t)(kt) * 64; \
        gk0 = *(const u32x4*)(cq + (kb + kr) * 1536 + 512 + hh * 128 + kc * 8); gk1 = *(const u32x4*)(cq + (kb + kr + 32) * 1536 + 512 + hh * 128 + kc * 8); \
        gv0 = *(const u32x4*)(cq + (kb + vk) * 1536 + 1024 + hh * 128 + vp * 8); gv1 = *(const u32x4*)(cq + (kb + vk + 1) * 1536 + 1024 + hh * 128 + vp * 8); } while (0)
    ATT_PREFETCH(0);
    const float scl = 0.08838834764831845f * 1.4426950408889634f;
#pragma unroll 1
    for (int kt = 0; kt < nkt; ++kt) {
        __syncthreads();
        *(u32x4*)(lds + AT_K + kr * QP + kcs * 16) = gk0; *(u32x4*)(lds + AT_K + (kr + 32) * QP + kcs * 16) = gk1;
        {
            const unsigned a[4] = {gv0.x, gv0.y, gv0.z, gv0.w}, c4[4] = {gv1.x, gv1.y, gv1.z, gv1.w};
#pragma unroll
            for (int e = 0; e < 4; ++e) {
                *(unsigned*)(lds + AT_VT + (8 * vp + 2 * e) * TP + vk * 2) = (a[e] & 0xffffu) | (c4[e] << 16);
                *(unsigned*)(lds + AT_VT + (8 * vp + 2 * e + 1) * TP + vk * 2) = (a[e] >> 16) | (c4[e] & 0xffff0000u);
            }
        }
        const u32x2 mw = *(const u32x2*)(mrow + 2 * kt);
        __syncthreads();
        if (kt + 1 < nkt) ATT_PREFETCH(kt + 1);
        bf16x8 kf[4][4];
#pragma unroll
        for (int nt = 0; nt < 4; ++nt)
#pragma unroll
            for (int s = 0; s < 4; ++s) kf[nt][s] = ld16(lds + AT_K + (32 * (nt >> 1) + 4 * (nt & 1) + prow) * QP + (((4 * s) ^ swz) + fq) * 16);
        __builtin_amdgcn_sched_barrier(0);
        f32x4 sacc[4];
#pragma unroll
        for (int nt = 0; nt < 4; ++nt) sacc[nt] = (f32x4){0.f, 0.f, 0.f, 0.f};
#pragma unroll
        for (int s = 0; s < 4; ++s)
#pragma unroll
            for (int nt = 0; nt < 4; ++nt) sacc[nt] = mfma16(kf[nt][s], qf[s], sacc[nt]);
        __builtin_amdgcn_sched_barrier(0);
#pragma unroll
        for (int nd = 0; nd < 8; ++nd)
#pragma unroll
            for (int s2 = 0; s2 < 2; ++s2) kf[nd >> 1][(nd & 1) * 2 + s2] = ld16(lds + AT_VT + (16 * nd + fr) * TP + (32 * s2 + 8 * fq) * 2);
        float mx = -INFINITY;
#pragma unroll
        for (int nt = 0; nt < 4; ++nt)
#pragma unroll
            for (int jj = 0; jj < 4; ++jj) { const int kk = 32 * (nt >> 1) + 8 * fq + 4 * (nt & 1) + jj; const unsigned wsel = (nt < 2) ? mw.x : mw.y;
                const bool on = (wsel >> (kk & 31)) & 1u;
                const float v = on ? sacc[nt][jj] * scl : -INFINITY; sacc[nt][jj] = v; mx = fmaxf(mx, v); }
        mx = fmaxf(mx, __shfl_xor(mx, 16)); mx = fmaxf(mx, __shfl_xor(mx, 32));
        const float mnew = fmaxf(mrun, mx);
        const float msafe = (mnew == -INFINITY) ? 0.f : mnew;
        const float alpha = __builtin_amdgcn_exp2f(mrun - msafe);
        mrun = mnew;
        float ps = 0.f;
#pragma unroll
        for (int nt = 0; nt < 4; ++nt)
#pragma unroll
            for (int jj = 0; jj < 4; ++jj) { const float pv = __builtin_amdgcn_exp2f(sacc[nt][jj] - msafe); sacc[nt][jj] = pv; ps += pv; }
        lrun = lrun * alpha + ps;
        bf16x8 pb[2];
#pragma unroll
        for (int s2 = 0; s2 < 2; ++s2) pb[s2] = packf(sacc[2 * s2], sacc[2 * s2 + 1]);
#pragma unroll
        for (int nd = 0; nd < 8; ++nd) oacc[nd] = oacc[nd] * alpha;
        __builtin_amdgcn_sched_barrier(0);
#pragma unroll
        for (int s2 = 0; s2 < 2; ++s2)
#pragma unroll
            for (int nd = 0; nd < 8; ++nd) oacc[nd] = mfma16(kf[nd >> 1][(nd & 1) * 2 + s2], pb[s2], oacc[nd]);
        __builtin_amdgcn_sched_barrier(0);
    }
#undef ATT_PREFETCH
    lrun += __shfl_xor(lrun, 16); lrun += __shfl_xor(lrun, 32);
    const float inv = 1.0f / lrun;
    bf16_t* czp = (bf16_t*)(ws + WS_CZ) + tokq * 512 + hh * 128;
#pragma unroll
    for (int nd = 0; nd < 8; ++nd) {
        bf16_t* zp = czp + 16 * nd + 4 * fq;
        const u32x2 zz = *(const u32x2*)zp;
        f32x4 o; o[0] = oacc[nd][0] * inv * siluf(lo_f(zz.x)); o[1] = oacc[nd][1] * inv * siluf(hi_f(zz.x)); o[2] = oacc[nd][2] * inv * siluf(lo_f(zz.y)); o[3] = oacc[nd][3] * inv * siluf(hi_f(zz.y));
        *(u32x2*)zp = pack4(o);
    }
}

DI void rms_unit(const Params& p, int layer, const float* xin, int unit) {
    int tid_ = threadIdx.x; asm volatile("" : "+v"(tid_)); const int lane = tid_ & 63, wave = tid_ >> 6;
    const float* ng = p.norm_g + layer * DM;
    for (int i = 0; i < 8; i += 4) { const size_t m = (size_t)unit * 64 + wave * 8 + i; rms_rows<4>(xin + m * DM, ng, (bf16_t*)(p.ws + WS_H2) + m * DM, lane); }
}

#ifndef GEMM_ALIGN
#define GEMM_ALIGN true
#endif
#ifndef GEMM_SP2
#define GEMM_SP2 true
#endif
#ifndef MK_SPLIT
#define MK_SPLIT 0
#endif
constexpr int NPHASE = 14;
constexpr int P2_IDX = 512, P2_DN = 1024, P2_POOL = 1024, P2_SA = 256, P2_TOTAL = P2_IDX + P2_DN + P2_POOL + P2_SA;
constexpr int P3_SCAN = 32, P3_ATT = 512, P3_RMS = 256, P3_TOTAL = P3_SCAN + P3_ATT + P3_RMS;

__global__ void __launch_bounds__(NTHR, 2) hybrid_fwd(Params p) {
    extern __shared__ __attribute__((aligned(16))) unsigned char lds[];
    unsigned char* ws = p.ws;
    unsigned* ctl = (unsigned*)(ws + WS_CTL);
    const int G = gridDim.x;
    PG8_LAS unsigned char* glds = (PG8_LAS unsigned char*)lds;
#if MK_SPLIT
#define SEAM(k) do { } while (0)
#else
    cg::grid_group grid = cg::this_grid();
    volatile LAS unsigned* bst = (volatile LAS unsigned*)((LAS unsigned char*)lds + LDS_SLOT + 16);
    if (threadIdx.x == 0) { bst[0] = 0u; bst[1] = 0u; }
    __syncthreads();
    XcdBarrier bar = xcd_barrier_post(ctl + 1024, bst);
#define SEAM(k) do { if (p.ph_lo <= (k) && (k) + 1 < p.ph_hi) { if (p.ph_hi > NPHASE) grid.sync(); else xcd_barrier(bar); } } while (0)
#endif
#define IN(k) (p.ph_lo <= (k) && (k) < p.ph_hi)
#ifdef PROBE_K
#ifndef PROBE_BLK
#define PROBE_BLK 0
#endif
#ifndef PROBE_T1
#define PROBE_T1 (PROBE_K + 1)
#endif
#define stamps ((unsigned long long*)(p.ws + WS_CTL + 24576))
#define STAMP(k) do { int t_ = threadIdx.x; asm volatile("" : "+v"(t_)); if (blockIdx.x == 0 && t_ == 0) stamps[(k)] = __builtin_amdgcn_s_memrealtime(); } while (0)
    STAMP(0);
#else
#define STAMP(k) do { } while (0)
#endif
#pragma unroll 1
    for (int layer = 0; layer < 2; ++layer) {
        const int pb = layer * 7;
        const float* xin = layer == 0 ? p.x : (const float*)p.out;
        if (IN(pb + 0)) {
#ifndef NO_P0
 phase0(p, layer, xin, lds);
#endif
 }
        SEAM(pb + 0); STAMP(pb + 0 + 1);
        if (IN(pb + 1)) {
            pg8::Gemm g{(const bf16_t*)(ws + WS_H), (const bf16_t*)(ws + WS_WIN1), MTOK, N1, 1024}; pg8::StaticOrder S; S.init(MTOK, N1, G, (int)blockIdx.x);
            pg8::EpiProj E{ws};

#ifndef NO_G1
 pg8::gemm_phase<pg8::EpiProj, pg8::StaticOrder, GEMM_ALIGN, GEMM_SP2>(glds, g, S, E);
#endif

        }
        SEAM(pb + 1); STAMP(pb + 1 + 1);
        if (IN(pb + 2)) {
            const int k = (int)blockIdx.x;
            for (int i = k; i < P2_IDX / 2; i += G) { __syncthreads(); indexer_unit(p, i, lds);
#ifdef PROBE_K
                { int t_ = threadIdx.x; asm volatile("" : "+v"(t_)); if (layer == 0 && (int)blockIdx.x == PROBE_BLK && t_ == 0) stamps[24] = __builtin_amdgcn_s_memrealtime(); }
#endif
                __syncthreads(); indexer_unit(p, P2_IDX - 1 - i, lds);
#ifdef PROBE_K
                { int t_ = threadIdx.x; asm volatile("" : "+v"(t_)); if (layer == 0 && (int)blockIdx.x == PROBE_BLK && t_ == 0) stamps[25] = __builtin_amdgcn_s_memrealtime(); }
#endif
            }
#ifdef PROBE_K
            if (layer == 0 && threadIdx.x == 0) atomicMax(&stamps[22], (unsigned long long)__builtin_amdgcn_s_memrealtime());
#endif
            for (int u = k; u < P2_DN; u += G) { __syncthreads(); dn_prep_unit(p, layer, u, lds); }
#ifdef PROBE_K
            if (layer == 0 && threadIdx.x == 0) atomicMax(&stamps[23], (unsigned long long)__builtin_amdgcn_s_memrealtime());
#endif
            for (int u = k; u < P2_SA; u += G) { __syncthreads(); sa_prep_unit(p, layer, u, lds); }
        }
        SEAM(pb + 2); STAMP(pb + 2 + 1);
        if (IN(pb + 3)) {
            const int k = (int)blockIdx.x, nsc = (G > 2 * P3_SCAN) ? P3_SCAN : 0, nb = G - nsc;
            if (k < nsc) {
                scan_unit(p, layer, k, lds);
#ifdef PROBE_K
                { int t_ = threadIdx.x; asm volatile("" : "+v"(t_)); if (layer == 0 && k == 0 && t_ == 0) stamps[20] = __builtin_amdgcn_s_memrealtime(); }
#endif
            } else {
                const int j = k - nsc;
                if (nsc == 0) for (int u = j; u < P3_SCAN; u += nb) { __syncthreads(); scan_unit(p, layer, u, lds); }
                for (int r = 0; r * nb < P3_ATT; ++r) { const int i = r * nb + ((r & 1) ? (nb - 1 - j) : j); if (i < P3_ATT) { __syncthreads(); attn_unit(p, i, lds); } }
#ifdef PROBE_K
                if (layer == 0 && threadIdx.x == 0) atomicMax(&stamps[21], (unsigned long long)__builtin_amdgcn_s_memrealtime());
#endif
                for (int u = j; u < P3_RMS; u += nb) rms_unit(p, layer, xin, u);
                for (int u = j; u < P2_POOL; u += nb) { __syncthreads(); pool_unit(p, layer, u, lds); }
            }
        }
        SEAM(pb + 3); STAMP(pb + 3 + 1);
        if (IN(pb + 4)) {
            pg8::Gemm g{(const bf16_t*)(ws + WS_H2), (const bf16_t*)(ws + WS_WG), MTOK, NG, 1024}; pg8::GateOrder S; S.init(G, (int)blockIdx.x);
            pg8::EpiGate E{ws, p.gate_b + layer * 3072};

#ifndef NO_G4
 pg8::gemm_phase<pg8::EpiGate, pg8::GateOrder, GEMM_ALIGN, GEMM_SP2>(glds, g, S, E);
#endif

        }
        asm volatile("s_waitcnt vmcnt(0)" ::: "memory"); __syncthreads(); STAMP(pb + 4 + 1);
        if (IN(pb + 5)) {
            pg8::Gemm g{(const bf16_t*)(ws + WS_AZ), (const bf16_t*)(ws + WS_WBR), 3 * MTOK, 3072, 512}; pg8::MergeOrder S; S.init(G, (int)blockIdx.x);
            pg8::EpiMerge E{ws};

#ifndef NO_G5
 pg8::gemm_phase<pg8::EpiMerge, pg8::MergeOrder, GEMM_ALIGN, GEMM_SP2>(glds, g, S, E);
#endif

        }
        SEAM(pb + 5); STAMP(pb + 5 + 1);
        if (IN(pb + 6)) {
            pg8::Gemm g{(const bf16_t*)(ws + WS_MERGED), (const bf16_t*)(ws + WS_WO), MTOK, 1024, 1024}; pg8::StaticOrder S; S.init(MTOK, 1024, G, (int)blockIdx.x);
            pg8::EpiOut E{xin, p.out};

#ifndef NO_G6
 pg8::gemm_phase<pg8::EpiOut, pg8::StaticOrder, GEMM_ALIGN, GEMM_SP2>(glds, g, S, E);
#endif

        }
        SEAM(pb + 6); STAMP(pb + 6 + 1);
    }
#ifdef PROBE_K
    __syncthreads();
    if (threadIdx.x == 0) __threadfence();
    xcd_barrier(bar);
    {
        const unsigned long long t0 = __hip_atomic_load(&stamps[PROBE_K], __ATOMIC_RELAXED, __HIP_MEMORY_SCOPE_AGENT), t1 = __hip_atomic_load(&stamps[PROBE_T1], __ATOMIC_RELAXED, __HIP_MEMORY_SCOPE_AGENT);
#ifdef PROBE_A
        const unsigned long long ta = __hip_atomic_load(&stamps[PROBE_A], __ATOMIC_RELAXED, __HIP_MEMORY_SCOPE_AGENT), tb = __hip_atomic_load(&stamps[PROBE_B], __ATOMIC_RELAXED, __HIP_MEMORY_SCOPE_AGENT);
        const float d1 = (float)(ta - t0) * 0.01f, d2 = (float)(tb - t0) * 0.01f * 30.0f;
        for (int i = blockIdx.x * NTHR + threadIdx.x; i < (1 << 20); i += gridDim.x * NTHR) p.out[i] += d1;
        if (blockIdx.x == 0 && threadIdx.x == 0) p.out[(1 << 21) + 12345] += d2;
#else
        const float dlt = (float)(t1 - t0) * 0.01f * 2e-5f;
        for (int i = blockIdx.x * NTHR + threadIdx.x; i < (1 << 20); i += gridDim.x * NTHR) p.out[i] += dlt;
#endif
    }
#endif
#undef IN
#undef SEAM
}

extern "C" void kernel_launch(void* const* d_in, const int* in_sizes, int n_in, void* d_out, int out_size, void* d_ws, size_t ws_size, hipStream_t stream) {
    static int grid = 0;
    if (grid == 0) {
        if (n_in != 14 || in_sizes[0] != MTOK * DM || out_size != MTOK * DM || ws_size < WS_END) { fprintf(stderr, "kernel_launch: unexpected shapes / workspace (%d inputs, ws %zu)\n", n_in, ws_size); grid = -1; return; }
        int dev = 0, cus = 0, per_cu = 0;
        if (hipGetDevice(&dev) != hipSuccess || hipDeviceGetAttribute(&cus, hipDeviceAttributeMultiprocessorCount, dev) != hipSuccess) { grid = -1; return; }
        if (hipFuncSetAttribute((const void*)hybrid_fwd, hipFuncAttributeMaxDynamicSharedMemorySize, LDS_BYTES) != hipSuccess) { fprintf(stderr, "kernel_launch: hipFuncSetAttribute failed\n"); grid = -1; return; }
        if (hipOccupancyMaxActiveBlocksPerMultiprocessor(&per_cu, (const void*)hybrid_fwd, NTHR, LDS_BYTES) != hipSuccess || per_cu < 1) { fprintf(stderr, "kernel_launch: occupancy query says %d\n", per_cu); per_cu = 1; }
        (void)hipGetLastError();
        grid = cus * per_cu;
    }
    if (grid < 0) return;
    (void)hipMemsetAsync((char*)d_ws + WS_CTL, 0, CTL_BYTES, stream);
    Params p{};
    p.x = (const float*)d_in[0]; p.norm_g = (const float*)d_in[1]; p.w_in = (const float*)d_in[2]; p.gate_b = (const float*)d_in[3]; p.conv_w = (const float*)d_in[4];
    p.a_log = (const float*)d_in[5]; p.dt_bias = (const float*)d_in[6]; p.dn_onorm = (const float*)d_in[7]; p.pool_w = (const float*)d_in[8]; p.pool_scale = (const float*)d_in[9];
    p.q_norm = (const float*)d_in[10]; p.k_norm = (const float*)d_in[11]; p.w_branch = (const float*)d_in[12]; p.w_out = (const float*)d_in[13];
    p.out = (float*)d_out; p.ws = (unsigned char*)d_ws;
#if MK_SPLIT
    for (int ph = 0; ph < NPHASE; ++ph) { p.ph_lo = ph; p.ph_hi = ph + 1; hipLaunchKernelGGL(hybrid_fwd, dim3(grid), dim3(NTHR), LDS_BYTES, stream, p); }
#else
    p.ph_lo = 0; p.ph_hi = NPHASE;
    void* args[] = {&p};
    const hipError_t e = hipLaunchCooperativeKernel((const void*)hybrid_fwd, dim3(grid), dim3(NTHR), args, LDS_BYTES, stream);
    if (e != hipSuccess) fprintf(stderr, "kernel_launch: cooperative launch failed: %s (grid %d)\n", hipGetErrorString(e), grid);
#endif
}
```

```cpp
#include <hip/hip_runtime.h>
#include <hip/hip_cooperative_groups.h>
#include <cstdio>
#include <cstdint>
#include <cmath>
namespace cg = cooperative_groups;
constexpr int BATCH = 8, SEQ = 2048, DM = 1024, MTOK = BATCH * SEQ;
constexpr int INW = 8524;
constexpr int N1 = 5632;
constexpr int NG = 3072;
constexpr float NORM_EPS = 1e-6f;
constexpr size_t MiB = 1u << 20;
constexpr size_t WS_CTL = 0;
constexpr size_t CTL_BYTES = 32768;
constexpr size_t WS_COSA = 1 * MiB, WS_SINA = WS_COSA + 512 * 1024;
constexpr size_t WS_COSI = 2 * MiB, WS_SINI = WS_COSI + 256 * 1024;
constexpr size_t WS_DEC = 2 * MiB + 512 * 1024;
constexpr size_t WS_MISC = 3 * MiB;
constexpr size_t WS_WG = 4 * MiB;
constexpr size_t WS_WBR = 10 * MiB;
constexpr size_t WS_WO = 13 * MiB;
constexpr size_t WS_POOLW = 15 * MiB;
constexpr size_t WS_MASK = 16 * MiB;
constexpr size_t WS_R1 = 20 * MiB;
constexpr size_t WS_H = WS_R1;
constexpr size_t WS_WIN1 = WS_R1 + 32 * MiB;
constexpr size_t WS_SCAN = WS_R1;
constexpr size_t WS_G0 = WS_R1, WS_G1 = WS_R1 + 32 * MiB;
constexpr size_t WS_R2 = 93 * MiB;
constexpr size_t WS_AQKV = WS_R2;
constexpr size_t WS_H2 = WS_R2;
constexpr size_t WS_MERGED = WS_G0;
constexpr size_t WS_R3 = 141 * MiB;
constexpr size_t WS_CQKV = WS_R3;
constexpr size_t WS_G2 = WS_R3;
constexpr size_t WS_AZ = 189 * MiB, WS_BZ = 205 * MiB, WS_CZ = 221 * MiB, WS_BU = 237 * MiB;
constexpr size_t WS_CIDX = 253 * MiB;
constexpr size_t WS_END = 263 * MiB;
constexpr int SCAN_UNIT_BYTES = 73728;
constexpr int SU_W = 0, SU_QG = 16384, SU_KDT = 32768, SU_UT = 49152, SU_A = 65536;
namespace pg8 {
#define PG8_LAS __attribute__((address_space(3)))
typedef unsigned short bf16_t;
typedef short bf16x8 __attribute__((ext_vector_type(8)));
typedef float f32x4 __attribute__((ext_vector_type(4)));
typedef unsigned u32x4 __attribute__((ext_vector_type(4)));
constexpr int BM = 256, BK = 64, HALF = 128, HTB = HALF * BK * 2  , STAGE_BYTES = 8 * HTB, NXCD = 8, WGM = 8;

__host__ __device__ __forceinline__ int lds_byte(int r, int c) { const int st = (r >> 4) * 2 + (c >> 5), rr = r & 15, cc = c & 31, ob = rr * 64 + cc * 2; return st * 1024 + (ob ^ (((ob >> 9) & 1) << 5)); }
__host__ __device__ __forceinline__ void stage_rc(int b, int& R, int& C) { const int st = b / 1024, sb = b % 1024, swz = sb ^ (((sb >> 9) & 1) << 5); R = (st >> 1) * 16 + swz / 64; C = (st & 1) * 32 + (swz % 64) / 2; }
__host__ __device__ __forceinline__ int perm32(int rho) { const int n = rho >> 4, i = rho & 15; return 8 * (i >> 2) + 4 * n + (i & 3); }

struct Unit { int pm, pn; };
struct Gemm { const bf16_t* A; const bf16_t* Bt; int M, N, K; };

struct StaticOrder {
    int nM, nN, nwg, G, c;
    __host__ __device__ void init(int M, int N, int G_, int c_) { nM = M / BM; nN = N / BM; nwg = nM * nN; G = G_; c = c_; }
    __host__ __device__ bool next(int i, Unit& u) const {
        const long L = (long)i * G + c; if (L >= nwg) return false;
        int wgid = (int)L; { const int q = nwg / NXCD, r = nwg % NXCD, xcd = wgid % NXCD, off = wgid / NXCD; wgid = (xcd < r ? xcd * (q + 1) : r * (q + 1) + (xcd - r) * q) + off; }
        const int nig = WGM * nN, gid = wgid / nig, fm = gid * WGM, gsz = (nM - fm) < WGM ? (nM - fm) : WGM;
        u.pm = fm + ((wgid % nig) % gsz); u.pn = (wgid % nig) / gsz; return true;
    }
    __device__ __forceinline__ void a_ready(const Unit&) const {}
    __device__ __forceinline__ void done(const Unit&) const {}
};

typedef float f32x2c __attribute__((ext_vector_type(2))); typedef __bf16 bf16x2c __attribute__((ext_vector_type(2)));
__device__ __forceinline__ unsigned cvt_pk_bf16(float lo, float hi) { const f32x2c v = {lo, hi}; return __builtin_bit_cast(unsigned, __builtin_convertvector(v, bf16x2c)); }
struct EpiProj {
    static constexpr bool PERM = true, AFTER_DRAIN = false;
    unsigned char* ws;
    __device__ __forceinline__ void operator()(const f32x4 (&acc)[2][2][4][2], const Unit& u, int wr, int wc, int fr, int fq) const {
        const int pn = u.pn; const int row0 = u.pm * BM + wr * 64 + fr;
        if (pn == 21) {
            const int c = wc * 32 + 8 * fq;
            if (c < 80) {
#pragma unroll
                for (int ai = 0; ai < 2; ++ai)
#pragma unroll
                    for (int m = 0; m < 4; ++m) { const size_t row = (size_t)(row0 + ai * HALF + m * 16); const f32x4 v0 = acc[ai][0][m][0], v1 = acc[ai][0][m][1];
                        if (c < 64) { u32x4 w; w.x = cvt_pk_bf16(v0[0], v0[1]); w.y = cvt_pk_bf16(v0[2], v0[3]); w.z = cvt_pk_bf16(v1[0], v1[1]); w.w = cvt_pk_bf16(v1[2], v1[3]);
                            *(u32x4*)((bf16_t*)(ws + WS_CIDX) + row * 320 + 256 + c) = w; }
                        else { float* mp = (float*)(ws + WS_MISC) + row * 16 + (c - 64); *(f32x4*)mp = v0; *(f32x4*)(mp + 4) = v1; } }
            }
            return;
        }
        size_t off; int ldc, colt;
        if (pn < 6) { off = WS_AQKV; ldc = 1536; colt = pn * 256; }
        else if (pn < 8) { off = WS_AZ; ldc = 512; colt = (pn - 6) * 256; }
        else if (pn < 10) { off = WS_BU; ldc = 512; colt = (pn - 8) * 256; }
        else if (pn < 12) { off = WS_BZ; ldc = 512; colt = (pn - 10) * 256; }
        else if (pn < 18) { off = WS_CQKV; ldc = 1536; colt = (pn - 12) * 256; }
        else if (pn < 20) { off = WS_CZ; ldc = 512; colt = (pn - 18) * 256; }
        else { off = WS_CIDX; ldc = 320; colt = 0; }
        bf16_t* base = (bf16_t*)(ws + off); const int col0 = colt + wc * 32 + 8 * fq;
#pragma unroll
        for (int ai = 0; ai < 2; ++ai)
#pragma unroll
            for (int m = 0; m < 4; ++m) { bf16_t* rowp = base + (size_t)(row0 + ai * HALF + m * 16) * ldc + col0;
#pragma unroll
                for (int bj = 0; bj < 2; ++bj) { const f32x4 v0 = acc[ai][bj][m][0], v1 = acc[ai][bj][m][1];
                    u32x4 w; w.x = cvt_pk_bf16(v0[0], v0[1]); w.y = cvt_pk_bf16(v0[2], v0[3]); w.z = cvt_pk_bf16(v1[0], v1[1]); w.w = cvt_pk_bf16(v1[2], v1[3]);
                    *(u32x4*)(rowp + bj * HALF) = w; } }
    }
};
__device__ __forceinline__ float sigm(float x) { return __builtin_amdgcn_rcpf(1.0f + __expf(-x)); }
struct EpiGate {
    static constexpr bool PERM = true, AFTER_DRAIN = false;
    unsigned char* ws; const float* gb;
    __device__ __forceinline__ void operator()(const f32x4 (&acc)[2][2][4][2], const Unit& u, int wr, int wc, int fr, int fq) const {
        const int pn = u.pn, br = pn >> 2; const int row0 = u.pm * BM + wr * 64 + fr;
        bf16_t* base = (bf16_t*)(ws + (br == 0 ? WS_G0 : (br == 1 ? WS_G1 : WS_G2)));
        const int col0 = (pn & 3) * 256 + wc * 32 + 8 * fq; const float* bp = gb + br * 1024 + col0;
        f32x4 bv[2][2];
#pragma unroll
        for (int bj = 0; bj < 2; ++bj)
#pragma unroll
            for (int n = 0; n < 2; ++n) bv[bj][n] = *(const f32x4*)(bp + bj * HALF + 4 * n);
#pragma unroll
        for (int ai = 0; ai < 2; ++ai)
#pragma unroll
            for (int m = 0; m < 4; ++m) { bf16_t* rowp = base + (size_t)(row0 + ai * HALF + m * 16) * 1024 + col0;
#pragma unroll
                for (int bj = 0; bj < 2; ++bj) { const f32x4 v0 = acc[ai][bj][m][0] + bv[bj][0], v1 = acc[ai][bj][m][1] + bv[bj][1];
                    u32x4 w; w.x = cvt_pk_bf16(sigm(v0[0]), sigm(v0[1])); w.y = cvt_pk_bf16(sigm(v0[2]), sigm(v0[3])); w.z = cvt_pk_bf16(sigm(v1[0]), sigm(v1[1])); w.w = cvt_pk_bf16(sigm(v1[2]), sigm(v1[3]));
                    *(u32x4*)(rowp + bj * HALF) = w; } }
    }
};
__device__ __forceinline__ float bflo(unsigned w) { return __uint_as_float(w << 16); }
__device__ __forceinline__ float bfhi(unsigned w) { return __uint_as_float(w & 0xffff0000u); }
struct GateOrder {
    int G, c;
    __device__ __forceinline__ void init(int G_, int c_) { G = G_; c = c_; }
    __device__ __forceinline__ bool next(int i, Unit& u) const {
        const int t = i / 3, br = i - 3 * t; int L = t * G + c; if (L >= 256) return false;
        if (G == 256) L = (L & 7) * 32 + (L >> 3);
        u.pm = L >> 2; u.pn = br * 4 + (L & 3); return true;
    }
    __device__ __forceinline__ void a_ready(const Unit&) const {}
    __device__ __forceinline__ void done(const Unit&) const {}
};
struct MergeOrder {
    int G, c;
    __device__ __forceinline__ void init(int G_, int c_) { G = G_; c = c_; }
    __device__ __forceinline__ bool next(int i, Unit& u) const {
        const int t = i / 3, br = i - 3 * t; int L = t * G + c; if (L >= 256) return false;
        if (G == 256) L = (L & 7) * 32 + (L >> 3);
        u.pm = br * 64 + (L >> 2); u.pn = br * 4 + (L & 3); return true;
    }
    __device__ __forceinline__ void a_ready(const Unit&) const {}
    __device__ __forceinline__ void done(const Unit&) const {}
};
struct EpiMerge {
    static constexpr bool PERM = true, AFTER_DRAIN = false;
    unsigned char* ws;
    __device__ __forceinline__ void operator()(const f32x4 (&acc)[2][2][4][2], const Unit& u, int wr, int wc, int fr, int fq) const {
        const int br = u.pm >> 6, pm = u.pm & 63, pn = u.pn & 3; const bool first = (br == 0);
        const bf16_t* G = (const bf16_t*)(ws + (br == 0 ? WS_G0 : (br == 1 ? WS_G1 : WS_G2))); bf16_t* mg = (bf16_t*)(ws + WS_MERGED);
        const int row0 = pm * BM + wr * 64 + fr; const int col0 = pn * 256 + wc * 32 + 8 * fq;
#pragma unroll
        for (int ai = 0; ai < 2; ++ai) {
            u32x4 gv[4][2], pv[4][2];
#pragma unroll
            for (int m = 0; m < 4; ++m)
#pragma unroll
                for (int bj = 0; bj < 2; ++bj) { const size_t o = (size_t)(row0 + ai * HALF + m * 16) * 1024 + col0 + bj * HALF;
                    gv[m][bj] = *(const u32x4*)(G + o); pv[m][bj] = first ? (u32x4){0u, 0u, 0u, 0u} : *(const u32x4*)(mg + o); }
            __builtin_amdgcn_sched_barrier(0);
#pragma unroll
            for (int m = 0; m < 4; ++m)
#pragma unroll
                for (int bj = 0; bj < 2; ++bj) { const size_t ro = (size_t)(row0 + ai * HALF + m * 16) * 1024 + col0 + bj * HALF;
                    const f32x4 v0 = acc[ai][bj][m][0], v1 = acc[ai][bj][m][1]; const u32x4 g = gv[m][bj], p = pv[m][bj];
                    u32x4 w;
                    w.x = cvt_pk_bf16(bflo(p.x) + bflo(g.x) * v0[0], bfhi(p.x) + bfhi(g.x) * v0[1]); w.y = cvt_pk_bf16(bflo(p.y) + bflo(g.y) * v0[2], bfhi(p.y) + bfhi(g.y) * v0[3]);
                    w.z = cvt_pk_bf16(bflo(p.z) + bflo(g.z) * v1[0], bfhi(p.z) + bfhi(g.z) * v1[1]); w.w = cvt_pk_bf16(bflo(p.w) + bflo(g.w) * v1[2], bfhi(p.w) + bfhi(g.w) * v1[3]);
                    *(u32x4*)(mg + ro) = w; }
            __builtin_amdgcn_sched_barrier(0);
        }
    }
};
struct EpiOut {
    static constexpr bool PERM = false, AFTER_DRAIN = false;
    const float* xin; float* out;
    __device__ __forceinline__ void operator()(const f32x4 (&acc)[2][2][4][2], const Unit& u, int wr, int wc, int fr, int fq) const {
        const int row0 = u.pm * BM + wr * 64 + fr; const int col0 = u.pn * 256 + wc * 32 + 4 * fq;
#pragma unroll
        for (int ai = 0; ai < 2; ++ai) {
            f32x4 xv[4][2][2];
#pragma unroll
            for (int m = 0; m < 4; ++m)
#pragma unroll
                for (int bj = 0; bj < 2; ++bj)
#pragma unroll
                    for (int n = 0; n < 2; ++n) xv[m][bj][n] = *(const f32x4*)(xin + (size_t)(row0 + ai * HALF + m * 16) * 1024 + col0 + bj * HALF + n * 16);
            __builtin_amdgcn_sched_barrier(0);
#pragma unroll
            for (int m = 0; m < 4; ++m)
#pragma unroll
                for (int bj = 0; bj < 2; ++bj)
#pragma unroll
                    for (int n = 0; n < 2; ++n) *(f32x4*)(out + (size_t)(row0 + ai * HALF + m * 16) * 1024 + col0 + bj * HALF + n * 16) = xv[m][bj][n] + acc[ai][bj][m][n];
            __builtin_amdgcn_sched_barrier(0);
        }
    }
};
template <class Epi, class Sched, bool ALIGN_EPI = false, bool SP2 = false>
__device__ __forceinline__ void gemm_phase(PG8_LAS unsigned char* lds, const Gemm g, const Sched& S, const Epi& E) {
    int tid_ = threadIdx.x; asm volatile("" : "+v"(tid_)); const int tid = tid_, wid = __builtin_amdgcn_readfirstlane(tid >> 6), lane = tid & 63, wr = wid >> 2, wc = wid & 3, fr = lane & 15, fq = lane >> 4;
    const int K = g.K, nt = K / BK;
    unsigned voffA[2], voffB[2];
#pragma unroll
    for (int i = 0; i < 2; ++i) { int R, C; stage_rc(tid * 16 + i * 8192, R, C); const int Rb = Epi::PERM ? ((R & ~31) + perm32(R & 31)) : R;
        voffA[i] = (unsigned)(R * K + C) * 2u; voffB[i] = (unsigned)(Rb * K + C) * 2u; }
    const size_t kstep = (size_t)(BK * 2);
    const size_t hstep = (size_t)HALF * K * 2;
    const size_t tstep = 2 * hstep;
    const unsigned ldsw = (unsigned)wid * 1024u;
    const int aoff = lds_byte(wr * 64 + fr, fq * 8), boff = lds_byte(wc * 32 + fr, fq * 8);
#define PG8_SA(b, h) (((b) * 2 + (h)) * HTB)
#define PG8_SB(b, h) ((4 + (b) * 2 + (h)) * HTB)
#define PG8_STAGE(bufoff, gbase, voff) do { _Pragma("unroll") for (int _i = 0; _i < 2; ++_i) \
        __builtin_amdgcn_global_load_lds((const unsigned*)((const char*)(gbase) + (voff)[_i]), (PG8_LAS unsigned*)(lds + (bufoff) + ldsw + _i * 8192), 16, 0, 0); } while (0)
#define PG8_LDA(dst, b, h) do { _Pragma("unroll") for (int m = 0; m < 4; ++m) _Pragma("unroll") for (int k = 0; k < 2; ++k) dst[m][k] = *(const PG8_LAS bf16x8*)(lds + PG8_SA(b, h) + aoff + m * 2048 + k * 1024); } while (0)
#define PG8_LDB(dst, b, h) do { _Pragma("unroll") for (int n = 0; n < 2; ++n) _Pragma("unroll") for (int k = 0; k < 2; ++k) dst[n][k] = *(const PG8_LAS bf16x8*)(lds + PG8_SB(b, h) + boff + n * 2048 + k * 1024); } while (0)
#define PG8_MMA(ai, bj, At, Bt) do { __builtin_amdgcn_s_setprio(1); _Pragma("unroll") for (int m = 0; m < 4; ++m) _Pragma("unroll") for (int n = 0; n < 2; ++n) _Pragma("unroll") for (int k = 0; k < 2; ++k) \
        acc[ai][bj][m][n] = __builtin_amdgcn_mfma_f32_16x16x32_bf16(Bt[n][k], At[m][k], acc[ai][bj][m][n], 0, 0, 0); __builtin_amdgcn_s_setprio(0); } while (0)
#define PG8_WAIT_V(n) asm volatile("s_waitcnt vmcnt(" #n ")" ::: "memory")
#define PG8_WAIT_L(n) asm volatile("s_waitcnt lgkmcnt(" #n ")" ::: "memory")
#define PG8_BAR __builtin_amdgcn_s_barrier()
#define PG8_SCHED __builtin_amdgcn_sched_barrier(0)
    Unit cur, nxt; int ui = 0;
    if (!S.next(0, cur)) return;
    f32x4 acc[2][2][4][2];
#pragma unroll
    for (int a = 0; a < 2; ++a)
#pragma unroll
        for (int b = 0; b < 2; ++b)
#pragma unroll
            for (int m = 0; m < 4; ++m)
#pragma unroll
                for (int n = 0; n < 2; ++n) acc[a][b][m][n] = (f32x4){0.f, 0.f, 0.f, 0.f};
    bf16x8 At[4][2], B0[2][2], B1[2][2];
    const char* cA = (const char*)g.A + (size_t)cur.pm * tstep; const char* cB = (const char*)g.Bt + (size_t)cur.pn * tstep;
    S.a_ready(cur);
    if constexpr (SP2) {
        PG8_STAGE(PG8_SB(0, 0), cB, voffB); PG8_STAGE(PG8_SB(0, 1), cB + hstep, voffB); PG8_STAGE(PG8_SA(0, 0), cA, voffA); PG8_STAGE(PG8_SA(0, 1), cA + hstep, voffA);
        if (wr == 1) PG8_BAR;
        PG8_WAIT_V(2); PG8_BAR;
        PG8_STAGE(PG8_SB(1, 0), cB + kstep, voffB); PG8_STAGE(PG8_SA(1, 0), cA + kstep, voffA); PG8_STAGE(PG8_SB(1, 1), cB + hstep + kstep, voffB);
        PG8_WAIT_V(6); PG8_BAR;
    } else {
        PG8_STAGE(PG8_SB(0, 0), cB, voffB); PG8_STAGE(PG8_SA(0, 0), cA, voffA); PG8_STAGE(PG8_SB(0, 1), cB + hstep, voffB); PG8_STAGE(PG8_SA(0, 1), cA + hstep, voffA);
        if (wr == 1) PG8_BAR;
        PG8_WAIT_V(4); PG8_BAR;
        PG8_STAGE(PG8_SB(1, 0), cB + kstep, voffB); PG8_STAGE(PG8_SA(1, 0), cA + kstep, voffA); PG8_STAGE(PG8_SB(1, 1), cB + hstep + kstep, voffB);
        PG8_WAIT_V(6); PG8_BAR;
    }
    for (;;) {
        const bool has_next = S.next(ui + 1, nxt);
        const char* nA = has_next ? (const char*)g.A + (size_t)nxt.pm * tstep : cA; const char* nB = has_next ? (const char*)g.Bt + (size_t)nxt.pn * tstep : cB;
        for (int t = 0; t < nt; t += 2) {
            const bool last = (t == nt - 2);
            const char* a1 = cA + (size_t)(t + 1) * kstep;
            const char* a2 = last ? nA : cA + (size_t)(t + 2) * kstep; const char* b2 = last ? nB : cB + (size_t)(t + 2) * kstep;
            const char* a3 = a2 + kstep; const char* b3 = b2 + kstep;
            if (last && has_next) S.a_ready(nxt);
            if constexpr (SP2) {
            PG8_LDB(B0, 0, 0); PG8_LDB(B1, 0, 1); PG8_SCHED; PG8_LDA(At, 0, 0); PG8_STAGE(PG8_SA(1, 1), a1 + hstep, voffA);
            PG8_WAIT_V(8); PG8_WAIT_L(0); PG8_BAR; PG8_MMA(0, 0, At, B0); PG8_MMA(0, 1, At, B1); PG8_BAR; PG8_SCHED;
            PG8_LDA(At, 0, 1); PG8_STAGE(PG8_SB(0, 0), b2, voffB); PG8_STAGE(PG8_SB(0, 1), b2 + hstep, voffB); PG8_STAGE(PG8_SA(0, 0), a2, voffA);
            PG8_WAIT_V(8); PG8_WAIT_L(0); PG8_BAR; PG8_MMA(1, 0, At, B0); PG8_MMA(1, 1, At, B1); PG8_BAR; PG8_SCHED;
            PG8_LDB(B0, 1, 0); PG8_LDB(B1, 1, 1); PG8_SCHED; PG8_LDA(At, 1, 0); PG8_STAGE(PG8_SA(0, 1), a2 + hstep, voffA);
            PG8_WAIT_V(8); PG8_WAIT_L(0); PG8_BAR; PG8_MMA(0, 0, At, B0); PG8_MMA(0, 1, At, B1); PG8_BAR; PG8_SCHED;
            PG8_LDA(At, 1, 1); PG8_STAGE(PG8_SB(1, 0), b3, voffB); PG8_STAGE(PG8_SB(1, 1), b3 + hstep, voffB); PG8_STAGE(PG8_SA(1, 0), a3, voffA);
            PG8_WAIT_V(8); PG8_WAIT_L(0); PG8_BAR; PG8_MMA(1, 0, At, B0); PG8_MMA(1, 1, At, B1); PG8_BAR; PG8_SCHED;
            } else {
            PG8_LDB(B0, 0, 0); PG8_SCHED; PG8_LDA(At, 0, 0); PG8_STAGE(PG8_SA(1, 1), a1 + hstep, voffA);
            PG8_WAIT_L(8); PG8_BAR; PG8_WAIT_L(0); PG8_MMA(0, 0, At, B0); PG8_BAR; PG8_SCHED;
            PG8_LDB(B1, 0, 1); PG8_STAGE(PG8_SB(0, 0), b2, voffB);
            PG8_BAR; PG8_WAIT_L(0); PG8_MMA(0, 1, At, B1); PG8_BAR;
            PG8_LDA(At, 0, 1); PG8_STAGE(PG8_SA(0, 0), a2, voffA);
            PG8_BAR; PG8_WAIT_L(0); PG8_MMA(1, 0, At, B0); PG8_BAR; PG8_SCHED;
            PG8_STAGE(PG8_SB(0, 1), b2 + hstep, voffB);
            PG8_WAIT_V(6); PG8_BAR; PG8_MMA(1, 1, At, B1); PG8_BAR;
            PG8_LDB(B0, 1, 0); PG8_SCHED; PG8_LDA(At, 1, 0); PG8_STAGE(PG8_SA(0, 1), a2 + hstep, voffA);
            PG8_WAIT_L(8); PG8_BAR; PG8_WAIT_L(0); PG8_MMA(0, 0, At, B0); PG8_BAR; PG8_SCHED;
            PG8_LDB(B1, 1, 1); PG8_STAGE(PG8_SB(1, 0), b3, voffB);
            PG8_BAR; PG8_WAIT_L(0); PG8_MMA(0, 1, At, B1); PG8_BAR;
            PG8_LDA(At, 1, 1); PG8_STAGE(PG8_SA(1, 0), a3, voffA);
            PG8_BAR; PG8_WAIT_L(0); PG8_MMA(1, 0, At, B0); PG8_BAR; PG8_SCHED;
            PG8_STAGE(PG8_SB(1, 1), b3 + hstep, voffB);
            PG8_WAIT_V(6); PG8_BAR; PG8_MMA(1, 1, At, B1); PG8_BAR;
            }
        }
        if constexpr (ALIGN_EPI) { if (wr == 0) PG8_BAR; }
        if constexpr (!Epi::AFTER_DRAIN) { E(acc, cur, wr, wc, fr, fq); S.done(cur); }
        if (!has_next) break;
#pragma unroll
        for (int a = 0; a < 2; ++a)
#pragma unroll
            for (int b = 0; b < 2; ++b)
#pragma unroll
                for (int m = 0; m < 4; ++m)
#pragma unroll
                    for (int n = 0; n < 2; ++n) acc[a][b][m][n] = (f32x4){0.f, 0.f, 0.f, 0.f};
        cur = nxt; cA = nA; cB = nB; ++ui;
        if constexpr (ALIGN_EPI) { if (wr == 1) PG8_BAR; }
    }
    PG8_WAIT_V(0);
    if constexpr (!ALIGN_EPI) { if (wr == 0) PG8_BAR; }
    PG8_BAR;
    if constexpr (Epi::AFTER_DRAIN) { E.fused(acc, cur, wr, wc, fr, fq, lds, wid, lane); S.done(cur); }
#undef PG8_SA
#undef PG8_SB
#undef PG8_STAGE
#undef PG8_LDA
#undef PG8_LDB
#undef PG8_MMA
#undef PG8_WAIT_V
#undef PG8_WAIT_L
#undef PG8_BAR
#undef PG8_SCHED
}
}

#define DI __device__ __forceinline__
typedef unsigned short bf16_t;
typedef short bf16x8 __attribute__((ext_vector_type(8)));
typedef short bf16x4 __attribute__((ext_vector_type(4)));
typedef float f32x4 __attribute__((ext_vector_type(4)));
typedef unsigned u32x4 __attribute__((ext_vector_type(4)));
typedef unsigned u32x2 __attribute__((ext_vector_type(2)));
constexpr int NTHR = 512, NWAVE = 8;
constexpr int LDS_BYTES = 155648;
constexpr int LDS_SLOT = 155648 - 64;

DI float bf2f(bf16_t v) { return __uint_as_float(((unsigned)v) << 16); }
typedef float f32x2v __attribute__((ext_vector_type(2)));
typedef __bf16 bf16x2v __attribute__((ext_vector_type(2)));
DI unsigned f2bf(float f) { return (unsigned)__builtin_bit_cast(unsigned short, (__bf16)f); }
DI unsigned pk2(float lo, float hi) { const f32x2v v = {lo, hi}; return __builtin_bit_cast(unsigned, __builtin_convertvector(v, bf16x2v)); }
DI float lo_f(unsigned w) { return __uint_as_float(w << 16); }
DI float hi_f(unsigned w) { return __uint_as_float(w & 0xffff0000u); }
DI float siluf(float x) { return x * __builtin_amdgcn_rcpf(1.0f + __expf(-x)); }
DI float sigmf(float x) { return __builtin_amdgcn_rcpf(1.0f + __expf(-x)); }
#define DPPF(v, ctrl) __builtin_bit_cast(float, __builtin_amdgcn_update_dpp(0, __builtin_bit_cast(int, (v)), (ctrl), 0xf, 0xf, true))
#define DPPI(v, ctrl) __builtin_amdgcn_update_dpp(0, (v), (ctrl), 0xf, 0xf, true)
DI float row16_sum(float v) {
    v += DPPF(v, 0xB1); v += DPPF(v, 0x4E); v += DPPF(v, 0x141); v += DPPF(v, 0x140);
    return v;
}
DI int row16_sumi(int v) {
    v += DPPI(v, 0xB1); v += DPPI(v, 0x4E); v += DPPI(v, 0x141); v += DPPI(v, 0x140);
    return v;
}
DI float wave_sum(float v) {
    v = row16_sum(v);
    v += __shfl_xor(v, 16); v += __shfl_xor(v, 32);
    return v;
}
DI f32x4 mfma16(bf16x8 a, bf16x8 b, f32x4 c) { return __builtin_amdgcn_mfma_f32_16x16x32_bf16(a, b, c, 0, 0, 0); }
DI bf16x8 ld16(const unsigned char* p) { return *(const bf16x8*)p; }
DI bf16x8 ld8x2(const unsigned char* p0, const unsigned char* p1) {
    const bf16x4 a = *(const bf16x4*)p0, b = *(const bf16x4*)p1;
    return __builtin_shufflevector(a, b, 0, 1, 2, 3, 4, 5, 6, 7);
}
DI bf16x8 packf(const f32x4 a, const f32x4 b) {
    u32x4 w; w.x = pk2(a[0], a[1]); w.y = pk2(a[2], a[3]); w.z = pk2(b[0], b[1]); w.w = pk2(b[2], b[3]);
    return __builtin_bit_cast(bf16x8, w);
}
DI u32x2 pack4(const f32x4 a) { u32x2 w; w.x = pk2(a[0], a[1]); w.y = pk2(a[2], a[3]); return w; }

#define LAS __attribute__((address_space(3)))
#define XB_TMO      128
#define XB_XCNT(j)  (256  + 64 * (j))
#define XB_XSUB(j)  (1280 + 64 * (j))
#define XB_XGEN(j)  (2304 + 64 * (j))
#define XB_TOP      3328
#define XB_TOPGEN   3392
#define XCD_BAR_WORDS 3456
#define XB_SPIN_CAP (1u << 18)

__device__ __forceinline__ unsigned xb_ld(unsigned* p)              { return __hip_atomic_load(p, __ATOMIC_RELAXED, __HIP_MEMORY_SCOPE_AGENT); }
__device__ __forceinline__ unsigned xb_add(unsigned* p, unsigned v) { return __hip_atomic_fetch_add(p, v, __ATOMIC_RELAXED, __HIP_MEMORY_SCOPE_AGENT); }
__device__ __forceinline__ unsigned xb_xcc_id() { return (unsigned)__builtin_amdgcn_s_getreg((3 << 11) | 20) & 0xFu; }
#define XB_SPIN(cond, bar) do { unsigned _sp = 0; while (cond) { __builtin_amdgcn_s_sleep(1); \
    if ((++_sp & 255u) == 0u) { if (xb_ld(&(bar)[XB_TMO])) break; if (_sp > XB_SPIN_CAP) { atomicAdd(&(bar)[XB_TMO], 1u); break; } } } } while (0)

struct XcdBarrier {
    unsigned* bar; unsigned x;
    volatile LAS unsigned* st;
};

__device__ __forceinline__ XcdBarrier xcd_barrier_post(unsigned* bar, volatile LAS unsigned* st) {
    XcdBarrier b; b.bar = bar; b.x = xb_xcc_id(); b.st = st;
    if (threadIdx.x == 0) (void)xb_add(&bar[XB_XCNT(b.x)], 1u);
    return b;
}
__device__ __forceinline__ void xcd_barrier_complete(unsigned* bar, unsigned x, unsigned& nloc, unsigned& nx) {
    const unsigned G = gridDim.x * gridDim.y * gridDim.z;
    unsigned sum, cnt, mine, sp = 0u;
    for (;;) {
        sum = 0u; cnt = 0u; mine = 0u;
#pragma unroll
        for (unsigned j = 0; j < 16; ++j) { const unsigned c = xb_ld(&bar[XB_XCNT(j)]); sum += c; cnt += (c > 0u) ? 1u : 0u; mine = (j == x) ? c : mine; }
        if (sum == G) break;
        __builtin_amdgcn_s_sleep(1);
        if ((++sp & 255u) == 0u) { if (xb_ld(&bar[XB_TMO])) break; if (sp > XB_SPIN_CAP) { atomicAdd(&bar[XB_TMO], 1u); break; } }
    }
    nloc = mine > 0u ? mine : 1u; nx = cnt > 0u ? cnt : 1u;
}

__device__ __forceinline__ void xcd_barrier(const XcdBarrier& b) {
    asm volatile("s_waitcnt vmcnt(0)" ::: "memory");
    __syncthreads();
    if (threadIdx.x == 0) {
        unsigned* bar = b.bar;
        __builtin_amdgcn_s_waitcnt(0);
        unsigned nloc = b.st[0], nx = b.st[1];
        if (nloc == 0u) { xcd_barrier_complete(bar, b.x, nloc, nx); b.st[0] = nloc; b.st[1] = nx; }
        const unsigned old = xb_add(&bar[XB_XSUB(b.x)], 1u);
        const unsigned gen = old / nloc;
        if (old + 1u == (gen + 1u) * nloc) {
            __builtin_amdgcn_fence(__ATOMIC_RELEASE, "agent");
            asm volatile("s_waitcnt vmcnt(0)" ::: "memory");
            const unsigned og = xb_add(&bar[XB_TOP], 1u);
            const unsigned tg = og / nx;
            if (og + 1u == (tg + 1u) * nx) xb_add(&bar[XB_TOPGEN], 1u);
            else XB_SPIN(xb_ld(&bar[XB_TOPGEN]) == tg, bar);
            __builtin_amdgcn_fence(__ATOMIC_ACQUIRE, "agent");
            xb_add(&bar[XB_XGEN(b.x)], 1u);
            asm volatile("s_waitcnt vmcnt(0)" ::: "memory");
        } else {
            XB_SPIN(xb_ld(&bar[XB_XGEN(b.x)]) == gen, bar);
            __builtin_amdgcn_fence(__ATOMIC_ACQUIRE, "agent");
            asm volatile("s_waitcnt vmcnt(0)" ::: "memory");
        }
    }
    __syncthreads();
}

__constant__ float INV_A[64] = {1.000000000e+00f, 8.659643531e-01f, 7.498942614e-01f, 6.493816376e-01f, 5.623413324e-01f, 4.869675338e-01f, 4.216965139e-01f, 3.651741147e-01f, 3.162277639e-01f, 2.738419771e-01f, 2.371373773e-01f, 2.053525001e-01f, 1.778279394e-01f, 1.539926529e-01f, 1.333521307e-01f, 1.154782027e-01f, 1.000000015e-01f, 8.659642935e-02f, 7.498941571e-02f, 6.493816525e-02f, 5.623413250e-02f, 4.869675264e-02f, 4.216965288e-02f, 3.651741147e-02f, 3.162277490e-02f, 2.738419734e-02f, 2.371373773e-02f, 2.053525113e-02f, 1.778279431e-02f, 1.539926510e-02f, 1.333521493e-02f, 1.154782064e-02f, 9.999999776e-03f, 8.659643121e-03f, 7.498941850e-03f, 6.493816152e-03f, 5.623413250e-03f, 4.869675264e-03f, 4.216964822e-03f, 3.651741194e-03f, 3.162277630e-03f, 2.738419687e-03f, 2.371373586e-03f, 2.053524833e-03f, 1.778279431e-03f, 1.539926510e-03f, 1.333521446e-03f, 1.154781901e-03f, 1.000000047e-03f, 8.659643354e-04f, 7.498942432e-04f, 6.493816618e-04f, 5.623413017e-04f, 4.869675322e-04f, 4.216965172e-04f, 3.651741426e-04f, 3.162277571e-04f, 2.738419571e-04f, 2.371373703e-04f, 2.053525095e-04f, 1.778279402e-04f, 1.539926452e-04f, 1.333521504e-04f, 1.154782003e-04f};
__constant__ float INV_I[32] = {1.000000000e+00f, 7.498942614e-01f, 5.623413324e-01f, 4.216965139e-01f, 3.162277639e-01f, 2.371373773e-01f, 1.778279394e-01f, 1.333521307e-01f, 1.000000015e-01f, 7.498941571e-02f, 5.623413250e-02f, 4.216965288e-02f, 3.162277490e-02f, 2.371373773e-02f, 1.778279431e-02f, 1.333521493e-02f, 9.999999776e-03f, 7.498941850e-03f, 5.623413250e-03f, 4.216964822e-03f, 3.162277630e-03f, 2.371373586e-03f, 1.778279431e-03f, 1.333521446e-03f, 1.000000047e-03f, 7.498942432e-04f, 5.623413017e-04f, 4.216965172e-04f, 3.162277571e-04f, 2.371373703e-04f, 1.778279402e-04f, 1.333521504e-04f};
struct Params {
    const float* x; const float* norm_g; const float* w_in; const float* gate_b; const float* conv_w; const float* a_log; const float* dt_bias;
    const float* dn_onorm; const float* pool_w; const float* pool_scale; const float* q_norm; const float* k_norm; const float* w_branch; const float* w_out;
    float* out; unsigned char* ws;
    int ph_lo, ph_hi;
};

DI int next_unit(unsigned* ctr, unsigned char* lds) {
    volatile int* slot = (volatile int*)(lds + LDS_SLOT);
    __syncthreads();
    if (threadIdx.x == 0) *slot = (int)atomicAdd(ctr, 1u);
    __syncthreads();
    return *slot;
}

DI int src_col(int mode, int n) {
    if (mode == 0) {
        if (n < 2048) return n;
        if (n < 5440) return n + 8;
        if (n < 5444) return 2048 + (n - 5440);
        if (n < 5448) return 2052 + (n - 5444);
        if (n < 5452) return n;
        return -1;
    }
    if (mode == 1) return 5452 + n;
    return n;
}
DI void transpose_item(const float* W, int ldw, int K, bf16_t* WT, int mode, float* scr, int item, int nblk, int lane) {
    const int kb = item / nblk, nb = item % nblk, k0 = 64 * kb, n0 = 32 * nb;
    const int sc = src_col(mode, n0 + (lane & 31));
    const int scc = sc < 0 ? 0 : sc;
    float tv[32];
#pragma unroll
    for (int i = 0; i < 32; ++i) { const int kk = 2 * i + (lane >> 5); tv[i] = W[(size_t)(k0 + kk) * ldw + scc]; }
    __builtin_amdgcn_sched_barrier(0);
#pragma unroll
    for (int i = 0; i < 32; ++i) { const int kk = 2 * i + (lane >> 5); scr[kk * 33 + (lane & 31)] = (sc >= 0) ? tv[i] : 0.f; }
    asm volatile("s_waitcnt lgkmcnt(0)" ::: "memory");
    const int c = lane & 7;
#pragma unroll
    for (int j = 0; j < 4; ++j) { const int n = (lane >> 3) + 8 * j; const float* s = scr + (8 * c) * 33 + n;
        u32x4 o; o.x = pk2(s[0 * 33], s[1 * 33]); o.y = pk2(s[2 * 33], s[3 * 33]); o.z = pk2(s[4 * 33], s[5 * 33]); o.w = pk2(s[6 * 33], s[7 * 33]);
        *(u32x4*)(WT + (size_t)(n0 + n) * K + k0 + 8 * c) = o; }
    asm volatile("s_waitcnt lgkmcnt(0)" ::: "memory");
}
DI void rms_row(const float* xrow, const float* g, bf16_t* orow, int lane) {
    const f32x4* xr = (const f32x4*)xrow + lane; const f32x4* gr = (const f32x4*)g + lane;
    f32x4 v[4]; float s = 0.f;
#pragma unroll
    for (int j = 0; j < 4; ++j) { v[j] = xr[64 * j]; s += (v[j].x * v[j].x + v[j].y * v[j].y) + (v[j].z * v[j].z + v[j].w * v[j].w); }
    const float rstd = 1.0f / sqrtf(wave_sum(s) * (1.0f / DM) + NORM_EPS);
    u32x2* o8 = (u32x2*)orow + lane;
#pragma unroll
    for (int j = 0; j < 4; ++j) { const f32x4 gg = gr[64 * j]; u32x2 w; w.x = pk2(v[j].x * rstd * gg.x, v[j].y * rstd * gg.y); w.y = pk2(v[j].z * rstd * gg.z, v[j].w * rstd * gg.w); o8[64 * j] = w; }
}
DI void rms_row2(const float* xrow, const float* g, bf16_t* orow, int lane) {
    const f32x4* xr = (const f32x4*)xrow + lane; const f32x4* gr = (const f32x4*)g + lane;
    f32x4 v[2][4], gg[4];
#pragma unroll
    for (int r = 0; r < 2; ++r)
#pragma unroll
        for (int j = 0; j < 4; ++j) v[r][j] = xr[r * (DM / 4) + 64 * j];
#pragma unroll
    for (int j = 0; j < 4; ++j) gg[j] = gr[64 * j];
    __builtin_amdgcn_sched_barrier(0);
    float s[2];
#pragma unroll
    for (int r = 0; r < 2; ++r) { s[r] = 0.f;
#pragma unroll
        for (int j = 0; j < 4; ++j) s[r] += (v[r][j].x * v[r][j].x + v[r][j].y * v[r][j].y) + (v[r][j].z * v[r][j].z + v[r][j].w * v[r][j].w); }
#pragma unroll
    for (int r = 0; r < 2; ++r) s[r] = wave_sum(s[r]);
#pragma unroll
    for (int r = 0; r < 2; ++r) { const float rstd = __builtin_amdgcn_rsqf(s[r] * (1.0f / DM) + NORM_EPS);
        u32x2* o8 = (u32x2*)(orow + r * DM) + lane;
#pragma unroll
        for (int j = 0; j < 4; ++j) { u32x2 w; w.x = pk2(v[r][j].x * rstd * gg[j].x, v[r][j].y * rstd * gg[j].y); w.y = pk2(v[r][j].z * rstd * gg[j].z, v[r][j].w * rstd * gg[j].w); o8[64 * j] = w; } }
}
DI void phase0(const Params& p, int layer, const float* xin, unsigned char* lds) {
    int tid_ = threadIdx.x; asm volatile("" : "+v"(tid_)); const int tid = tid_, lane = tid & 63, wave = tid >> 6;
    const int gw = blockIdx.x * NWAVE + wave, NGW = gridDim.x * NWAVE;
    float* scr = (float*)(lds + wave * 8704);
    unsigned char* ws = p.ws;
    const float* win = p.w_in + (size_t)layer * DM * INW;
    const float* wbr = p.w_branch + (size_t)layer * 3 * 512 * 1024;
    const float* wo = p.w_out + (size_t)layer * 1024 * 1024;
    const float* pw = p.pool_w + (size_t)layer * 4 * 128 * 128;
    constexpr int I_1 = 16 * (N1 / 32), I_G = 16 * (NG / 32), I_B = 8 * 32, I_O = 16 * 32, I_P = 2 * 4;
    constexpr int NITEMS = I_1 + I_G + 3 * I_B + I_O + 4 * I_P;
    for (int it = gw; it < NITEMS; it += NGW) {
        int r = it;
        if (r < I_1) { transpose_item(win, INW, 1024, (bf16_t*)(ws + WS_WIN1), 0, scr, r, N1 / 32, lane); continue; } r -= I_1;
        if (r < I_G) { transpose_item(win, INW, 1024, (bf16_t*)(ws + WS_WG), 1, scr, r, NG / 32, lane); continue; } r -= I_G;
        if (r < 3 * I_B) { const int br = r / I_B; transpose_item(wbr + (size_t)br * 512 * 1024, 1024, 512, (bf16_t*)(ws + WS_WBR) + (size_t)br * 1024 * 512, 2, scr, r % I_B, 32, lane); continue; } r -= 3 * I_B;
        if (r < I_O) { transpose_item(wo, 1024, 1024, (bf16_t*)(ws + WS_WO), 2, scr, r, 32, lane); continue; } r -= I_O;
        { const int g = r / I_P; transpose_item(pw + (size_t)g * 128 * 128, 128, 128, (bf16_t*)(ws + WS_POOLW) + (size_t)g * 128 * 128, 2, scr, r % I_P, 4, lane); }
    }
    const float* ng = p.norm_g + layer * DM;
    for (int m = 2 * gw; m < MTOK; m += 2 * NGW) rms_row2(xin + (size_t)m * DM, ng, (bf16_t*)(ws + WS_H) + (size_t)m * DM, lane);
    if (layer == 0) {
        const int gt = blockIdx.x * NTHR + tid, NGT = gridDim.x * NTHR;
        for (int i = gt; i < SEQ * 96; i += NGT) {
            const int t = i / 96, j = i % 96;
            const float inv = (j < 64) ? INV_A[j] : INV_I[j - 64];
            const float ang = (float)t * inv;
            double rev = (double)ang * 0.15915494309189535; rev -= floor(rev);
            const float rf = (float)rev;
            const float c = __builtin_amdgcn_cosf(rf), s = __builtin_amdgcn_sinf(rf);
            if (j < 64) { ((float*)(ws + WS_COSA))[t * 64 + j] = c; ((float*)(ws + WS_SINA))[t * 64 + j] = s; }
            else { ((float*)(ws + WS_COSI))[t * 32 + (j - 64)] = c; ((float*)(ws + WS_SINI))[t * 32 + (j - 64)] = s; }
        }
    }
}

constexpr int DP_Q = 0, DP_K = 17408, DP_KBT = 34816, DP_VT = 53248, DP_KDT = 71680, DP_L = 90112, DP_TF = 106752, DP_T = 123392, DP_GC = 132608, DP_BETA = 132864, DP_P = 133120;
constexpr int QP = 272;
constexpr int TP = 144;
DI void dn_prep_unit(const Params& p, int layer, int unit, unsigned char* lds) {
    int tid_ = threadIdx.x; asm volatile("" : "+v"(tid_)); const int tid = tid_, lane = tid & 63, wave = tid >> 6, fr = lane & 15, fq = lane >> 4;
    const int c = unit & 31, h = (unit >> 5) & 3, b = unit >> 7;
    unsigned char* ws = p.ws;
    const size_t tok0 = (size_t)b * SEQ + (size_t)c * 64;
    float* sGc = (float*)(lds + DP_GC); float* sBeta = (float*)(lds + DP_BETA);
    float* sL = (float*)(lds + DP_L); float* sTf = (float*)(lds + DP_TF);
    unsigned char* su = ws + WS_SCAN + (size_t)unit * SCAN_UNIT_BYTES;
    const bf16_t* aq = (const bf16_t*)(ws + WS_AQKV);
    const float* cw = p.conv_w + (size_t)layer * 4 * 1536;
    const int tl0 = 8 * wave;
        float raA[3][11], rbA[3][11], w0A[3][4], w1A[3][4];
#pragma unroll
        for (int part = 0; part < 3; ++part) {
            const int ch0 = part * 512 + h * 128 + lane, ch1 = ch0 + 64;
#pragma unroll
            for (int j = 0; j < 4; ++j) { w0A[part][j] = cw[j * 1536 + ch0]; w1A[part][j] = cw[j * 1536 + ch1]; }
#pragma unroll
            for (int j = 0; j < 11; ++j) { const int tg = c * 64 + tl0 - 3 + j;
                const int tgc = tg < 0 ? 0 : tg; const bf16_t* rp = aq + ((size_t)b * SEQ + tgc) * 1536;
                const float va = bf2f(rp[ch0]), vb = bf2f(rp[ch1]); raA[part][j] = tg >= 0 ? va : 0.f; rbA[part][j] = tg >= 0 ? vb : 0.f; }
        }
    if (wave == 0) {
        const float* mp = (const float*)(ws + WS_MISC) + (tok0 + lane) * 16;
        const float ba = mp[h], aa = mp[4 + h];
        const float al = p.a_log[layer * 4 + h], dtb = p.dt_bias[layer * 4 + h];
        const float xx = aa + dtb;
        const float sp = fmaxf(xx, 0.f) + log1pf(__expf(-fabsf(xx)));
        float g = -__expf(al) * sp;
        float cs = g;
#pragma unroll
        for (int o = 1; o < 64; o <<= 1) { const float n = __shfl_up(cs, o); if (lane >= o) cs += n; }
        sGc[lane] = cs; sBeta[lane] = sigmf(ba);
    }
    __syncthreads();
    const float gl = sGc[63];
    {
        __builtin_amdgcn_sched_barrier(0);
#pragma unroll
        for (int part = 0; part < 3; ++part) {
            const float (&ra)[11] = raA[part]; const float (&rb)[11] = rbA[part]; const float (&w0)[4] = w0A[part]; const float (&w1)[4] = w1A[part];
            float yav[8], ybv[8];
#pragma unroll
            for (int i = 0; i < 8; ++i) {
                yav[i] = siluf(w0[0] * ra[i] + w0[1] * ra[i + 1] + w0[2] * ra[i + 2] + w0[3] * ra[i + 3]);
                ybv[i] = siluf(w1[0] * rb[i] + w1[1] * rb[i + 1] + w1[2] * rb[i + 2] + w1[3] * rb[i + 3]);
            }
            float rnv[8];
            if (part < 2) {
#pragma unroll
                for (int i = 0; i < 8; ++i) rnv[i] = yav[i] * yav[i] + ybv[i] * ybv[i];
#pragma unroll
                for (int i = 0; i < 8; ++i) rnv[i] = 1.0f / sqrtf(wave_sum(rnv[i]) + NORM_EPS);
            }
#pragma unroll
            for (int i = 0; i < 8; ++i) {
                const int tl = tl0 + i;
                float ya = yav[i], yb = ybv[i];
                const float beta = sBeta[tl], gct = sGc[tl];
                if (part < 2) {
                    const float rn = rnv[i];
                    ya *= rn; yb *= rn;
                    if (part == 0) {
                        *(bf16_t*)(lds + DP_Q + tl * QP + lane * 2) = (bf16_t)f2bf(ya); *(bf16_t*)(lds + DP_Q + tl * QP + (lane + 64) * 2) = (bf16_t)f2bf(yb);
                    } else {
                        *(bf16_t*)(lds + DP_K + tl * QP + lane * 2) = (bf16_t)f2bf(ya); *(bf16_t*)(lds + DP_K + tl * QP + (lane + 64) * 2) = (bf16_t)f2bf(yb);
                        const float s1 = beta * __expf(gct), s2 = __expf(gl - gct);
                        *(bf16_t*)(lds + DP_KBT + lane * TP + tl * 2) = (bf16_t)f2bf(ya * s1); *(bf16_t*)(lds + DP_KBT + (lane + 64) * TP + tl * 2) = (bf16_t)f2bf(yb * s1);
                        *(bf16_t*)(lds + DP_KDT + lane * TP + tl * 2) = (bf16_t)f2bf(ya * s2); *(bf16_t*)(lds + DP_KDT + (lane + 64) * TP + tl * 2) = (bf16_t)f2bf(yb * s2);
                    }
                } else {
                    *(bf16_t*)(lds + DP_VT + lane * TP + tl * 2) = (bf16_t)f2bf(ya * beta); *(bf16_t*)(lds + DP_VT + (lane + 64) * TP + tl * 2) = (bf16_t)f2bf(yb * beta);
                }
            }
        }
    }
    __syncthreads();
#pragma unroll 1
    for (int i4 = 0; i4 < 4; ++i4) {
        const int id = wave + 8 * i4;
        if (id < 16) {
            const int mt = id >> 2, nt = id & 3;
            f32x4 acc = {0.f, 0.f, 0.f, 0.f};
            if (nt <= mt) {
#pragma unroll
                for (int s = 0; s < 4; ++s) acc = mfma16(ld16(lds + DP_K + (16 * mt + fr) * QP + (32 * s + 8 * fq) * 2), ld16(lds + DP_K + (16 * nt + fr) * QP + (32 * s + 8 * fq) * 2), acc);
            }
            const int j = 16 * nt + fr; const float gj = sGc[j];
#pragma unroll
            for (int jj = 0; jj < 4; ++jj) { const int i = 16 * mt + 4 * fq + jj;
                float v = 0.f; if (j < i) v = sBeta[i] * acc[jj] * __expf(sGc[i] - gj);
                sL[i * 65 + j] = v; }
        } else {
            const int mt = (id - 16) >> 2, nt = (id - 16) & 3;
            f32x4 acc = {0.f, 0.f, 0.f, 0.f};
            if (nt <= mt) {
#pragma unroll
                for (int s = 0; s < 4; ++s) acc = mfma16(ld16(lds + DP_K + (16 * nt + fr) * QP + (32 * s + 8 * fq) * 2), ld16(lds + DP_Q + (16 * mt + fr) * QP + (32 * s + 8 * fq) * 2), acc);
            }
            const int i = 16 * mt + fr; const float gi = sGc[i];
            f32x4 o;
#pragma unroll
            for (int jj = 0; jj < 4; ++jj) { const int j = 16 * nt + 4 * fq + jj;
                float v = 0.f; if (j <= i) v = acc[jj] * 0.08838834764831845f * __expf(gi - sGc[j]);
                o[jj] = v; }
            *(u32x2*)(su + SU_A + (i * 64 + 16 * nt + 4 * fq) * 2) = pack4(o);
        }
    }
    __syncthreads();
    float* sP = (float*)(lds + DP_P);
    if (wave < 4) {
        const int o = 16 * wave;
        for (int e = lane; e < 16 * 64; e += 64) { const int i = e >> 6, cc = e & 63; if (cc >= o + 16) sTf[(o + i) * 65 + cc] = 0.f; }
        if (lane < 16) {
            float lv[120];
#pragma unroll
            for (int i = 1; i < 16; ++i)
#pragma unroll
                for (int j = 0; j < i; ++j) lv[i * (i - 1) / 2 + j] = sL[(o + i) * 65 + o + j];
            float tc[16];
#pragma unroll
            for (int i = 0; i < 16; ++i) {
                float acc = (i == lane) ? 1.f : 0.f;
#pragma unroll
                for (int j = 0; j < i; ++j) acc -= lv[i * (i - 1) / 2 + j] * tc[j];
                tc[i] = acc;
            }
#pragma unroll
            for (int i = 0; i < 16; ++i) sTf[(o + i) * 65 + o + lane] = tc[i];
        }
    } else {
        for (int ch = tid - 256; ch < 1024; ch += 256) {
            const int row = ch >> 4, c8 = (ch & 15) * 8;
            const u32x4 q = *(const u32x4*)(lds + DP_Q + row * QP + c8 * 2);
            const float sc = __expf(sGc[row]) * 0.08838834764831845f;
            u32x4 o; o.x = pk2(lo_f(q.x) * sc, hi_f(q.x) * sc); o.y = pk2(lo_f(q.y) * sc, hi_f(q.y) * sc); o.z = pk2(lo_f(q.z) * sc, hi_f(q.z) * sc); o.w = pk2(lo_f(q.w) * sc, hi_f(q.w) * sc);
            *(u32x4*)(su + SU_QG + (row * 128 + c8) * 2) = o;
        }
        for (int ch = tid - 256; ch < 1024; ch += 256) {
            const int row = ch >> 3, c8 = (ch & 7) * 8;
            *(u32x4*)(su + SU_KDT + (row * 64 + c8) * 2) = *(const u32x4*)(lds + DP_KDT + row * TP + c8 * 2);
        }
        if (tid == 256) ((float*)(ws + WS_DEC))[unit] = __expf(gl);
    }
    __syncthreads();
#pragma unroll 1
    for (int I = 1; I < 4; ++I) {
        for (int e = tid; e < I * 256; e += NTHR) { const int J = e >> 8, r = (e >> 4) & 15, cc = e & 15;
            float acc = 0.f;
            for (int K = J; K < I; ++K) {
#pragma unroll
                for (int k2 = 0; k2 < 16; ++k2) acc += sL[(16 * I + r) * 65 + 16 * K + k2] * sTf[(16 * K + k2) * 65 + 16 * J + cc];
            }
            sP[r * 65 + 16 * J + cc] = acc; }
        __syncthreads();
        for (int e = tid; e < I * 256; e += NTHR) { const int J = e >> 8, r = (e >> 4) & 15, cc = e & 15;
            float acc = 0.f;
#pragma unroll
            for (int kk = 0; kk < 16; ++kk) acc += sTf[(16 * I + r) * 65 + 16 * I + kk] * sP[kk * 65 + 16 * J + cc];
            sTf[(16 * I + r) * 65 + 16 * J + cc] = -acc; }
        __syncthreads();
    }
    for (int e = tid; e < 4096; e += NTHR) { const int i = e >> 6, j = e & 63; *(bf16_t*)(lds + DP_T + i * TP + j * 2) = (bf16_t)f2bf(sTf[i * 65 + j]); }
    __syncthreads();
#pragma unroll 1
    for (int i8 = 0; i8 < 8; ++i8) {
        const int id = wave + 8 * i8;
        if (id < 32) {
            const int mt = id >> 3, nt = id & 7;
            f32x4 acc = {0.f, 0.f, 0.f, 0.f};
#pragma unroll
            for (int s = 0; s < 2; ++s) acc = mfma16(ld16(lds + DP_T + (16 * mt + fr) * TP + (32 * s + 8 * fq) * 2), ld16(lds + DP_VT + (16 * nt + fr) * TP + (32 * s + 8 * fq) * 2), acc);
            *(u32x2*)(su + SU_UT + ((16 * nt + fr) * 64 + 16 * mt + 4 * fq) * 2) = pack4(acc);
        } else {
            const int mt = (id - 32) >> 3, nt = (id - 32) & 7;
            f32x4 acc = {0.f, 0.f, 0.f, 0.f};
#pragma unroll
            for (int s = 0; s < 2; ++s) acc = mfma16(ld16(lds + DP_KBT + (16 * nt + fr) * TP + (32 * s + 8 * fq) * 2), ld16(lds + DP_T + (16 * mt + fr) * TP + (32 * s + 8 * fq) * 2), acc);
            *(u32x2*)(su + SU_W + ((16 * mt + fr) * 128 + 16 * nt + 4 * fq) * 2) = pack4(acc);
        }
    }
}

constexpr int PL_U = 0, PL_P = 40960;
DI void pool_unit(const Params& p, int layer, int unit, unsigned char* lds) {
    int tid_ = threadIdx.x; asm volatile("" : "+v"(tid_)); const int tid = tid_, lane = tid & 63, wave = tid >> 6, fr = lane & 15, fq = lane >> 4;
    const int g = unit & 3, tt = (unit >> 2) & 31, b = unit >> 7;
    unsigned char* ws = p.ws;
    const int t0 = tt * 64, win = 2 << g;
    float* sU = (float*)(lds + PL_U);
    const bf16_t* bu = (const bf16_t*)(ws + WS_BU);
    const bf16_t* pw = (const bf16_t*)(ws + WS_POOLW) + (size_t)g * 128 * 128;
    const int mt = wave & 3, nh = wave >> 2;
    const float* psc = p.pool_scale + layer * 512 + g * 128;
    bf16_t* bz = (bf16_t*)(ws + WS_BZ);
    bf16x8 bw[4][4]; u32x2 zz[4]; f32x4 scv[4];
#pragma unroll
        for (int n4 = 0; n4 < 4; ++n4) { const int nt = nh * 4 + n4;
#pragma unroll
            for (int s = 0; s < 4; ++s) bw[n4][s] = *(const bf16x8*)(pw + (16 * nt + fr) * 128 + 32 * s + 8 * fq);
            const int d0 = 16 * nt + 4 * fq;
            zz[n4] = *(const u32x2*)(bz + ((size_t)b * SEQ + t0 + 16 * mt + fr) * 512 + g * 128 + d0); scv[n4] = *(const f32x4*)(psc + d0); }
    {
        float pv[20];
#pragma unroll
        for (int k = 0; k < 20; ++k) { const int e = tid + k * NTHR; const int r = e >> 7, cc = e & 127; const int t = t0 - 15 + r;
            const int tc = t < 0 ? 0 : (t > SEQ - 1 ? SEQ - 1 : t);
            const float v = bf2f(bu[((size_t)b * SEQ + tc) * 512 + g * 128 + cc]); pv[k] = (t >= 0) ? v : 0.f; }
        __builtin_amdgcn_sched_barrier(0);
#pragma unroll
        for (int k = 0; k < 20; ++k) { const int e = tid + k * NTHR; if (e < 79 * 128) sU[e] = pv[k]; }
    }
    __syncthreads();
    for (int e = tid; e < 64 * 128; e += NTHR) { const int tl = e >> 7, cc = e & 127; const int t = t0 + tl;
        const int cnt = (t + 1 < win) ? (t + 1) : win;
        float s = 0.f;
#pragma unroll
        for (int i = 0; i < 16; ++i) { const float v = sU[(tl + 15 - i) * 128 + cc]; s += (i < cnt) ? v : 0.f; }
        const float pv = s / (float)cnt - sU[(tl + 15) * 128 + cc];
        *(bf16_t*)(lds + PL_P + tl * QP + cc * 2) = (bf16_t)f2bf(pv); }
    __syncthreads();
    {
        __builtin_amdgcn_sched_barrier(0);
#pragma unroll
        for (int n4 = 0; n4 < 4; ++n4) {
            const int nt = nh * 4 + n4;
            f32x4 acc = {0.f, 0.f, 0.f, 0.f};
#pragma unroll
            for (int s = 0; s < 4; ++s) acc = mfma16(bw[n4][s], ld16(lds + PL_P + (16 * mt + fr) * QP + (32 * s + 8 * fq) * 2), acc);
            const int d0 = 16 * nt + 4 * fq; bf16_t* zp = bz + ((size_t)b * SEQ + t0 + 16 * mt + fr) * 512 + g * 128 + d0;
            f32x4 o; o[0] = acc[0] * scv[n4][0] * siluf(lo_f(zz[n4].x)); o[1] = acc[1] * scv[n4][1] * siluf(hi_f(zz[n4].x)); o[2] = acc[2] * scv[n4][2] * siluf(lo_f(zz[n4].y)); o[3] = acc[3] * scv[n4][3] * siluf(hi_f(zz[n4].y));
            *(u32x2*)zp = pack4(o);
        }
    }
}

DI void sa_prep_unit(const Params& p, int layer, int unit, unsigned char* lds) {
    int tid_ = threadIdx.x; asm volatile("" : "+v"(tid_)); const int tid = tid_, lane = tid & 63, wave = tid >> 6;
    unsigned char* ws = p.ws;
    bf16_t* cq = (bf16_t*)(ws + WS_CQKV);
    const float* cosA = (const float*)(ws + WS_COSA); const float* sinA = (const float*)(ws + WS_SINA);
    const float gq0 = p.q_norm[layer * 128 + lane], gq1 = p.q_norm[layer * 128 + lane + 64];
    const float gk0 = p.k_norm[layer * 128 + lane], gk1 = p.k_norm[layer * 128 + lane + 64];
#pragma unroll 1
    for (int i0 = 0; i0 < 64; i0 += 16) {
        float x1[16], x2[16], cs[16], sn[16]; bf16_t* rp[16];
#pragma unroll
        for (int k = 0; k < 16; ++k) {
            const int rid = wave * 64 + i0 + k;
            const int tl = rid >> 3, qk = (rid >> 2) & 1, hh = rid & 3;
            const size_t tok = (size_t)unit * 64 + tl; const int t = (int)(tok & (SEQ - 1));
            rp[k] = cq + tok * 1536 + qk * 512 + hh * 128;
            x1[k] = bf2f(rp[k][lane]); x2[k] = bf2f(rp[k][lane + 64]);
            cs[k] = cosA[t * 64 + lane]; sn[k] = sinA[t * 64 + lane];
        }
        __builtin_amdgcn_sched_barrier(0);
        float ss[16];
#pragma unroll
        for (int k = 0; k < 16; ++k) ss[k] = x1[k] * x1[k] + x2[k] * x2[k];
#pragma unroll
        for (int k = 0; k < 16; ++k) ss[k] = wave_sum(ss[k]);
#pragma unroll
        for (int k = 0; k < 16; ++k) {
            const int qk = ((i0 + k) >> 2) & 1;
            const float rstd = 1.0f / sqrtf(ss[k] * (1.0f / 128.0f) + NORM_EPS);
            const float y1 = x1[k] * rstd * (qk ? gk0 : gq0), y2 = x2[k] * rstd * (qk ? gk1 : gq1);
            rp[k][lane] = (bf16_t)f2bf(y1 * cs[k] - y2 * sn[k]); rp[k][lane + 64] = (bf16_t)f2bf(y2 * cs[k] + y1 * sn[k]);
        }
    }
}

constexpr int IX_K = 0;
DI unsigned sortable(float f) { const unsigned u = __float_as_uint(f + 0.0f); return u ^ ((u >> 31) ? 0xffffffffu : 0x80000000u); }
DI void indexer_unit(const Params& p, int unit, unsigned char* lds) {
    int tid_ = threadIdx.x; asm volatile("" : "+v"(tid_)); const int tid = tid_, lane = tid & 63, wave = tid >> 6, fr = lane & 15, fq = lane >> 4;
    const int b = unit & 7, qb = 63 - (unit >> 3);
    unsigned char* ws = p.ws;
    const int t0 = qb * 32, tw = t0 + 4 * wave;
    const int tq = tw + fq;
    unsigned* mask = (unsigned*)(ws + WS_MASK) + ((size_t)b * SEQ + tq) * 64;
    if (t0 < 256) {
#pragma unroll
        for (int k = 0; k < 4; ++k) { const int wd = 16 * k + fr; const int lo = 32 * wd;
            unsigned m = 0u; if (tq >= lo + 31) m = 0xffffffffu; else if (tq >= lo) m = (2u << (tq - lo)) - 1u;
            mask[wd] = m; }
        return;
    }
    const bf16_t* cidx = (const bf16_t*)(ws + WS_CIDX);
    const float* cosI = (const float*)(ws + WS_COSI); const float* sinI = (const float*)(ws + WS_SINI);
    bf16x8 a0, a1;
    {
        const int ql = fr >> 2, hh = fr & 3; const int t = tw + ql;
        const bf16_t* qp = cidx + ((size_t)b * SEQ + t) * 320 + hh * 64;
        const u32x4 x1 = *(const u32x4*)(qp + 8 * fq), x2 = *(const u32x4*)(qp + 32 + 8 * fq);
        const f32x4 c0 = *(const f32x4*)(cosI + t * 32 + 8 * fq), c1 = *(const f32x4*)(cosI + t * 32 + 8 * fq + 4);
        const f32x4 s0 = *(const f32x4*)(sinI + t * 32 + 8 * fq), s1 = *(const f32x4*)(sinI + t * 32 + 8 * fq + 4);
        const float xa[8] = {lo_f(x1.x), hi_f(x1.x), lo_f(x1.y), hi_f(x1.y), lo_f(x1.z), hi_f(x1.z), lo_f(x1.w), hi_f(x1.w)};
        const float xb[8] = {lo_f(x2.x), hi_f(x2.x), lo_f(x2.y), hi_f(x2.y), lo_f(x2.z), hi_f(x2.z), lo_f(x2.w), hi_f(x2.w)};
        const float cc[8] = {c0[0], c0[1], c0[2], c0[3], c1[0], c1[1], c1[2], c1[3]};
        const float sn[8] = {s0[0], s0[1], s0[2], s0[3], s1[0], s1[1], s1[2], s1[3]};
        u32x4 w0, w1;
        w0.x = pk2(xa[0] * cc[0] - xb[0] * sn[0], xa[1] * cc[1] - xb[1] * sn[1]); w0.y = pk2(xa[2] * cc[2] - xb[2] * sn[2], xa[3] * cc[3] - xb[3] * sn[3]);
        w0.z = pk2(xa[4] * cc[4] - xb[4] * sn[4], xa[5] * cc[5] - xb[5] * sn[5]); w0.w = pk2(xa[6] * cc[6] - xb[6] * sn[6], xa[7] * cc[7] - xb[7] * sn[7]);
        w1.x = pk2(xb[0] * cc[0] + xa[0] * sn[0], xb[1] * cc[1] + xa[1] * sn[1]); w1.y = pk2(xb[2] * cc[2] + xa[2] * sn[2], xb[3] * cc[3] + xa[3] * sn[3]);
        w1.z = pk2(xb[4] * cc[4] + xa[4] * sn[4], xb[5] * cc[5] + xa[5] * sn[5]); w1.w = pk2(xb[6] * cc[6] + xa[6] * sn[6], xb[7] * cc[7] + xa[7] * sn[7]);
        a0 = __builtin_bit_cast(bf16x8, w0); a1 = __builtin_bit_cast(bf16x8, w1);
    }
    float wi[4];
    { const float* mp = (const float*)(ws + WS_MISC) + ((size_t)b * SEQ + tq) * 16 + 8;
#pragma unroll
      for (int j = 0; j < 4; ++j) wi[j] = mp[j] * 0.0625f; }
    unsigned sc[128];
    const int tmax = t0 + 31;
    const int skey = tid >> 1, hf = tid & 1;
    u32x4 xa0, xa1, xb0, xb1; f32x4 cv[4], sv[4];
#define IDX_LOAD(r) do { const int t_ = (r) * 256 + skey; const bf16_t* kp_ = cidx + ((size_t)b * SEQ + t_) * 320 + 256; \
        xa0 = *(const u32x4*)(kp_ + 16 * hf); xa1 = *(const u32x4*)(kp_ + 16 * hf + 8); xb0 = *(const u32x4*)(kp_ + 32 + 16 * hf); xb1 = *(const u32x4*)(kp_ + 32 + 16 * hf + 8); \
        _Pragma("unroll") for (int q = 0; q < 4; ++q) { cv[q] = *(const f32x4*)(cosI + t_ * 32 + 16 * hf + 4 * q); sv[q] = *(const f32x4*)(sinI + t_ * 32 + 16 * hf + 4 * q); } } while (0)
    IDX_LOAD(0);
#pragma unroll
    for (int r = 0; r < 8; ++r) {
        if (r * 256 <= tmax) {
            __syncthreads();
            {
                const unsigned xa[8] = {xa0.x, xa0.y, xa0.z, xa0.w, xa1.x, xa1.y, xa1.z, xa1.w};
                const unsigned xb[8] = {xb0.x, xb0.y, xb0.z, xb0.w, xb1.x, xb1.y, xb1.z, xb1.w};
                unsigned o1[8], o2[8];
#pragma unroll
                for (int q = 0; q < 8; ++q) {
                    const float c0 = cv[q >> 1][2 * (q & 1)], c1 = cv[q >> 1][2 * (q & 1) + 1], s0 = sv[q >> 1][2 * (q & 1)], s1 = sv[q >> 1][2 * (q & 1) + 1];
                    const float a_lo = lo_f(xa[q]), a_hi = hi_f(xa[q]), b_lo = lo_f(xb[q]), b_hi = hi_f(xb[q]);
                    o1[q] = pk2(a_lo * c0 - b_lo * s0, a_hi * c1 - b_hi * s1);
                    o2[q] = pk2(b_lo * c0 + a_lo * s0, b_hi * c1 + a_hi * s1);
                }
                u32x4 v; unsigned char* dp = lds + IX_K + skey * TP;
                v.x = o1[0]; v.y = o1[1]; v.z = o1[2]; v.w = o1[3]; *(u32x4*)(dp + (16 * hf) * 2) = v;
                v.x = o1[4]; v.y = o1[5]; v.z = o1[6]; v.w = o1[7]; *(u32x4*)(dp + (16 * hf + 8) * 2) = v;
                v.x = o2[0]; v.y = o2[1]; v.z = o2[2]; v.w = o2[3]; *(u32x4*)(dp + (32 + 16 * hf) * 2) = v;
                v.x = o2[4]; v.y = o2[5]; v.z = o2[6]; v.w = o2[7]; *(u32x4*)(dp + (32 + 16 * hf + 8) * 2) = v;
            }
            __syncthreads();
            if ((r + 1) * 256 <= tmax) IDX_LOAD(r + 1);
            __builtin_amdgcn_sched_barrier(0);
#pragma unroll
            for (int tt = 0; tt < 16; ++tt) {
                const int i = r * 16 + tt;
                const unsigned char* kp = lds + IX_K + (16 * tt + fr) * TP + (8 * fq) * 2;
                f32x4 acc = {0.f, 0.f, 0.f, 0.f};
                acc = mfma16(a0, ld16(kp), acc);
                acc = mfma16(a1, ld16(kp + 64), acc);
                const float s = wi[0] * fmaxf(acc[0], 0.f) + wi[1] * fmaxf(acc[1], 0.f) + wi[2] * fmaxf(acc[2], 0.f) + wi[3] * fmaxf(acc[3], 0.f);
                const int key = 16 * i + fr;
                sc[i] = (key <= tq) ? sortable(s) : 0u;
            }
        } else {
#pragma unroll
            for (int tt = 0; tt < 16; ++tt) sc[r * 16 + tt] = 0u;
        }
    }
#undef IDX_LOAD
    const int ngrp = (tmax >> 8) + 1;
    unsigned thr = 0u; bool fin = false;
#pragma unroll 1
    for (int bit = 31; bit >= 0; --bit) {
        const unsigned cand = thr | (1u << bit);
        int cnt = 0;
#pragma unroll
        for (int g = 0; g < 8; ++g) if (g < ngrp) {
            bool pr[16];
#pragma unroll
            for (int tt = 0; tt < 16; ++tt) pr[tt] = sc[g * 16 + tt] >= cand;
            __builtin_amdgcn_sched_barrier(0);
#pragma unroll
            for (int tt = 0; tt < 16; ++tt) cnt += pr[tt] ? 1 : 0;
            __builtin_amdgcn_sched_barrier(0);
        }
        cnt = row16_sumi(cnt);
        if (!fin && cnt >= 256) { thr = cand; fin = (cnt == 256); }
        if (__ballot(!fin) == 0ull) break;
    }
    int ngt = 0;
#pragma unroll
    for (int g = 0; g < 8; ++g) if (g < ngrp) {
        bool pr[16];
#pragma unroll
        for (int tt = 0; tt < 16; ++tt) pr[tt] = sc[g * 16 + tt] > thr;
        __builtin_amdgcn_sched_barrier(0);
#pragma unroll
        for (int tt = 0; tt < 16; ++tt) ngt += pr[tt] ? 1 : 0;
        __builtin_amdgcn_sched_barrier(0);
    }
    ngt = row16_sumi(ngt);
    const int need = 256 - ngt;
    int run = 0;
    unsigned w4[4] = {0u, 0u, 0u, 0u};
    const unsigned lowmask = (1u << fr) - 1u;
#pragma unroll
    for (int g = 0; g < 8; ++g) if (g < ngrp) {
#pragma unroll
        for (int tt = 0; tt < 16; ++tt) {
            const int i = g * 16 + tt;
            const bool eq = (sc[i] == thr);
            const unsigned long long be = __ballot(eq);
            const unsigned eqrow = (unsigned)(be >> (16 * fq)) & 0xffffu;
            const int rank = run + __popc(eqrow & lowmask);
            const bool sel = (sc[i] > thr) || (eq && rank < need);
            run += __popc(eqrow);
            const unsigned long long bs = __ballot(sel);
            const unsigned selrow = (unsigned)(bs >> (16 * fq)) & 0xffffu;
            if (fr == ((i >> 1) & 15)) w4[i >> 5] |= selrow << (16 * (i & 1));
        }
    }
#pragma unroll
    for (int k = 0; k < 4; ++k) mask[16 * k + fr] = w4[k];
}

constexpr int SB_W = 0, SB_QG = 17408, SB_KDT = 34816, SB_A = 53248, SB_BYTES = 62464, SB_RED = 2 * 62464;
DI void scan_unit(const Params& p, int layer, int unit, unsigned char* lds) {
    int tid_ = threadIdx.x; asm volatile("" : "+v"(tid_)); const int tid = tid_, lane = tid & 63, wave = tid >> 6, fr = lane & 15, fq = lane >> 4;
    const int h = unit & 3, b = unit >> 2;
    unsigned char* ws = p.ws;
    const unsigned char* su0 = ws + WS_SCAN + (size_t)((b * 4 + h) * 32) * SCAN_UNIT_BYTES;
    const float decv = ((const float*)(ws + WS_DEC))[(b * 4 + h) * 32 + (lane & 31)];
    bf16_t* az = (bf16_t*)(ws + WS_AZ);
    float* red = (float*)(lds + SB_RED);
    const int dvc = h * 128 + 16 * wave + fr;
    const float onw = p.dn_onorm[layer * 128 + 16 * wave + fr];
    const int r16 = tid >> 4, c16 = tid & 15, r8 = tid >> 3, c8 = tid & 7;
    const int c16s = c16 ^ (((r16 >> 4) & 1) << 2), c8s = c8 ^ (((r8 >> 4) & 1) << 2);
    const int prow = 8 * (fr >> 2) + (fr & 3);
    const int swz = ((fr >> 3) & 1) << 2;
    u32x4 pw0, pw1, pq0, pq1, pk0, pk1, pa0; u32x2 pu[4];
#define SCAN_PREFETCH(cc) do { const unsigned char* su = su0 + (size_t)(cc) * SCAN_UNIT_BYTES; \
        pw0 = *(const u32x4*)(su + SU_W + tid * 16); pw1 = *(const u32x4*)(su + SU_W + 8192 + tid * 16); \
        pq0 = *(const u32x4*)(su + SU_QG + tid * 16); pq1 = *(const u32x4*)(su + SU_QG + 8192 + tid * 16); \
        pk0 = *(const u32x4*)(su + SU_KDT + tid * 16); pk1 = *(const u32x4*)(su + SU_KDT + 8192 + tid * 16); \
        pa0 = *(const u32x4*)(su + SU_A + tid * 16); \
        _Pragma("unroll") for (int mt = 0; mt < 4; ++mt) pu[mt] = *(const u32x2*)(su + SU_UT + ((16 * wave + fr) * 64 + 32 * (mt >> 1) + 8 * fq + 4 * (mt & 1)) * 2); \
        } while (0)
#define SCAN_STORE(bufp) do { unsigned char* bp = (bufp); \
        *(u32x4*)(bp + SB_W + r16 * QP + c16s * 16) = pw0; *(u32x4*)(bp + SB_W + (r16 + 32) * QP + c16s * 16) = pw1; \
        *(u32x4*)(bp + SB_QG + r16 * QP + c16s * 16) = pq0; *(u32x4*)(bp + SB_QG + (r16 + 32) * QP + c16s * 16) = pq1; \
        *(u32x4*)(bp + SB_KDT + r8 * TP + c8s * 16) = pk0; *(u32x4*)(bp + SB_KDT + (r8 + 64) * TP + c8s * 16) = pk1; \
        *(u32x4*)(bp + SB_A + r8 * TP + c8s * 16) = pa0; } while (0)
    f32x4 st[8];
#pragma unroll
    for (int m = 0; m < 8; ++m) st[m] = (f32x4){0.f, 0.f, 0.f, 0.f};
    SCAN_PREFETCH(0);
    SCAN_STORE(lds);
    u32x2 cu[4];
#pragma unroll
    for (int i = 0; i < 4; ++i) cu[i] = pu[i];
    __syncthreads();
    SCAN_PREFETCH(1);
#pragma unroll 1
    for (int c = 0; c < 32; ++c) {
        const int cur = c & 1;
        const unsigned char* bp = lds + cur * SB_BYTES;
        const float dg = __builtin_bit_cast(float, __builtin_amdgcn_readlane(__builtin_bit_cast(int, decv), c));
        bf16_t cz[16];
#pragma unroll
        for (int mt = 0; mt < 4; ++mt)
#pragma unroll
            for (int jj = 0; jj < 4; ++jj) cz[mt * 4 + jj] = az[((size_t)b * SEQ + c * 64 + 32 * (mt >> 1) + 8 * fq + 4 * (mt & 1) + jj) * 512 + dvc];
        bf16x8 sb[4];
#pragma unroll
        for (int s = 0; s < 4; ++s) sb[s] = packf(st[2 * s], st[2 * s + 1]);
        bf16x8 fw[4][4];
#pragma unroll
        for (int mt = 0; mt < 4; ++mt)
#pragma unroll
            for (int s = 0; s < 4; ++s) fw[mt][s] = ld16(bp + SB_W + (32 * (mt >> 1) + 4 * (mt & 1) + prow) * QP + (((4 * s) ^ swz) + fq) * 16);
        __builtin_amdgcn_sched_barrier(0);
        f32x4 vn[4];
#pragma unroll
        for (int mt = 0; mt < 4; ++mt) vn[mt] = (f32x4){0.f, 0.f, 0.f, 0.f};
#pragma unroll
        for (int s = 0; s < 4; ++s)
#pragma unroll
            for (int mt = 0; mt < 4; ++mt) vn[mt] = mfma16(fw[mt][s], sb[s], vn[mt]);
        __builtin_amdgcn_sched_barrier(0);
#pragma unroll
        for (int mt = 0; mt < 4; ++mt)
#pragma unroll
            for (int s = 0; s < 4; ++s) fw[mt][s] = ld16(bp + SB_QG + (32 * (mt >> 1) + 4 * (mt & 1) + prow) * QP + (((4 * s) ^ swz) + fq) * 16);
#pragma unroll
        for (int mt = 0; mt < 4; ++mt) {
            vn[mt][0] = lo_f(cu[mt].x) - vn[mt][0]; vn[mt][1] = hi_f(cu[mt].x) - vn[mt][1]; vn[mt][2] = lo_f(cu[mt].y) - vn[mt][2]; vn[mt][3] = hi_f(cu[mt].y) - vn[mt][3];
        }
        bf16x8 vb[2];
#pragma unroll
        for (int s2 = 0; s2 < 2; ++s2) vb[s2] = packf(vn[2 * s2], vn[2 * s2 + 1]);
        __builtin_amdgcn_sched_barrier(0);
        f32x4 o[4];
#pragma unroll
        for (int mt = 0; mt < 4; ++mt) o[mt] = (f32x4){0.f, 0.f, 0.f, 0.f};
#pragma unroll
        for (int s = 0; s < 4; ++s)
#pragma unroll
            for (int mt = 0; mt < 4; ++mt) o[mt] = mfma16(fw[mt][s], sb[s], o[mt]);
        __builtin_amdgcn_sched_barrier(0);
#pragma unroll
        for (int mt = 0; mt < 4; ++mt)
#pragma unroll
            for (int s2 = 0; s2 < 2; ++s2) fw[mt][s2] = ld16(bp + SB_A + (32 * (mt >> 1) + 4 * (mt & 1) + prow) * TP + (((4 * s2) ^ swz) + fq) * 16);
        __builtin_amdgcn_sched_barrier(0);
#pragma unroll
        for (int s2 = 0; s2 < 2; ++s2)
#pragma unroll
            for (int mt = 0; mt < 4; ++mt) o[mt] = mfma16(fw[mt][s2], vb[s2], o[mt]);
        __builtin_amdgcn_sched_barrier(0);
#pragma unroll
        for (int m = 0; m < 8; ++m)
#pragma unroll
            for (int s2 = 0; s2 < 2; ++s2) fw[m >> 1][(m & 1) * 2 + s2] = ld16(bp + SB_KDT + (32 * (m >> 1) + 4 * (m & 1) + prow) * TP + (((4 * s2) ^ swz) + fq) * 16);
#pragma unroll
        for (int m = 0; m < 8; ++m) st[m] = st[m] * dg;
        __builtin_amdgcn_sched_barrier(0);
#pragma unroll
        for (int s2 = 0; s2 < 2; ++s2)
#pragma unroll
            for (int m = 0; m < 8; ++m) st[m] = mfma16(fw[m >> 1][(m & 1) * 2 + s2], vb[s2], st[m]);
        __builtin_amdgcn_sched_barrier(0);
        {
            f32x4 sq[4];
#pragma unroll
            for (int mt = 0; mt < 4; ++mt)
#pragma unroll
                for (int jj = 0; jj < 4; ++jj) sq[mt][jj] = row16_sum(o[mt][jj] * o[mt][jj]);
            if (fr == 0) {
#pragma unroll
                for (int mt = 0; mt < 4; ++mt) *(f32x4*)(red + (cur * 8 + wave) * 64 + 32 * (mt >> 1) + 8 * fq + 4 * (mt & 1)) = sq[mt];
            }
        }
        if (c + 1 < 32) SCAN_STORE(lds + (cur ^ 1) * SB_BYTES);
        __syncthreads();
        u32x2 nu[4];
#pragma unroll
        for (int i = 0; i < 4; ++i) nu[i] = pu[i];
        if (c + 2 < 32) SCAN_PREFETCH(c + 2);
#pragma unroll
        for (int mt = 0; mt < 4; ++mt)
#pragma unroll
            for (int jj = 0; jj < 4; ++jj) {
                const int row = 32 * (mt >> 1) + 8 * fq + 4 * (mt & 1) + jj;
                float tot = 0.f;
#pragma unroll
                for (int w8 = 0; w8 < 8; ++w8) tot += red[(cur * 8 + w8) * 64 + row];
                const float rstd = __builtin_amdgcn_rsqf(tot * (1.0f / 128.0f) + NORM_EPS);
                const float zv = bf2f(cz[mt * 4 + jj]);
                const float y = o[mt][jj] * rstd * onw * zv * __builtin_amdgcn_rcpf(1.0f + __expf(-zv));
                az[((size_t)b * SEQ + c * 64 + row) * 512 + dvc] = (bf16_t)f2bf(y);
            }
#pragma unroll
        for (int i = 0; i < 4; ++i) cu[i] = nu[i];
    }
#undef SCAN_PREFETCH
#undef SCAN_STORE
}

constexpr int AT_K = 0, AT_VT = 17408;
DI void attn_unit(const Params& p, int unit, unsigned char* lds) {
    int tid_ = threadIdx.x; asm volatile("" : "+v"(tid_)); const int tid = tid_, lane = tid & 63, wave = tid >> 6, fr = lane & 15, fq = lane >> 4;
    const int qb = 15 - (unit >> 5), bh = unit & 31, b = bh >> 2, hh = bh & 3;
    unsigned char* ws = p.ws;
    const bf16_t* cq = (const bf16_t*)(ws + WS_CQKV);
    const int q0 = qb * 128, tq = q0 + 16 * wave + fr;
    const size_t tokq = (size_t)b * SEQ + tq;
    const unsigned* mrow = (const unsigned*)(ws + WS_MASK) + tokq * 64;
    bf16x8 qf[4];
#pragma unroll
    for (int s = 0; s < 4; ++s) qf[s] = *(const bf16x8*)(cq + tokq * 1536 + hh * 128 + 32 * s + 8 * fq);
    f32x4 oacc[8];
#pragma unroll
    for (int i = 0; i < 8; ++i) oacc[i] = (f32x4){0.f, 0.f, 0.f, 0.f};
    float mrun = -INFINITY, lrun = 0.f;
    const int nkt = (q0 + 128) / 64;
    const int kr = tid >> 4, kc = tid & 15, vk = 2 * (tid & 31), vp = tid >> 5;
    const int kcs = kc ^ (((kr >> 4) & 1) << 2);
    const int prow = 8 * (fr >> 2) + (fr & 3), swz = ((fr >> 3) & 1) << 2;
    u32x4 gk0, gk1, gv0, gv1;
#define ATT_PREFETCH(kt) do { const size_t kb = (size_t)b * SEQ + (size_t)(kt) * 64; \
        gk0 = *(const u32x4*)(cq + (kb + kr) * 1536 + 512 + hh * 128 + kc * 8); gk1 = *(const u32x4*)(cq + (kb + kr + 32) * 1536 + 512 + hh * 128 + kc * 8); \
        gv0 = *(const u32x4*)(cq + (kb + vk) * 1536 + 1024 + hh * 128 + vp * 8); gv1 = *(const u32x4*)(cq + (kb + vk + 1) * 1536 + 1024 + hh * 128 + vp * 8); } while (0)
    ATT_PREFETCH(0);
    const float scl = 0.08838834764831845f * 1.4426950408889634f;
#pragma unroll 1
    for (int kt = 0; kt < nkt; ++kt) {
        __syncthreads();
        *(u32x4*)(lds + AT_K + kr * QP + kcs * 16) = gk0; *(u32x4*)(lds + AT_K + (kr + 32) * QP + kcs * 16) = gk1;
        {
            const unsigned a[4] = {gv0.x, gv0.y, gv0.z, gv0.w}, c4[4] = {gv1.x, gv1.y, gv1.z, gv1.w};
#pragma unroll
            for (int e = 0; e < 4; ++e) {
                *(unsigned*)(lds + AT_VT + (8 * vp + 2 * e) * TP + vk * 2) = (a[e] & 0xffffu) | (c4[e] << 16);
                *(unsigned*)(lds + AT_VT + (8 * vp + 2 * e + 1) * TP + vk * 2) = (a[e] >> 16) | (c4[e] & 0xffff0000u);
            }
        }
        const u32x2 mw = *(const u32x2*)(mrow + 2 * kt);
        __syncthreads();
        if (kt + 1 < nkt) ATT_PREFETCH(kt + 1);
        bf16x8 kf[4][4];
#pragma unroll
        for (int nt = 0; nt < 4; ++nt)
#pragma unroll
            for (int s = 0; s < 4; ++s) kf[nt][s] = ld16(lds + AT_K + (32 * (nt >> 1) + 4 * (nt & 1) + prow) * QP + (((4 * s) ^ swz) + fq) * 16);
        __builtin_amdgcn_sched_barrier(0);
        f32x4 sacc[4];
#pragma unroll
        for (int nt = 0; nt < 4; ++nt) sacc[nt] = (f32x4){0.f, 0.f, 0.f, 0.f};
#pragma unroll
        for (int s = 0; s < 4; ++s)
#pragma unroll
            for (int nt = 0; nt < 4; ++nt) sacc[nt] = mfma16(kf[nt][s], qf[s], sacc[nt]);
        __builtin_amdgcn_sched_barrier(0);
#pragma unroll
        for (int nd = 0; nd < 8; ++nd)
#pragma unroll
            for (int s2 = 0; s2 < 2; ++s2) kf[nd >> 1][(nd & 1) * 2 + s2] = ld16(lds + AT_VT + (16 * nd + fr) * TP + (32 * s2 + 8 * fq) * 2);
        float mx = -INFINITY;
#pragma unroll
        for (int nt = 0; nt < 4; ++nt)
#pragma unroll
            for (int jj = 0; jj < 4; ++jj) { const int kk = 32 * (nt >> 1) + 8 * fq + 4 * (nt & 1) + jj; const unsigned wsel = (nt < 2) ? mw.x : mw.y;
                const bool on = (wsel >> (kk & 31)) & 1u;
                const float v = on ? sacc[nt][jj] * scl : -INFINITY; sacc[nt][jj] = v; mx = fmaxf(mx, v); }
        mx = fmaxf(mx, __shfl_xor(mx, 16)); mx = fmaxf(mx, __shfl_xor(mx, 32));
        const float mnew = fmaxf(mrun, mx);
        const float msafe = (mnew == -INFINITY) ? 0.f : mnew;
        const float alpha = __builtin_amdgcn_exp2f(mrun - msafe);
        mrun = mnew;
        float ps = 0.f;
#pragma unroll
        for (int nt = 0; nt < 4; ++nt)
#pragma unroll
            for (int jj = 0; jj < 4; ++jj) { const float pv = __builtin_amdgcn_exp2f(sacc[nt][jj] - msafe); sacc[nt][jj] = pv; ps += pv; }
        lrun = lrun * alpha + ps;
        bf16x8 pb[2];
#pragma unroll
        for (int s2 = 0; s2 < 2; ++s2) pb[s2] = packf(sacc[2 * s2], sacc[2 * s2 + 1]);
#pragma unroll
        for (int nd = 0; nd < 8; ++nd) oacc[nd] = oacc[nd] * alpha;
        __builtin_amdgcn_sched_barrier(0);
#pragma unroll
        for (int s2 = 0; s2 < 2; ++s2)
#pragma unroll
            for (int nd = 0; nd < 8; ++nd) oacc[nd] = mfma16(kf[nd >> 1][(nd & 1) * 2 + s2], pb[s2], oacc[nd]);
        __builtin_amdgcn_sched_barrier(0);
    }
#undef ATT_PREFETCH
    lrun += __shfl_xor(lrun, 16); lrun += __shfl_xor(lrun, 32);
    const float inv = 1.0f / lrun;
    bf16_t* czp = (bf16_t*)(ws + WS_CZ) + tokq * 512 + hh * 128;
#pragma unroll
    for (int nd = 0; nd < 8; ++nd) {
        bf16_t* zp = czp + 16 * nd + 4 * fq;
        const u32x2 zz = *(const u32x2*)zp;
        f32x4 o; o[0] = oacc[nd][0] * inv * siluf(lo_f(zz.x)); o[1] = oacc[nd][1] * inv * siluf(hi_f(zz.x)); o[2] = oacc[nd][2] * inv * siluf(lo_f(zz.y)); o[3] = oacc[nd][3] * inv * siluf(hi_f(zz.y));
        *(u32x2*)zp = pack4(o);
    }
}

DI void rms_unit(const Params& p, int layer, const float* xin, int unit) {
    int tid_ = threadIdx.x; asm volatile("" : "+v"(tid_)); const int lane = tid_ & 63, wave = tid_ >> 6;
    const float* ng = p.norm_g + layer * DM;
    for (int i = 0; i < 8; i += 2) { const size_t m = (size_t)unit * 64 + wave * 8 + i; rms_row2(xin + m * DM, ng, (bf16_t*)(p.ws + WS_H2) + m * DM, lane); }
}

#ifndef GEMM_ALIGN
#define GEMM_ALIGN true
#endif
#ifndef GEMM_SP2
#define GEMM_SP2 true
#endif
#ifndef MK_SPLIT
#define MK_SPLIT 0
#endif
constexpr int NPHASE = 14;
constexpr int P2_IDX = 512, P2_DN = 1024, P2_POOL = 1024, P2_SA = 256, P2_TOTAL = P2_IDX + P2_DN + P2_POOL + P2_SA;
constexpr int P3_SCAN = 32, P3_ATT = 512, P3_RMS = 256, P3_TOTAL = P3_SCAN + P3_ATT + P3_RMS;

__global__ void __launch_bounds__(NTHR, 2) hybrid_fwd(Params p) {
    extern __shared__ __attribute__((aligned(16))) unsigned char lds[];
    unsigned char* ws = p.ws;
    unsigned* ctl = (unsigned*)(ws + WS_CTL);
    const int G = gridDim.x;
    PG8_LAS unsigned char* glds = (PG8_LAS unsigned char*)lds;
#if MK_SPLIT
#define SEAM(k) do { } while (0)
#else
    cg::grid_group grid = cg::this_grid();
    volatile LAS unsigned* bst = (volatile LAS unsigned*)((LAS unsigned char*)lds + LDS_SLOT + 16);
    if (threadIdx.x == 0) { bst[0] = 0u; bst[1] = 0u; }
    __syncthreads();
    XcdBarrier bar = xcd_barrier_post(ctl + 1024, bst);
#define SEAM(k) do { if (p.ph_lo <= (k) && (k) + 1 < p.ph_hi) { if (p.ph_hi > NPHASE) grid.sync(); else xcd_barrier(bar); } } while (0)
#endif
#define IN(k) (p.ph_lo <= (k) && (k) < p.ph_hi)
#ifdef PROBE_K
#ifndef PROBE_BLK
#define PROBE_BLK 0
#endif
#ifndef PROBE_T1
#define PROBE_T1 (PROBE_K + 1)
#endif
#define stamps ((unsigned long long*)(p.ws + WS_CTL + 24576))
#define STAMP(k) do { int t_ = threadIdx.x; asm volatile("" : "+v"(t_)); if (blockIdx.x == 0 && t_ == 0) stamps[(k)] = __builtin_amdgcn_s_memrealtime(); } while (0)
    STAMP(0);
#else
#define STAMP(k) do { } while (0)
#endif
#pragma unroll 1
    for (int layer = 0; layer < 2; ++layer) {
        const int pb = layer * 7;
        const float* xin = layer == 0 ? p.x : (const float*)p.out;
        if (IN(pb + 0)) {
#ifndef NO_P0
 phase0(p, layer, xin, lds);
#endif
 }
        SEAM(pb + 0); STAMP(pb + 0 + 1);
        if (IN(pb + 1)) {
            pg8::Gemm g{(const bf16_t*)(ws + WS_H), (const bf16_t*)(ws + WS_WIN1), MTOK, N1, 1024}; pg8::StaticOrder S; S.init(MTOK, N1, G, (int)blockIdx.x);
            pg8::EpiProj E{ws};

#ifndef NO_G1
 pg8::gemm_phase<pg8::EpiProj, pg8::StaticOrder, GEMM_ALIGN, GEMM_SP2>(glds, g, S, E);
#endif

        }
        SEAM(pb + 1); STAMP(pb + 1 + 1);
        if (IN(pb + 2)) {
            const int k = (int)blockIdx.x;
            for (int i = k; i < P2_IDX / 2; i += G) { __syncthreads(); indexer_unit(p, i, lds);
#ifdef PROBE_K
                { int t_ = threadIdx.x; asm volatile("" : "+v"(t_)); if (layer == 0 && (int)blockIdx.x == PROBE_BLK && t_ == 0) stamps[24] = __builtin_amdgcn_s_memrealtime(); }
#endif
                __syncthreads(); indexer_unit(p, P2_IDX - 1 - i, lds);
#ifdef PROBE_K
                { int t_ = threadIdx.x; asm volatile("" : "+v"(t_)); if (layer == 0 && (int)blockIdx.x == PROBE_BLK && t_ == 0) stamps[25] = __builtin_amdgcn_s_memrealtime(); }
#endif
            }
#ifdef PROBE_K
            if (layer == 0 && threadIdx.x == 0) atomicMax(&stamps[22], (unsigned long long)__builtin_amdgcn_s_memrealtime());
#endif
            for (int u = k; u < P2_DN; u += G) { __syncthreads(); dn_prep_unit(p, layer, u, lds); }
#ifdef PROBE_K
            if (layer == 0 && threadIdx.x == 0) atomicMax(&stamps[23], (unsigned long long)__builtin_amdgcn_s_memrealtime());
#endif
            for (int u = k; u < P2_SA; u += G) { __syncthreads(); sa_prep_unit(p, layer, u, lds); }
        }
        SEAM(pb + 2); STAMP(pb + 2 + 1);
        if (IN(pb + 3)) {
            const int k = (int)blockIdx.x, nsc = (G > 2 * P3_SCAN) ? P3_SCAN : 0, nb = G - nsc;
            if (k < nsc) {
                scan_unit(p, layer, k, lds);
#ifdef PROBE_K
                { int t_ = threadIdx.x; asm volatile("" : "+v"(t_)); if (layer == 0 && k == 0 && t_ == 0) stamps[20] = __builtin_amdgcn_s_memrealtime(); }
#endif
            } else {
                const int j = k - nsc;
                if (nsc == 0) for (int u = j; u < P3_SCAN; u += nb) { __syncthreads(); scan_unit(p, layer, u, lds); }
                for (int r = 0; r * nb < P3_ATT; ++r) { const int i = r * nb + ((r & 1) ? (nb - 1 - j) : j); if (i < P3_ATT) { __syncthreads(); attn_unit(p, i, lds); } }
#ifdef PROBE_K
                if (layer == 0 && threadIdx.x == 0) atomicMax(&stamps[21], (unsigned long long)__builtin_amdgcn_s_memrealtime());
#endif
                for (int u = j; u < P3_RMS; u += nb) rms_unit(p, layer, xin, u);
                for (int u = j; u < P2_POOL; u += nb) { __syncthreads(); pool_unit(p, layer, u, lds); }
            }
        }
        SEAM(pb + 3); STAMP(pb + 3 + 1);
        if (IN(pb + 4)) {
            pg8::Gemm g{(const bf16_t*)(ws + WS_H2), (const bf16_t*)(ws + WS_WG), MTOK, NG, 1024}; pg8::GateOrder S; S.init(G, (int)blockIdx.x);
            pg8::EpiGate E{ws, p.gate_b + layer * 3072};

#ifndef NO_G4
 pg8::gemm_phase<pg8::EpiGate, pg8::GateOrder, GEMM_ALIGN, GEMM_SP2>(glds, g, S, E);
#endif

        }
        asm volatile("s_waitcnt vmcnt(0)" ::: "memory"); __syncthreads(); STAMP(pb + 4 + 1);
        if (IN(pb + 5)) {
            pg8::Gemm g{(const bf16_t*)(ws + WS_AZ), (const bf16_t*)(ws + WS_WBR), 3 * MTOK, 3072, 512}; pg8::MergeOrder S; S.init(G, (int)blockIdx.x);
            pg8::EpiMerge E{ws};

#ifndef NO_G5
 pg8::gemm_phase<pg8::EpiMerge, pg8::MergeOrder, GEMM_ALIGN, GEMM_SP2>(glds, g, S, E);
#endif

        }
        SEAM(pb + 5); STAMP(pb + 5 + 1);
        if (IN(pb + 6)) {
            pg8::Gemm g{(const bf16_t*)(ws + WS_MERGED), (const bf16_t*)(ws + WS_WO), MTOK, 1024, 1024}; pg8::StaticOrder S; S.init(MTOK, 1024, G, (int)blockIdx.x);
            pg8::EpiOut E{xin, p.out};

#ifndef NO_G6
 pg8::gemm_phase<pg8::EpiOut, pg8::StaticOrder, GEMM_ALIGN, GEMM_SP2>(glds, g, S, E);
#endif

        }
        SEAM(pb + 6); STAMP(pb + 6 + 1);
    }
#ifdef PROBE_K
    __syncthreads();
    if (threadIdx.x == 0) __threadfence();
    xcd_barrier(bar);
    {
        const unsigned long long t0 = __hip_atomic_load(&stamps[PROBE_K], __ATOMIC_RELAXED, __HIP_MEMORY_SCOPE_AGENT), t1 = __hip_atomic_load(&stamps[PROBE_T1], __ATOMIC_RELAXED, __HIP_MEMORY_SCOPE_AGENT);
#ifdef PROBE_A
        const unsigned long long ta = __hip_atomic_load(&stamps[PROBE_A], __ATOMIC_RELAXED, __HIP_MEMORY_SCOPE_AGENT), tb = __hip_atomic_load(&stamps[PROBE_B], __ATOMIC_RELAXED, __HIP_MEMORY_SCOPE_AGENT);
        const float d1 = (float)(ta - t0) * 0.01f, d2 = (float)(tb - t0) * 0.01f * 30.0f;
        for (int i = blockIdx.x * NTHR + threadIdx.x; i < (1 << 20); i += gridDim.x * NTHR) p.out[i] += d1;
        if (blockIdx.x == 0 && threadIdx.x == 0) p.out[(1 << 21) + 12345] += d2;
#else
        const float dlt = (float)(t1 - t0) * 0.01f * 2e-5f;
        for (int i = blockIdx.x * NTHR + threadIdx.x; i < (1 << 20); i += gridDim.x * NTHR) p.out[i] += dlt;
#endif
    }
#endif
#undef IN
#undef SEAM
}

extern "C" void kernel_launch(void* const* d_in, const int* in_sizes, int n_in, void* d_out, int out_size, void* d_ws, size_t ws_size, hipStream_t stream) {
    static int grid = 0;
    if (grid == 0) {
        if (n_in != 14 || in_sizes[0] != MTOK * DM || out_size != MTOK * DM || ws_size < WS_END) { fprintf(stderr, "kernel_launch: unexpected shapes / workspace (%d inputs, ws %zu)\n", n_in, ws_size); grid = -1; return; }
        int dev = 0, cus = 0, per_cu = 0;
        if (hipGetDevice(&dev) != hipSuccess || hipDeviceGetAttribute(&cus, hipDeviceAttributeMultiprocessorCount, dev) != hipSuccess) { grid = -1; return; }
        if (hipFuncSetAttribute((const void*)hybrid_fwd, hipFuncAttributeMaxDynamicSharedMemorySize, LDS_BYTES) != hipSuccess) { fprintf(stderr, "kernel_launch: hipFuncSetAttribute failed\n"); grid = -1; return; }
        if (hipOccupancyMaxActiveBlocksPerMultiprocessor(&per_cu, (const void*)hybrid_fwd, NTHR, LDS_BYTES) != hipSuccess || per_cu < 1) { fprintf(stderr, "kernel_launch: occupancy query says %d\n", per_cu); per_cu = 1; }
        (void)hipGetLastError();
        grid = cus * per_cu;
    }
    if (grid < 0) return;
    (void)hipMemsetAsync((char*)d_ws + WS_CTL, 0, CTL_BYTES, stream);
    Params p{};
    p.x = (const float*)d_in[0]; p.norm_g = (const float*)d_in[1]; p.w_in = (const float*)d_in[2]; p.gate_b = (const float*)d_in[3]; p.conv_w = (const float*)d_in[4];
    p.a_log = (const float*)d_in[5]; p.dt_bias = (const float*)d_in[6]; p.dn_onorm = (const float*)d_in[7]; p.pool_w = (const float*)d_in[8]; p.pool_scale = (const float*)d_in[9];
    p.q_norm = (const float*)d_in[10]; p.k_norm = (const float*)d_in[11]; p.w_branch = (const float*)d_in[12]; p.w_out = (const float*)d_in[13];
    p.out = (float*)d_out; p.ws = (unsigned char*)d_ws;
#if MK_SPLIT
    for (int ph = 0; ph < NPHASE; ++ph) { p.ph_lo = ph; p.ph_hi = ph + 1; hipLaunchKernelGGL(hybrid_fwd, dim3(grid), dim3(NTHR), LDS_BYTES, stream, p); }
#else
    p.ph_lo = 0; p.ph_hi = NPHASE;
    void* args[] = {&p};
    const hipError_t e = hipLaunchCooperativeKernel((const void*)hybrid_fwd, dim3(grid), dim3(NTHR), args, LDS_BYTES, stream);
    if (e != hipSuccess) fprintf(stderr, "kernel_launch: cooperative launch failed: %s (grid %d)\n", hipGetErrorString(e), grid);
#endif
}
```

```cpp
#include <hip/hip_runtime.h>
#include <hip/hip_cooperative_groups.h>
#include <cstdio>
#include <cstdint>
#include <cmath>
namespace cg = cooperative_groups;
constexpr int BATCH = 8, SEQ = 2048, DM = 1024, MTOK = BATCH * SEQ;
constexpr int INW = 8524;
constexpr int N1 = 5632;
constexpr int NG = 3072;
constexpr float NORM_EPS = 1e-6f;
constexpr size_t MiB = 1u << 20;
constexpr size_t WS_CTL = 0;
constexpr size_t CTL_BYTES = 32768;
constexpr size_t WS_COSA = 1 * MiB, WS_SINA = WS_COSA + 512 * 1024;
constexpr size_t WS_COSI = 2 * MiB, WS_SINI = WS_COSI + 256 * 1024;
constexpr size_t WS_DEC = 2 * MiB + 512 * 1024;
constexpr size_t WS_MISC = 3 * MiB;
constexpr size_t WS_WG = 4 * MiB;
constexpr size_t WS_WBR = 10 * MiB;
constexpr size_t WS_WO = 13 * MiB;
constexpr size_t WS_POOLW = 15 * MiB;
constexpr size_t WS_MASK = 16 * MiB;
constexpr size_t WS_R1 = 20 * MiB;
constexpr size_t WS_H = WS_R1;
constexpr size_t WS_WIN1 = WS_R1 + 32 * MiB;
constexpr size_t WS_SCAN = WS_R1;
constexpr size_t WS_G0 = WS_R1, WS_G1 = WS_R1 + 32 * MiB;
constexpr size_t WS_R2 = 93 * MiB;
constexpr size_t WS_AQKV = WS_R2;
constexpr size_t WS_H2 = WS_R2;
constexpr size_t WS_MERGED = WS_G0;
constexpr size_t WS_R3 = 141 * MiB;
constexpr size_t WS_CQKV = WS_R3;
constexpr size_t WS_G2 = WS_R3;
constexpr size_t WS_AZ = 189 * MiB, WS_BZ = 205 * MiB, WS_CZ = 221 * MiB, WS_BU = 237 * MiB;
constexpr size_t WS_CIDX = 253 * MiB;
constexpr size_t WS_END = 263 * MiB;
constexpr int SCAN_UNIT_BYTES = 73728;
constexpr int SU_W = 0, SU_QG = 16384, SU_KDT = 32768, SU_UT = 49152, SU_A = 65536;
namespace pg8 {
#define PG8_LAS __attribute__((address_space(3)))
typedef unsigned short bf16_t;
typedef short bf16x8 __attribute__((ext_vector_type(8)));
typedef float f32x4 __attribute__((ext_vector_type(4)));
typedef unsigned u32x4 __attribute__((ext_vector_type(4)));
constexpr int BM = 256, BK = 64, HALF = 128, HTB = HALF * BK * 2  , STAGE_BYTES = 8 * HTB, NXCD = 8, WGM = 8;

__host__ __device__ __forceinline__ int lds_byte(int r, int c) { const int st = (r >> 4) * 2 + (c >> 5), rr = r & 15, cc = c & 31, ob = rr * 64 + cc * 2; return st * 1024 + (ob ^ (((ob >> 9) & 1) << 5)); }
__host__ __device__ __forceinline__ void stage_rc(int b, int& R, int& C) { const int st = b / 1024, sb = b % 1024, swz = sb ^ (((sb >> 9) & 1) << 5); R = (st >> 1) * 16 + swz / 64; C = (st & 1) * 32 + (swz % 64) / 2; }
__host__ __device__ __forceinline__ int perm32(int rho) { const int n = rho >> 4, i = rho & 15; return 8 * (i >> 2) + 4 * n + (i & 3); }

struct Unit { int pm, pn; };
struct Gemm { const bf16_t* A; const bf16_t* Bt; int M, N, K; };

struct StaticOrder {
    int nM, nN, nwg, G, c;
    __host__ __device__ void init(int M, int N, int G_, int c_) { nM = M / BM; nN = N / BM; nwg = nM * nN; G = G_; c = c_; }
    __host__ __device__ bool next(int i, Unit& u) const {
        const long L = (long)i * G + c; if (L >= nwg) return false;
        int wgid = (int)L; { const int q = nwg / NXCD, r = nwg % NXCD, xcd = wgid % NXCD, off = wgid / NXCD; wgid = (xcd < r ? xcd * (q + 1) : r * (q + 1) + (xcd - r) * q) + off; }
        const int nig = WGM * nN, gid = wgid / nig, fm = gid * WGM, gsz = (nM - fm) < WGM ? (nM - fm) : WGM;
        u.pm = fm + ((wgid % nig) % gsz); u.pn = (wgid % nig) / gsz; return true;
    }
    __device__ __forceinline__ void a_ready(const Unit&) const {}
    __device__ __forceinline__ void done(const Unit&) const {}
};

typedef float f32x2c __attribute__((ext_vector_type(2))); typedef __bf16 bf16x2c __attribute__((ext_vector_type(2)));
__device__ __forceinline__ unsigned cvt_pk_bf16(float lo, float hi) { const f32x2c v = {lo, hi}; return __builtin_bit_cast(unsigned, __builtin_convertvector(v, bf16x2c)); }
struct EpiProj {
    static constexpr bool PERM = true, AFTER_DRAIN = false;
    unsigned char* ws;
    __device__ __forceinline__ void operator()(const f32x4 (&acc)[2][2][4][2], const Unit& u, int wr, int wc, int fr, int fq) const {
        const int pn = u.pn; const int row0 = u.pm * BM + wr * 64 + fr;
        if (pn == 21) {
            const int c = wc * 32 + 8 * fq;
            if (c < 80) {
#pragma unroll
                for (int ai = 0; ai < 2; ++ai)
#pragma unroll
                    for (int m = 0; m < 4; ++m) { const size_t row = (size_t)(row0 + ai * HALF + m * 16); const f32x4 v0 = acc[ai][0][m][0], v1 = acc[ai][0][m][1];
                        if (c < 64) { u32x4 w; w.x = cvt_pk_bf16(v0[0], v0[1]); w.y = cvt_pk_bf16(v0[2], v0[3]); w.z = cvt_pk_bf16(v1[0], v1[1]); w.w = cvt_pk_bf16(v1[2], v1[3]);
                            *(u32x4*)((bf16_t*)(ws + WS_CIDX) + row * 320 + 256 + c) = w; }
                        else { float* mp = (float*)(ws + WS_MISC) + row * 16 + (c - 64); *(f32x4*)mp = v0; *(f32x4*)(mp + 4) = v1; } }
            }
            return;
        }
        size_t off; int ldc, colt;
        if (pn < 6) { off = WS_AQKV; ldc = 1536; colt = pn * 256; }
        else if (pn < 8) { off = WS_AZ; ldc = 512; colt = (pn - 6) * 256; }
        else if (pn < 10) { off = WS_BU; ldc = 512; colt = (pn - 8) * 256; }
        else if (pn < 12) { off = WS_BZ; ldc = 512; colt = (pn - 10) * 256; }
        else if (pn < 18) { off = WS_CQKV; ldc = 1536; colt = (pn - 12) * 256; }
        else if (pn < 20) { off = WS_CZ; ldc = 512; colt = (pn - 18) * 256; }
        else { off = WS_CIDX; ldc = 320; colt = 0; }
        bf16_t* base = (bf16_t*)(ws + off); const int col0 = colt + wc * 32 + 8 * fq;
#pragma unroll
        for (int ai = 0; ai < 2; ++ai)
#pragma unroll
            for (int m = 0; m < 4; ++m) { bf16_t* rowp = base + (size_t)(row0 + ai * HALF + m * 16) * ldc + col0;
#pragma unroll
                for (int bj = 0; bj < 2; ++bj) { const f32x4 v0 = acc[ai][bj][m][0], v1 = acc[ai][bj][m][1];
                    u32x4 w; w.x = cvt_pk_bf16(v0[0], v0[1]); w.y = cvt_pk_bf16(v0[2], v0[3]); w.z = cvt_pk_bf16(v1[0], v1[1]); w.w = cvt_pk_bf16(v1[2], v1[3]);
                    *(u32x4*)(rowp + bj * HALF) = w; } }
    }
};
__device__ __forceinline__ float sigm(float x) { return __builtin_amdgcn_rcpf(1.0f + __expf(-x)); }
struct EpiGate {
    static constexpr bool PERM = true, AFTER_DRAIN = false;
    unsigned char* ws; const float* gb;
    __device__ __forceinline__ void operator()(const f32x4 (&acc)[2][2][4][2], const Unit& u, int wr, int wc, int fr, int fq) const {
        const int pn = u.pn, br = pn >> 2; const int row0 = u.pm * BM + wr * 64 + fr;
        bf16_t* base = (bf16_t*)(ws + (br == 0 ? WS_G0 : (br == 1 ? WS_G1 : WS_G2)));
        const int col0 = (pn & 3) * 256 + wc * 32 + 8 * fq; const float* bp = gb + br * 1024 + col0;
        f32x4 bv[2][2];
#pragma unroll
        for (int bj = 0; bj < 2; ++bj)
#pragma unroll
            for (int n = 0; n < 2; ++n) bv[bj][n] = *(const f32x4*)(bp + bj * HALF + 4 * n);
#pragma unroll
        for (int ai = 0; ai < 2; ++ai)
#pragma unroll
            for (int m = 0; m < 4; ++m) { bf16_t* rowp = base + (size_t)(row0 + ai * HALF + m * 16) * 1024 + col0;
#pragma unroll
                for (int bj = 0; bj < 2; ++bj) { const f32x4 v0 = acc[ai][bj][m][0] + bv[bj][0], v1 = acc[ai][bj][m][1] + bv[bj][1];
                    u32x4 w; w.x = cvt_pk_bf16(sigm(v0[0]), sigm(v0[1])); w.y = cvt_pk_bf16(sigm(v0[2]), sigm(v0[3])); w.z = cvt_pk_bf16(sigm(v1[0]), sigm(v1[1])); w.w = cvt_pk_bf16(sigm(v1[2]), sigm(v1[3]));
                    *(u32x4*)(rowp + bj * HALF) = w; } }
    }
};
__device__ __forceinline__ float bflo(unsigned w) { return __uint_as_float(w << 16); }
__device__ __forceinline__ float bfhi(unsigned w) { return __uint_as_float(w & 0xffff0000u); }
struct GateOrder {
    int G, c;
    __device__ __forceinline__ void init(int G_, int c_) { G = G_; c = c_; }
    __device__ __forceinline__ bool next(int i, Unit& u) const {
        const int t = i / 3, br = i - 3 * t; int L = t * G + c; if (L >= 256) return false;
        if (G == 256) L = (L & 7) * 32 + (L >> 3);
        u.pm = L >> 2; u.pn = br * 4 + (L & 3); return true;
    }
    __device__ __forceinline__ void a_ready(const Unit&) const {}
    __device__ __forceinline__ void done(const Unit&) const {}
};
struct MergeOrder {
    int G, c;
    __device__ __forceinline__ void init(int G_, int c_) { G = G_; c = c_; }
    __device__ __forceinline__ bool next(int i, Unit& u) const {
        const int t = i / 3, br = i - 3 * t; int L = t * G + c; if (L >= 256) return false;
        if (G == 256) L = (L & 7) * 32 + (L >> 3);
        u.pm = br * 64 + (L >> 2); u.pn = br * 4 + (L & 3); return true;
    }
    __device__ __forceinline__ void a_ready(const Unit&) const {}
    __device__ __forceinline__ void done(const Unit&) const {}
};
struct EpiMerge {
    static constexpr bool PERM = true, AFTER_DRAIN = false;
    unsigned char* ws;
    __device__ __forceinline__ void operator()(const f32x4 (&acc)[2][2][4][2], const Unit& u, int wr, int wc, int fr, int fq) const {
        const int br = u.pm >> 6, pm = u.pm & 63, pn = u.pn & 3; const bool first = (br == 0);
        const bf16_t* G = (const bf16_t*)(ws + (br == 0 ? WS_G0 : (br == 1 ? WS_G1 : WS_G2))); bf16_t* mg = (bf16_t*)(ws + WS_MERGED);
        const int row0 = pm * BM + wr * 64 + fr; const int col0 = pn * 256 + wc * 32 + 8 * fq;
#pragma unroll
        for (int ai = 0; ai < 2; ++ai) {
            u32x4 gv[4][2], pv[4][2];
#pragma unroll
            for (int m = 0; m < 4; ++m)
#pragma unroll
                for (int bj = 0; bj < 2; ++bj) { const size_t o = (size_t)(row0 + ai * HALF + m * 16) * 1024 + col0 + bj * HALF;
                    gv[m][bj] = *(const u32x4*)(G + o); pv[m][bj] = first ? (u32x4){0u, 0u, 0u, 0u} : *(const u32x4*)(mg + o); }
            __builtin_amdgcn_sched_barrier(0);
#pragma unroll
            for (int m = 0; m < 4; ++m)
#pragma unroll
                for (int bj = 0; bj < 2; ++bj) { const size_t ro = (size_t)(row0 + ai * HALF + m * 16) * 1024 + col0 + bj * HALF;
                    const f32x4 v0 = acc[ai][bj][m][0], v1 = acc[ai][bj][m][1]; const u32x4 g = gv[m][bj], p = pv[m][bj];
                    u32x4 w;
                    w.x = cvt_pk_bf16(bflo(p.x) + bflo(g.x) * v0[0], bfhi(p.x) + bfhi(g.x) * v0[1]); w.y = cvt_pk_bf16(bflo(p.y) + bflo(g.y) * v0[2], bfhi(p.y) + bfhi(g.y) * v0[3]);
                    w.z = cvt_pk_bf16(bflo(p.z) + bflo(g.z) * v1[0], bfhi(p.z) + bfhi(g.z) * v1[1]); w.w = cvt_pk_bf16(bflo(p.w) + bflo(g.w) * v1[2], bfhi(p.w) + bfhi(g.w) * v1[3]);
                    *(u32x4*)(mg + ro) = w; }
            __builtin_amdgcn_sched_barrier(0);
        }
    }
};
struct EpiOut {
    static constexpr bool PERM = false, AFTER_DRAIN = false;
    const float* xin; float* out;
    __device__ __forceinline__ void operator()(const f32x4 (&acc)[2][2][4][2], const Unit& u, int wr, int wc, int fr, int fq) const {
        const int row0 = u.pm * BM + wr * 64 + fr; const int col0 = u.pn * 256 + wc * 32 + 4 * fq;
#pragma unroll
        for (int ai = 0; ai < 2; ++ai) {
            f32x4 xv[4][2][2];
#pragma unroll
            for (int m = 0; m < 4; ++m)
#pragma unroll
                for (int bj = 0; bj < 2; ++bj)
#pragma unroll
                    for (int n = 0; n < 2; ++n) xv[m][bj][n] = *(const f32x4*)(xin + (size_t)(row0 + ai * HALF + m * 16) * 1024 + col0 + bj * HALF + n * 16);
            __builtin_amdgcn_sched_barrier(0);
#pragma unroll
            for (int m = 0; m < 4; ++m)
#pragma unroll
                for (int bj = 0; bj < 2; ++bj)
#pragma unroll
                    for (int n = 0; n < 2; ++n) *(f32x4*)(out + (size_t)(row0 + ai * HALF + m * 16) * 1024 + col0 + bj * HALF + n * 16) = xv[m][bj][n] + acc[ai][bj][m][n];
            __builtin_amdgcn_sched_barrier(0);
        }
    }
};
template <class Epi, class Sched, bool ALIGN_EPI = false, bool SP2 = false>
__device__ __forceinline__ void gemm_phase(PG8_LAS unsigned char* lds, const Gemm g, const Sched& S, const Epi& E) {
    int tid_ = threadIdx.x; asm volatile("" : "+v"(tid_)); const int tid = tid_, wid = __builtin_amdgcn_readfirstlane(tid >> 6), lane = tid & 63, wr = wid >> 2, wc = wid & 3, fr = lane & 15, fq = lane >> 4;
    const int K = g.K, nt = K / BK;
    unsigned voffA[2], voffB[2];
#pragma unroll
    for (int i = 0; i < 2; ++i) { int R, C; stage_rc(tid * 16 + i * 8192, R, C); const int Rb = Epi::PERM ? ((R & ~31) + perm32(R & 31)) : R;
        voffA[i] = (unsigned)(R * K + C) * 2u; voffB[i] = (unsigned)(Rb * K + C) * 2u; }
    const size_t kstep = (size_t)(BK * 2);
    const size_t hstep = (size_t)HALF * K * 2;
    const size_t tstep = 2 * hstep;
    const unsigned ldsw = (unsigned)wid * 1024u;
    const int aoff = lds_byte(wr * 64 + fr, fq * 8), boff = lds_byte(wc * 32 + fr, fq * 8);
#define PG8_SA(b, h) (((b) * 2 + (h)) * HTB)
#define PG8_SB(b, h) ((4 + (b) * 2 + (h)) * HTB)
#define PG8_STAGE(bufoff, gbase, voff) do { _Pragma("unroll") for (int _i = 0; _i < 2; ++_i) \
        __builtin_amdgcn_global_load_lds((const unsigned*)((const char*)(gbase) + (voff)[_i]), (PG8_LAS unsigned*)(lds + (bufoff) + ldsw + _i * 8192), 16, 0, 0); } while (0)
#define PG8_LDA(dst, b, h) do { _Pragma("unroll") for (int m = 0; m < 4; ++m) _Pragma("unroll") for (int k = 0; k < 2; ++k) dst[m][k] = *(const PG8_LAS bf16x8*)(lds + PG8_SA(b, h) + aoff + m * 2048 + k * 1024); } while (0)
#define PG8_LDB(dst, b, h) do { _Pragma("unroll") for (int n = 0; n < 2; ++n) _Pragma("unroll") for (int k = 0; k < 2; ++k) dst[n][k] = *(const PG8_LAS bf16x8*)(lds + PG8_SB(b, h) + boff + n * 2048 + k * 1024); } while (0)
#define PG8_MMA(ai, bj, At, Bt) do { __builtin_amdgcn_s_setprio(1); _Pragma("unroll") for (int m = 0; m < 4; ++m) _Pragma("unroll") for (int n = 0; n < 2; ++n) _Pragma("unroll") for (int k = 0; k < 2; ++k) \
        acc[ai][bj][m][n] = __builtin_amdgcn_mfma_f32_16x16x32_bf16(Bt[n][k], At[m][k], acc[ai][bj][m][n], 0, 0, 0); __builtin_amdgcn_s_setprio(0); } while (0)
#define PG8_WAIT_V(n) asm volatile("s_waitcnt vmcnt(" #n ")" ::: "memory")
#define PG8_WAIT_L(n) asm volatile("s_waitcnt lgkmcnt(" #n ")" ::: "memory")
#define PG8_BAR __builtin_amdgcn_s_barrier()
#define PG8_SCHED __builtin_amdgcn_sched_barrier(0)
    Unit cur, nxt; int ui = 0;
    if (!S.next(0, cur)) return;
    f32x4 acc[2][2][4][2];
#pragma unroll
    for (int a = 0; a < 2; ++a)
#pragma unroll
        for (int b = 0; b < 2; ++b)
#pragma unroll
            for (int m = 0; m < 4; ++m)
#pragma unroll
                for (int n = 0; n < 2; ++n) acc[a][b][m][n] = (f32x4){0.f, 0.f, 0.f, 0.f};
    bf16x8 At[4][2], B0[2][2], B1[2][2];
    const char* cA = (const char*)g.A + (size_t)cur.pm * tstep; const char* cB = (const char*)g.Bt + (size_t)cur.pn * tstep;
    S.a_ready(cur);
    if constexpr (SP2) {
        PG8_STAGE(PG8_SB(0, 0), cB, voffB); PG8_STAGE(PG8_SB(0, 1), cB + hstep, voffB); PG8_STAGE(PG8_SA(0, 0), cA, voffA); PG8_STAGE(PG8_SA(0, 1), cA + hstep, voffA);
        if (wr == 1) PG8_BAR;
        PG8_WAIT_V(2); PG8_BAR;
        PG8_STAGE(PG8_SB(1, 0), cB + kstep, voffB); PG8_STAGE(PG8_SA(1, 0), cA + kstep, voffA); PG8_STAGE(PG8_SB(1, 1), cB + hstep + kstep, voffB);
        PG8_WAIT_V(6); PG8_BAR;
    } else {
        PG8_STAGE(PG8_SB(0, 0), cB, voffB); PG8_STAGE(PG8_SA(0, 0), cA, voffA); PG8_STAGE(PG8_SB(0, 1), cB + hstep, voffB); PG8_STAGE(PG8_SA(0, 1), cA + hstep, voffA);
        if (wr == 1) PG8_BAR;
        PG8_WAIT_V(4); PG8_BAR;
        PG8_STAGE(PG8_SB(1, 0), cB + kstep, voffB); PG8_STAGE(PG8_SA(1, 0), cA + kstep, voffA); PG8_STAGE(PG8_SB(1, 1), cB + hstep + kstep, voffB);
        PG8_WAIT_V(6); PG8_BAR;
    }
    for (;;) {
        const bool has_next = S.next(ui + 1, nxt);
        const char* nA = has_next ? (const char*)g.A + (size_t)nxt.pm * tstep : cA; const char* nB = has_next ? (const char*)g.Bt + (size_t)nxt.pn * tstep : cB;
        for (int t = 0; t < nt; t += 2) {
            const bool last = (t == nt - 2);
            const char* a1 = cA + (size_t)(t + 1) * kstep;
            const char* a2 = last ? nA : cA + (size_t)(t + 2) * kstep; const char* b2 = last ? nB : cB + (size_t)(t + 2) * kstep;
            const char* a3 = a2 + kstep; const char* b3 = b2 + kstep;
            if (last && has_next) S.a_ready(nxt);
            if constexpr (SP2) {
            PG8_LDB(B0, 0, 0); PG8_LDB(B1, 0, 1); PG8_SCHED; PG8_LDA(At, 0, 0); PG8_STAGE(PG8_SA(1, 1), a1 + hstep, voffA);
            PG8_WAIT_V(8); PG8_WAIT_L(0); PG8_BAR; PG8_MMA(0, 0, At, B0); PG8_MMA(0, 1, At, B1); PG8_BAR; PG8_SCHED;
            PG8_LDA(At, 0, 1); PG8_STAGE(PG8_SB(0, 0), b2, voffB); PG8_STAGE(PG8_SB(0, 1), b2 + hstep, voffB); PG8_STAGE(PG8_SA(0, 0), a2, voffA);
            PG8_WAIT_V(8); PG8_WAIT_L(0); PG8_BAR; PG8_MMA(1, 0, At, B0); PG8_MMA(1, 1, At, B1); PG8_BAR; PG8_SCHED;
            PG8_LDB(B0, 1, 0); PG8_LDB(B1, 1, 1); PG8_SCHED; PG8_LDA(At, 1, 0); PG8_STAGE(PG8_SA(0, 1), a2 + hstep, voffA);
            PG8_WAIT_V(8); PG8_WAIT_L(0); PG8_BAR; PG8_MMA(0, 0, At, B0); PG8_MMA(0, 1, At, B1); PG8_BAR; PG8_SCHED;
            PG8_LDA(At, 1, 1); PG8_STAGE(PG8_SB(1, 0), b3, voffB); PG8_STAGE(PG8_SB(1, 1), b3 + hstep, voffB); PG8_STAGE(PG8_SA(1, 0), a3, voffA);
            PG8_WAIT_V(8); PG8_WAIT_L(0); PG8_BAR; PG8_MMA(1, 0, At, B0); PG8_MMA(1, 1, At, B1); PG8_BAR; PG8_SCHED;
            } else {
            PG8_LDB(B0, 0, 0); PG8_SCHED; PG8_LDA(At, 0, 0); PG8_STAGE(PG8_SA(1, 1), a1 + hstep, voffA);
            PG8_WAIT_L(8); PG8_BAR; PG8_WAIT_L(0); PG8_MMA(0, 0, At, B0); PG8_BAR; PG8_SCHED;
            PG8_LDB(B1, 0, 1); PG8_STAGE(PG8_SB(0, 0), b2, voffB);
            PG8_BAR; PG8_WAIT_L(0); PG8_MMA(0, 1, At, B1); PG8_BAR;
            PG8_LDA(At, 0, 1); PG8_STAGE(PG8_SA(0, 0), a2, voffA);
            PG8_BAR; PG8_WAIT_L(0); PG8_MMA(1, 0, At, B0); PG8_BAR; PG8_SCHED;
            PG8_STAGE(PG8_SB(0, 1), b2 + hstep, voffB);
            PG8_WAIT_V(6); PG8_BAR; PG8_MMA(1, 1, At, B1); PG8_BAR;
            PG8_LDB(B0, 1, 0); PG8_SCHED; PG8_LDA(At, 1, 0); PG8_STAGE(PG8_SA(0, 1), a2 + hstep, voffA);
            PG8_WAIT_L(8); PG8_BAR; PG8_WAIT_L(0); PG8_MMA(0, 0, At, B0); PG8_BAR; PG8_SCHED;
            PG8_LDB(B1, 1, 1); PG8_STAGE(PG8_SB(1, 0), b3, voffB);
            PG8_BAR; PG8_WAIT_L(0); PG8_MMA(0, 1, At, B1); PG8_BAR;
            PG8_LDA(At, 1, 1); PG8_STAGE(PG8_SA(1, 0), a3, voffA);
            PG8_BAR; PG8_WAIT_L(0); PG8_MMA(1, 0, At, B0); PG8_BAR; PG8_SCHED;
            PG8_STAGE(PG8_SB(1, 1), b3 + hstep, voffB);
            PG8_WAIT_V(6); PG8_BAR; PG8_MMA(1, 1, At, B1); PG8_BAR;
            }
        }
        if constexpr (ALIGN_EPI) { if (wr == 0) PG8_BAR; }
        if constexpr (!Epi::AFTER_DRAIN) { E(acc, cur, wr, wc, fr, fq); S.done(cur); }
        if (!has_next) break;
#pragma unroll
        for (int a = 0; a < 2; ++a)
#pragma unroll
            for (int b = 0; b < 2; ++b)
#pragma unroll
                for (int m = 0; m < 4; ++m)
#pragma unroll
                    for (int n = 0; n < 2; ++n) acc[a][b][m][n] = (f32x4){0.f, 0.f, 0.f, 0.f};
        cur = nxt; cA = nA; cB = nB; ++ui;
        if constexpr (ALIGN_EPI) { if (wr == 1) PG8_BAR; }
    }
    PG8_WAIT_V(0);
    if constexpr (!ALIGN_EPI) { if (wr == 0) PG8_BAR; }
    PG8_BAR;
    if constexpr (Epi::AFTER_DRAIN) { E.fused(acc, cur, wr, wc, fr, fq, lds, wid, lane); S.done(cur); }
#undef PG8_SA
#undef PG8_SB
#undef PG8_STAGE
#undef PG8_LDA
#undef PG8_LDB
#undef PG8_MMA
#undef PG8_WAIT_V
#undef PG8_WAIT_L
#undef PG8_BAR
#undef PG8_SCHED
}
}

#define DI __device__ __forceinline__
typedef unsigned short bf16_t;
typedef short bf16x8 __attribute__((ext_vector_type(8)));
typedef short bf16x4 __attribute__((ext_vector_type(4)));
typedef float f32x4 __attribute__((ext_vector_type(4)));
typedef unsigned u32x4 __attribute__((ext_vector_type(4)));
typedef unsigned u32x2 __attribute__((ext_vector_type(2)));
constexpr int NTHR = 512, NWAVE = 8;
constexpr int LDS_BYTES = 155648;
constexpr int LDS_SLOT = 155648 - 64;

DI float bf2f(bf16_t v) { return __uint_as_float(((unsigned)v) << 16); }
typedef float f32x2v __attribute__((ext_vector_type(2)));
typedef __bf16 bf16x2v __attribute__((ext_vector_type(2)));
DI unsigned f2bf(float f) { return (unsigned)__builtin_bit_cast(unsigned short, (__bf16)f); }
DI unsigned pk2(float lo, float hi) { const f32x2v v = {lo, hi}; return __builtin_bit_cast(unsigned, __builtin_convertvector(v, bf16x2v)); }
DI float lo_f(unsigned w) { return __uint_as_float(w << 16); }
DI float hi_f(unsigned w) { return __uint_as_float(w & 0xffff0000u); }
DI float siluf(float x) { return x * __builtin_amdgcn_rcpf(1.0f + __expf(-x)); }
DI float sigmf(float x) { return __builtin_amdgcn_rcpf(1.0f + __expf(-x)); }
#define DPPF(v, ctrl) __builtin_bit_cast(float, __builtin_amdgcn_update_dpp(0, __builtin_bit_cast(int, (v)), (ctrl), 0xf, 0xf, true))
#define DPPI(v, ctrl) __builtin_amdgcn_update_dpp(0, (v), (ctrl), 0xf, 0xf, true)
DI float row16_sum(float v) {
    v += DPPF(v, 0xB1); v += DPPF(v, 0x4E); v += DPPF(v, 0x141); v += DPPF(v, 0x140);
    return v;
}
DI int row16_sumi(int v) {
    v += DPPI(v, 0xB1); v += DPPI(v, 0x4E); v += DPPI(v, 0x141); v += DPPI(v, 0x140);
    return v;
}
DI float wave_sum(float v) {
    v = row16_sum(v);
    v += __builtin_bit_cast(float, __builtin_amdgcn_update_dpp(0, __builtin_bit_cast(int, v), 0x142, 0xa, 0xf, false));
    v += __builtin_bit_cast(float, __builtin_amdgcn_update_dpp(0, __builtin_bit_cast(int, v), 0x143, 0xc, 0xf, false));
    return __builtin_bit_cast(float, __builtin_amdgcn_readlane(__builtin_bit_cast(int, v), 63));
}
DI f32x4 mfma16(bf16x8 a, bf16x8 b, f32x4 c) { return __builtin_amdgcn_mfma_f32_16x16x32_bf16(a, b, c, 0, 0, 0); }
DI bf16x8 ld16(const unsigned char* p) { return *(const bf16x8*)p; }
DI bf16x8 ld8x2(const unsigned char* p0, const unsigned char* p1) {
    const bf16x4 a = *(const bf16x4*)p0, b = *(const bf16x4*)p1;
    return __builtin_shufflevector(a, b, 0, 1, 2, 3, 4, 5, 6, 7);
}
DI bf16x8 packf(const f32x4 a, const f32x4 b) {
    u32x4 w; w.x = pk2(a[0], a[1]); w.y = pk2(a[2], a[3]); w.z = pk2(b[0], b[1]); w.w = pk2(b[2], b[3]);
    return __builtin_bit_cast(bf16x8, w);
}
DI u32x2 pack4(const f32x4 a) { u32x2 w; w.x = pk2(a[0], a[1]); w.y = pk2(a[2], a[3]); return w; }

#define LAS __attribute__((address_space(3)))
#define XB_TMO      128
#define XB_XCNT(j)  (256  + 64 * (j))
#define XB_XSUB(j)  (1280 + 64 * (j))
#define XB_XGEN(j)  (2304 + 64 * (j))
#define XB_TOP      3328
#define XB_TOPGEN   3392
#define XCD_BAR_WORDS 3456
#define XB_SPIN_CAP (1u << 18)

__device__ __forceinline__ unsigned xb_ld(unsigned* p)              { return __hip_atomic_load(p, __ATOMIC_RELAXED, __HIP_MEMORY_SCOPE_AGENT); }
__device__ __forceinline__ unsigned xb_add(unsigned* p, unsigned v) { return __hip_atomic_fetch_add(p, v, __ATOMIC_RELAXED, __HIP_MEMORY_SCOPE_AGENT); }
__device__ __forceinline__ unsigned xb_xcc_id() { return (unsigned)__builtin_amdgcn_s_getreg((3 << 11) | 20) & 0xFu; }
#define XB_SPIN(cond, bar) do { unsigned _sp = 0; while (cond) { __builtin_amdgcn_s_sleep(1); \
    if ((++_sp & 255u) == 0u) { if (xb_ld(&(bar)[XB_TMO])) break; if (_sp > XB_SPIN_CAP) { atomicAdd(&(bar)[XB_TMO], 1u); break; } } } } while (0)

struct XcdBarrier {
    unsigned* bar; unsigned x;
    volatile LAS unsigned* st;
};

__device__ __forceinline__ XcdBarrier xcd_barrier_post(unsigned* bar, volatile LAS unsigned* st) {
    XcdBarrier b; b.bar = bar; b.x = xb_xcc_id(); b.st = st;
    if (threadIdx.x == 0) (void)xb_add(&bar[XB_XCNT(b.x)], 1u);
    return b;
}
__device__ __forceinline__ void xcd_barrier_complete(unsigned* bar, unsigned x, unsigned& nloc, unsigned& nx) {
    const unsigned G = gridDim.x * gridDim.y * gridDim.z;
    unsigned sum, cnt, mine, sp = 0u;
    for (;;) {
        sum = 0u; cnt = 0u; mine = 0u;
#pragma unroll
        for (unsigned j = 0; j < 16; ++j) { const unsigned c = xb_ld(&bar[XB_XCNT(j)]); sum += c; cnt += (c > 0u) ? 1u : 0u; mine = (j == x) ? c : mine; }
        if (sum == G) break;
        __builtin_amdgcn_s_sleep(1);
        if ((++sp & 255u) == 0u) { if (xb_ld(&bar[XB_TMO])) break; if (sp > XB_SPIN_CAP) { atomicAdd(&bar[XB_TMO], 1u); break; } }
    }
    nloc = mine > 0u ? mine : 1u; nx = cnt > 0u ? cnt : 1u;
}

__device__ __forceinline__ void xcd_barrier(const XcdBarrier& b) {
    asm volatile("s_waitcnt vmcnt(0)" ::: "memory");
    __syncthreads();
    if (threadIdx.x == 0) {
        unsigned* bar = b.bar;
        __builtin_amdgcn_s_waitcnt(0);
        unsigned nloc = b.st[0], nx = b.st[1];
        if (nloc == 0u) { xcd_barrier_complete(bar, b.x, nloc, nx); b.st[0] = nloc; b.st[1] = nx; }
        const unsigned old = xb_add(&bar[XB_XSUB(b.x)], 1u);
        const unsigned gen = old / nloc;
        if (old + 1u == (gen + 1u) * nloc) {
            __builtin_amdgcn_fence(__ATOMIC_RELEASE, "agent");
            asm volatile("s_waitcnt vmcnt(0)" ::: "memory");
            const unsigned og = xb_add(&bar[XB_TOP], 1u);
            const unsigned tg = og / nx;
            if (og + 1u == (tg + 1u) * nx) xb_add(&bar[XB_TOPGEN], 1u);
            else XB_SPIN(xb_ld(&bar[XB_TOPGEN]) == tg, bar);
            __builtin_amdgcn_fence(__ATOMIC_ACQUIRE, "agent");
            xb_add(&bar[XB_XGEN(b.x)], 1u);
            asm volatile("s_waitcnt vmcnt(0)" ::: "memory");
        } else {
            XB_SPIN(xb_ld(&bar[XB_XGEN(b.x)]) == gen, bar);
            __builtin_amdgcn_fence(__ATOMIC_ACQUIRE, "agent");
            asm volatile("s_waitcnt vmcnt(0)" ::: "memory");
        }
    }
    __syncthreads();
}

__constant__ float INV_A[64] = {1.000000000e+00f, 8.659643531e-01f, 7.498942614e-01f, 6.493816376e-01f, 5.623413324e-01f, 4.869675338e-01f, 4.216965139e-01f, 3.651741147e-01f, 3.162277639e-01f, 2.738419771e-01f, 2.371373773e-01f, 2.053525001e-01f, 1.778279394e-01f, 1.539926529e-01f, 1.333521307e-01f, 1.154782027e-01f, 1.000000015e-01f, 8.659642935e-02f, 7.498941571e-02f, 6.493816525e-02f, 5.623413250e-02f, 4.869675264e-02f, 4.216965288e-02f, 3.651741147e-02f, 3.162277490e-02f, 2.738419734e-02f, 2.371373773e-02f, 2.053525113e-02f, 1.778279431e-02f, 1.539926510e-02f, 1.333521493e-02f, 1.154782064e-02f, 9.999999776e-03f, 8.659643121e-03f, 7.498941850e-03f, 6.493816152e-03f, 5.623413250e-03f, 4.869675264e-03f, 4.216964822e-03f, 3.651741194e-03f, 3.162277630e-03f, 2.738419687e-03f, 2.371373586e-03f, 2.053524833e-03f, 1.778279431e-03f, 1.539926510e-03f, 1.333521446e-03f, 1.154781901e-03f, 1.000000047e-03f, 8.659643354e-04f, 7.498942432e-04f, 6.493816618e-04f, 5.623413017e-04f, 4.869675322e-04f, 4.216965172e-04f, 3.651741426e-04f, 3.162277571e-04f, 2.738419571e-04f, 2.371373703e-04f, 2.053525095e-04f, 1.778279402e-04f, 1.539926452e-04f, 1.333521504e-04f, 1.154782003e-04f};
__constant__ float INV_I[32] = {1.000000000e+00f, 7.498942614e-01f, 5.623413324e-01f, 4.216965139e-01f, 3.162277639e-01f, 2.371373773e-01f, 1.778279394e-01f, 1.333521307e-01f, 1.000000015e-01f, 7.498941571e-02f, 5.623413250e-02f, 4.216965288e-02f, 3.162277490e-02f, 2.371373773e-02f, 1.778279431e-02f, 1.333521493e-02f, 9.999999776e-03f, 7.498941850e-03f, 5.623413250e-03f, 4.216964822e-03f, 3.162277630e-03f, 2.371373586e-03f, 1.778279431e-03f, 1.333521446e-03f, 1.000000047e-03f, 7.498942432e-04f, 5.623413017e-04f, 4.216965172e-04f, 3.162277571e-04f, 2.371373703e-04f, 1.778279402e-04f, 1.333521504e-04f};
struct Params {
    const float* x; const float* norm_g; const float* w_in; const float* gate_b; const float* conv_w; const float* a_log; const float* dt_bias;
    const float* dn_onorm; const float* pool_w; const float* pool_scale; const float* q_norm; const float* k_norm; const float* w_branch; const float* w_out;
    float* out; unsigned char* ws;
    int ph_lo, ph_hi;
};

DI int next_unit(unsigned* ctr, unsigned char* lds) {
    volatile int* slot = (volatile int*)(lds + LDS_SLOT);
    __syncthreads();
    if (threadIdx.x == 0) *slot = (int)atomicAdd(ctr, 1u);
    __syncthreads();
    return *slot;
}

DI int src_col(int mode, int n) {
    if (mode == 0) {
        if (n < 2048) return n;
        if (n < 5440) return n + 8;
        if (n < 5444) return 2048 + (n - 5440);
        if (n < 5448) return 2052 + (n - 5444);
        if (n < 5452) return n;
        return -1;
    }
    if (mode == 1) return 5452 + n;
    return n;
}
DI void transpose_item(const float* W, int ldw, int K, bf16_t* WT, int mode, float* scr, int item, int nblk, int lane) {
    const int kb = item / nblk, nb = item % nblk, k0 = 64 * kb, n0 = 32 * nb;
    const int sc = src_col(mode, n0 + (lane & 31));
    const int scc = sc < 0 ? 0 : sc;
    float tv[32];
#pragma unroll
    for (int i = 0; i < 32; ++i) { const int kk = 2 * i + (lane >> 5); tv[i] = W[(size_t)(k0 + kk) * ldw + scc]; }
    __builtin_amdgcn_sched_barrier(0);
#pragma unroll
    for (int i = 0; i < 32; ++i) { const int kk = 2 * i + (lane >> 5); scr[kk * 33 + (lane & 31)] = (sc >= 0) ? tv[i] : 0.f; }
    asm volatile("s_waitcnt lgkmcnt(0)" ::: "memory");
    const int c = lane & 7;
#pragma unroll
    for (int j = 0; j < 4; ++j) { const int n = (lane >> 3) + 8 * j; const float* s = scr + (8 * c) * 33 + n;
        u32x4 o; o.x = pk2(s[0 * 33], s[1 * 33]); o.y = pk2(s[2 * 33], s[3 * 33]); o.z = pk2(s[4 * 33], s[5 * 33]); o.w = pk2(s[6 * 33], s[7 * 33]);
        *(u32x4*)(WT + (size_t)(n0 + n) * K + k0 + 8 * c) = o; }
    asm volatile("s_waitcnt lgkmcnt(0)" ::: "memory");
}
DI void rms_row(const float* xrow, const float* g, bf16_t* orow, int lane) {
    const f32x4* xr = (const f32x4*)xrow + lane; const f32x4* gr = (const f32x4*)g + lane;
    f32x4 v[4]; float s = 0.f;
#pragma unroll
    for (int j = 0; j < 4; ++j) { v[j] = xr[64 * j]; s += (v[j].x * v[j].x + v[j].y * v[j].y) + (v[j].z * v[j].z + v[j].w * v[j].w); }
    const float rstd = 1.0f / sqrtf(wave_sum(s) * (1.0f / DM) + NORM_EPS);
    u32x2* o8 = (u32x2*)orow + lane;
#pragma unroll
    for (int j = 0; j < 4; ++j) { const f32x4 gg = gr[64 * j]; u32x2 w; w.x = pk2(v[j].x * rstd * gg.x, v[j].y * rstd * gg.y); w.y = pk2(v[j].z * rstd * gg.z, v[j].w * rstd * gg.w); o8[64 * j] = w; }
}
DI void rms_row2(const float* xrow, const float* g, bf16_t* orow, int lane) {
    const f32x4* xr = (const f32x4*)xrow + lane; const f32x4* gr = (const f32x4*)g + lane;
    f32x4 v[2][4], gg[4];
#pragma unroll
    for (int r = 0; r < 2; ++r)
#pragma unroll
        for (int j = 0; j < 4; ++j) v[r][j] = xr[r * (DM / 4) + 64 * j];
#pragma unroll
    for (int j = 0; j < 4; ++j) gg[j] = gr[64 * j];
    __builtin_amdgcn_sched_barrier(0);
    float s[2];
#pragma unroll
    for (int r = 0; r < 2; ++r) { s[r] = 0.f;
#pragma unroll
        for (int j = 0; j < 4; ++j) s[r] += (v[r][j].x * v[r][j].x + v[r][j].y * v[r][j].y) + (v[r][j].z * v[r][j].z + v[r][j].w * v[r][j].w); }
#pragma unroll
    for (int r = 0; r < 2; ++r) s[r] = wave_sum(s[r]);
#pragma unroll
    for (int r = 0; r < 2; ++r) { const float rstd = __builtin_amdgcn_rsqf(s[r] * (1.0f / DM) + NORM_EPS);
        u32x2* o8 = (u32x2*)(orow + r * DM) + lane;
#pragma unroll
        for (int j = 0; j < 4; ++j) { u32x2 w; w.x = pk2(v[r][j].x * rstd * gg[j].x, v[r][j].y * rstd * gg[j].y); w.y = pk2(v[r][j].z * rstd * gg[j].z, v[r][j].w * rstd * gg[j].w); o8[64 * j] = w; } }
}
DI void phase0(const Params& p, int layer, const float* xin, unsigned char* lds) {
    int tid_ = threadIdx.x; asm volatile("" : "+v"(tid_)); const int tid = tid_, lane = tid & 63, wave = tid >> 6;
    const int gw = blockIdx.x * NWAVE + wave, NGW = gridDim.x * NWAVE;
    float* scr = (float*)(lds + wave * 8704);
    unsigned char* ws = p.ws;
    const float* win = p.w_in + (size_t)layer * DM * INW;
    const float* wbr = p.w_branch + (size_t)layer * 3 * 512 * 1024;
    const float* wo = p.w_out + (size_t)layer * 1024 * 1024;
    const float* pw = p.pool_w + (size_t)layer * 4 * 128 * 128;
    constexpr int I_1 = 16 * (N1 / 32), I_G = 16 * (NG / 32), I_B = 8 * 32, I_O = 16 * 32, I_P = 2 * 4;
    constexpr int NITEMS = I_1 + I_G + 3 * I_B + I_O + 4 * I_P;
    for (int it = gw; it < NITEMS; it += NGW) {
        int r = it;
        if (r < I_1) { transpose_item(win, INW, 1024, (bf16_t*)(ws + WS_WIN1), 0, scr, r, N1 / 32, lane); continue; } r -= I_1;
        if (r < I_G) { transpose_item(win, INW, 1024, (bf16_t*)(ws + WS_WG), 1, scr, r, NG / 32, lane); continue; } r -= I_G;
        if (r < 3 * I_B) { const int br = r / I_B; transpose_item(wbr + (size_t)br * 512 * 1024, 1024, 512, (bf16_t*)(ws + WS_WBR) + (size_t)br * 1024 * 512, 2, scr, r % I_B, 32, lane); continue; } r -= 3 * I_B;
        if (r < I_O) { transpose_item(wo, 1024, 1024, (bf16_t*)(ws + WS_WO), 2, scr, r, 32, lane); continue; } r -= I_O;
        { const int g = r / I_P; transpose_item(pw + (size_t)g * 128 * 128, 128, 128, (bf16_t*)(ws + WS_POOLW) + (size_t)g * 128 * 128, 2, scr, r % I_P, 4, lane); }
    }
    const float* ng = p.norm_g + layer * DM;
    for (int m = 2 * gw; m < MTOK; m += 2 * NGW) rms_row2(xin + (size_t)m * DM, ng, (bf16_t*)(ws + WS_H) + (size_t)m * DM, lane);
    if (layer == 0) {
        const int gt = blockIdx.x * NTHR + tid, NGT = gridDim.x * NTHR;
        for (int i = gt; i < SEQ * 96; i += NGT) {
            const int t = i / 96, j = i % 96;
            const float inv = (j < 64) ? INV_A[j] : INV_I[j - 64];
            const float ang = (float)t * inv;
            double rev = (double)ang * 0.15915494309189535; rev -= floor(rev);
            const float rf = (float)rev;
            const float c = __builtin_amdgcn_cosf(rf), s = __builtin_amdgcn_sinf(rf);
            if (j < 64) { ((float*)(ws + WS_COSA))[t * 64 + j] = c; ((float*)(ws + WS_SINA))[t * 64 + j] = s; }
            else { ((float*)(ws + WS_COSI))[t * 32 + (j - 64)] = c; ((float*)(ws + WS_SINI))[t * 32 + (j - 64)] = s; }
        }
    }
}

constexpr int DP_Q = 0, DP_K = 17408, DP_KBT = 34816, DP_VT = 53248, DP_KDT = 71680, DP_L = 90112, DP_TF = 106752, DP_T = 123392, DP_GC = 132608, DP_BETA = 132864, DP_P = 133120;
constexpr int QP = 272;
constexpr int TP = 144;
DI void dn_prep_unit(const Params& p, int layer, int unit, unsigned char* lds) {
    int tid_ = threadIdx.x; asm volatile("" : "+v"(tid_)); const int tid = tid_, lane = tid & 63, wave = tid >> 6, fr = lane & 15, fq = lane >> 4;
    const int c = unit & 31, h = (unit >> 5) & 3, b = unit >> 7;
    unsigned char* ws = p.ws;
    const size_t tok0 = (size_t)b * SEQ + (size_t)c * 64;
    float* sGc = (float*)(lds + DP_GC); float* sBeta = (float*)(lds + DP_BETA);
    float* sL = (float*)(lds + DP_L); float* sTf = (float*)(lds + DP_TF);
    unsigned char* su = ws + WS_SCAN + (size_t)unit * SCAN_UNIT_BYTES;
    const bf16_t* aq = (const bf16_t*)(ws + WS_AQKV);
    const float* cw = p.conv_w + (size_t)layer * 4 * 1536;
    const int tl0 = 8 * wave;
        float raA[3][11], rbA[3][11], w0A[3][4], w1A[3][4];
#pragma unroll
        for (int part = 0; part < 3; ++part) {
            const int ch0 = part * 512 + h * 128 + lane, ch1 = ch0 + 64;
#pragma unroll
            for (int j = 0; j < 4; ++j) { w0A[part][j] = cw[j * 1536 + ch0]; w1A[part][j] = cw[j * 1536 + ch1]; }
#pragma unroll
            for (int j = 0; j < 11; ++j) { const int tg = c * 64 + tl0 - 3 + j;
                const int tgc = tg < 0 ? 0 : tg; const bf16_t* rp = aq + ((size_t)b * SEQ + tgc) * 1536;
                const float va = bf2f(rp[ch0]), vb = bf2f(rp[ch1]); raA[part][j] = tg >= 0 ? va : 0.f; rbA[part][j] = tg >= 0 ? vb : 0.f; }
        }
    if (wave == 0) {
        const float* mp = (const float*)(ws + WS_MISC) + (tok0 + lane) * 16;
        const float ba = mp[h], aa = mp[4 + h];
        const float al = p.a_log[layer * 4 + h], dtb = p.dt_bias[layer * 4 + h];
        const float xx = aa + dtb;
        const float sp = fmaxf(xx, 0.f) + log1pf(__expf(-fabsf(xx)));
        float g = -__expf(al) * sp;
        float cs = g;
#pragma unroll
        for (int o = 1; o < 64; o <<= 1) { const float n = __shfl_up(cs, o); if (lane >= o) cs += n; }
        sGc[lane] = cs; sBeta[lane] = sigmf(ba);
    }
    __syncthreads();
    const float gl = sGc[63];
    {
        __builtin_amdgcn_sched_barrier(0);
#pragma unroll
        for (int part = 0; part < 3; ++part) {
            const float (&ra)[11] = raA[part]; const float (&rb)[11] = rbA[part]; const float (&w0)[4] = w0A[part]; const float (&w1)[4] = w1A[part];
            float yav[8], ybv[8];
#pragma unroll
            for (int i = 0; i < 8; ++i) {
                yav[i] = siluf(w0[0] * ra[i] + w0[1] * ra[i + 1] + w0[2] * ra[i + 2] + w0[3] * ra[i + 3]);
                ybv[i] = siluf(w1[0] * rb[i] + w1[1] * rb[i + 1] + w1[2] * rb[i + 2] + w1[3] * rb[i + 3]);
            }
            float rnv[8];
            if (part < 2) {
#pragma unroll
                for (int i = 0; i < 8; ++i) rnv[i] = yav[i] * yav[i] + ybv[i] * ybv[i];
#pragma unroll
                for (int i = 0; i < 8; ++i) rnv[i] = __builtin_amdgcn_rsqf(wave_sum(rnv[i]) + NORM_EPS);
            }
#pragma unroll
            for (int i = 0; i < 8; ++i) {
                const int tl = tl0 + i;
                float ya = yav[i], yb = ybv[i];
                const float beta = sBeta[tl], gct = sGc[tl];
                if (part < 2) {
                    const float rn = rnv[i];
                    ya *= rn; yb *= rn;
                    if (part == 0) {
                        *(bf16_t*)(lds + DP_Q + tl * QP + lane * 2) = (bf16_t)f2bf(ya); *(bf16_t*)(lds + DP_Q + tl * QP + (lane + 64) * 2) = (bf16_t)f2bf(yb);
                    } else {
                        *(bf16_t*)(lds + DP_K + tl * QP + lane * 2) = (bf16_t)f2bf(ya); *(bf16_t*)(lds + DP_K + tl * QP + (lane + 64) * 2) = (bf16_t)f2bf(yb);
                        const float s1 = beta * __expf(gct), s2 = __expf(gl - gct);
                        *(bf16_t*)(lds + DP_KBT + lane * TP + tl * 2) = (bf16_t)f2bf(ya * s1); *(bf16_t*)(lds + DP_KBT + (lane + 64) * TP + tl * 2) = (bf16_t)f2bf(yb * s1);
                        *(bf16_t*)(lds + DP_KDT + lane * TP + tl * 2) = (bf16_t)f2bf(ya * s2); *(bf16_t*)(lds + DP_KDT + (lane + 64) * TP + tl * 2) = (bf16_t)f2bf(yb * s2);
                    }
                } else {
                    *(bf16_t*)(lds + DP_VT + lane * TP + tl * 2) = (bf16_t)f2bf(ya * beta); *(bf16_t*)(lds + DP_VT + (lane + 64) * TP + tl * 2) = (bf16_t)f2bf(yb * beta);
                }
            }
        }
    }
    __syncthreads();
#pragma unroll 1
    for (int i4 = 0; i4 < 4; ++i4) {
        const int id = wave + 8 * i4;
        if (id < 16) {
            const int mt = id >> 2, nt = id & 3;
            f32x4 acc = {0.f, 0.f, 0.f, 0.f};
            if (nt <= mt) {
#pragma unroll
                for (int s = 0; s < 4; ++s) acc = mfma16(ld16(lds + DP_K + (16 * mt + fr) * QP + (32 * s + 8 * fq) * 2), ld16(lds + DP_K + (16 * nt + fr) * QP + (32 * s + 8 * fq) * 2), acc);
            }
            const int j = 16 * nt + fr; const float gj = sGc[j];
#pragma unroll
            for (int jj = 0; jj < 4; ++jj) { const int i = 16 * mt + 4 * fq + jj;
                float v = 0.f; if (j < i) v = sBeta[i] * acc[jj] * __expf(sGc[i] - gj);
                sL[i * 65 + j] = v; }
        } else {
            const int mt = (id - 16) >> 2, nt = (id - 16) & 3;
            f32x4 acc = {0.f, 0.f, 0.f, 0.f};
            if (nt <= mt) {
#pragma unroll
                for (int s = 0; s < 4; ++s) acc = mfma16(ld16(lds + DP_K + (16 * nt + fr) * QP + (32 * s + 8 * fq) * 2), ld16(lds + DP_Q + (16 * mt + fr) * QP + (32 * s + 8 * fq) * 2), acc);
            }
            const int i = 16 * mt + fr; const float gi = sGc[i];
            f32x4 o;
#pragma unroll
            for (int jj = 0; jj < 4; ++jj) { const int j = 16 * nt + 4 * fq + jj;
                float v = 0.f; if (j <= i) v = acc[jj] * 0.08838834764831845f * __expf(gi - sGc[j]);
                o[jj] = v; }
            *(u32x2*)(su + SU_A + (i * 64 + 16 * nt + 4 * fq) * 2) = pack4(o);
        }
    }
    __syncthreads();
    float* sP = (float*)(lds + DP_P);
    if (wave < 4) {
        const int o = 16 * wave;
        for (int e = lane; e < 16 * 64; e += 64) { const int i = e >> 6, cc = e & 63; if (cc >= o + 16) sTf[(o + i) * 65 + cc] = 0.f; }
        if (lane < 16) {
            float lv[120];
#pragma unroll
            for (int i = 1; i < 16; ++i)
#pragma unroll
                for (int j = 0; j < i; ++j) lv[i * (i - 1) / 2 + j] = sL[(o + i) * 65 + o + j];
            float tc[16];
#pragma unroll
            for (int i = 0; i < 16; ++i) {
                float acc = (i == lane) ? 1.f : 0.f;
#pragma unroll
                for (int j = 0; j < i; ++j) acc -= lv[i * (i - 1) / 2 + j] * tc[j];
                tc[i] = acc;
            }
#pragma unroll
            for (int i = 0; i < 16; ++i) sTf[(o + i) * 65 + o + lane] = tc[i];
        }
    } else {
        for (int ch = tid - 256; ch < 1024; ch += 256) {
            const int row = ch >> 4, c8 = (ch & 15) * 8;
            const u32x4 q = *(const u32x4*)(lds + DP_Q + row * QP + c8 * 2);
            const float sc = __expf(sGc[row]) * 0.08838834764831845f;
            u32x4 o; o.x = pk2(lo_f(q.x) * sc, hi_f(q.x) * sc); o.y = pk2(lo_f(q.y) * sc, hi_f(q.y) * sc); o.z = pk2(lo_f(q.z) * sc, hi_f(q.z) * sc); o.w = pk2(lo_f(q.w) * sc, hi_f(q.w) * sc);
            *(u32x4*)(su + SU_QG + (row * 128 + c8) * 2) = o;
        }
        for (int ch = tid - 256; ch < 1024; ch += 256) {
            const int row = ch >> 3, c8 = (ch & 7) * 8;
            *(u32x4*)(su + SU_KDT + (row * 64 + c8) * 2) = *(const u32x4*)(lds + DP_KDT + row * TP + c8 * 2);
        }
        if (tid == 256) ((float*)(ws + WS_DEC))[unit] = __expf(gl);
    }
    __syncthreads();
#pragma unroll 1
    for (int I = 1; I < 4; ++I) {
        for (int e = tid; e < I * 256; e += NTHR) { const int J = e >> 8, r = (e >> 4) & 15, cc = e & 15;
            float acc = 0.f;
            for (int K = J; K < I; ++K) {
#pragma unroll
                for (int k2 = 0; k2 < 16; ++k2) acc += sL[(16 * I + r) * 65 + 16 * K + k2] * sTf[(16 * K + k2) * 65 + 16 * J + cc];
            }
            sP[r * 65 + 16 * J + cc] = acc; }
        __syncthreads();
        for (int e = tid; e < I * 256; e += NTHR) { const int J = e >> 8, r = (e >> 4) & 15, cc = e & 15;
            float acc = 0.f;
#pragma unroll
            for (int kk = 0; kk < 16; ++kk) acc += sTf[(16 * I + r) * 65 + 16 * I + kk] * sP[kk * 65 + 16 * J + cc];
            sTf[(16 * I + r) * 65 + 16 * J + cc] = -acc; }
        __syncthreads();
    }
    for (int e = tid; e < 4096; e += NTHR) { const int i = e >> 6, j = e & 63; *(bf16_t*)(lds + DP_T + i * TP + j * 2) = (bf16_t)f2bf(sTf[i * 65 + j]); }
    __syncthreads();
#pragma unroll 1
    for (int i8 = 0; i8 < 8; ++i8) {
        const int id = wave + 8 * i8;
        if (id < 32) {
            const int mt = id >> 3, nt = id & 7;
            f32x4 acc = {0.f, 0.f, 0.f, 0.f};
#pragma unroll
            for (int s = 0; s < 2; ++s) acc = mfma16(ld16(lds + DP_T + (16 * mt + fr) * TP + (32 * s + 8 * fq) * 2), ld16(lds + DP_VT + (16 * nt + fr) * TP + (32 * s + 8 * fq) * 2), acc);
            *(u32x2*)(su + SU_UT + ((16 * nt + fr) * 64 + 16 * mt + 4 * fq) * 2) = pack4(acc);
        } else {
            const int mt = (id - 32) >> 3, nt = (id - 32) & 7;
            f32x4 acc = {0.f, 0.f, 0.f, 0.f};
#pragma unroll
            for (int s = 0; s < 2; ++s) acc = mfma16(ld16(lds + DP_KBT + (16 * nt + fr) * TP + (32 * s + 8 * fq) * 2), ld16(lds + DP_T + (16 * mt + fr) * TP + (32 * s + 8 * fq) * 2), acc);
            *(u32x2*)(su + SU_W + ((16 * mt + fr) * 128 + 16 * nt + 4 * fq) * 2) = pack4(acc);
        }
    }
}

constexpr int PL_U = 0, PL_P = 40960;
DI void pool_unit(const Params& p, int layer, int unit, unsigned char* lds) {
    int tid_ = threadIdx.x; asm volatile("" : "+v"(tid_)); const int tid = tid_, lane = tid & 63, wave = tid >> 6, fr = lane & 15, fq = lane >> 4;
    const int g = unit & 3, tt = (unit >> 2) & 31, b = unit >> 7;
    unsigned char* ws = p.ws;
    const int t0 = tt * 64, win = 2 << g;
    float* sU = (float*)(lds + PL_U);
    const bf16_t* bu = (const bf16_t*)(ws + WS_BU);
    const bf16_t* pw = (const bf16_t*)(ws + WS_POOLW) + (size_t)g * 128 * 128;
    const int mt = wave & 3, nh = wave >> 2;
    const float* psc = p.pool_scale + layer * 512 + g * 128;
    bf16_t* bz = (bf16_t*)(ws + WS_BZ);
    bf16x8 bw[4][4]; u32x2 zz[4]; f32x4 scv[4];
#pragma unroll
        for (int n4 = 0; n4 < 4; ++n4) { const int nt = nh * 4 + n4;
#pragma unroll
            for (int s = 0; s < 4; ++s) bw[n4][s] = *(const bf16x8*)(pw + (16 * nt + fr) * 128 + 32 * s + 8 * fq);
            const int d0 = 16 * nt + 4 * fq;
            zz[n4] = *(const u32x2*)(bz + ((size_t)b * SEQ + t0 + 16 * mt + fr) * 512 + g * 128 + d0); scv[n4] = *(const f32x4*)(psc + d0); }
    {
        float pv[20];
#pragma unroll
        for (int k = 0; k < 20; ++k) { const int e = tid + k * NTHR; const int r = e >> 7, cc = e & 127; const int t = t0 - 15 + r;
            const int tc = t < 0 ? 0 : (t > SEQ - 1 ? SEQ - 1 : t);
            const float v = bf2f(bu[((size_t)b * SEQ + tc) * 512 + g * 128 + cc]); pv[k] = (t >= 0) ? v : 0.f; }
        __builtin_amdgcn_sched_barrier(0);
#pragma unroll
        for (int k = 0; k < 20; ++k) { const int e = tid + k * NTHR; if (e < 79 * 128) sU[e] = pv[k]; }
    }
    __syncthreads();
    for (int e = tid; e < 64 * 128; e += NTHR) { const int tl = e >> 7, cc = e & 127; const int t = t0 + tl;
        const int cnt = (t + 1 < win) ? (t + 1) : win;
        float s = 0.f;
#pragma unroll
        for (int i = 0; i < 16; ++i) { const float v = sU[(tl + 15 - i) * 128 + cc]; s += (i < cnt) ? v : 0.f; }
        const float pv = s * __builtin_amdgcn_rcpf((float)cnt) - sU[(tl + 15) * 128 + cc];
        *(bf16_t*)(lds + PL_P + tl * QP + cc * 2) = (bf16_t)f2bf(pv); }
    __syncthreads();
    {
        __builtin_amdgcn_sched_barrier(0);
#pragma unroll
        for (int n4 = 0; n4 < 4; ++n4) {
            const int nt = nh * 4 + n4;
            f32x4 acc = {0.f, 0.f, 0.f, 0.f};
#pragma unroll
            for (int s = 0; s < 4; ++s) acc = mfma16(bw[n4][s], ld16(lds + PL_P + (16 * mt + fr) * QP + (32 * s + 8 * fq) * 2), acc);
            const int d0 = 16 * nt + 4 * fq; bf16_t* zp = bz + ((size_t)b * SEQ + t0 + 16 * mt + fr) * 512 + g * 128 + d0;
            f32x4 o; o[0] = acc[0] * scv[n4][0] * siluf(lo_f(zz[n4].x)); o[1] = acc[1] * scv[n4][1] * siluf(hi_f(zz[n4].x)); o[2] = acc[2] * scv[n4][2] * siluf(lo_f(zz[n4].y)); o[3] = acc[3] * scv[n4][3] * siluf(hi_f(zz[n4].y));
            *(u32x2*)zp = pack4(o);
        }
    }
}

DI void sa_prep_unit(const Params& p, int layer, int unit, unsigned char* lds) {
    int tid_ = threadIdx.x; asm volatile("" : "+v"(tid_)); const int tid = tid_, lane = tid & 63, wave = tid >> 6;
    unsigned char* ws = p.ws;
    bf16_t* cq = (bf16_t*)(ws + WS_CQKV);
    const float* cosA = (const float*)(ws + WS_COSA); const float* sinA = (const float*)(ws + WS_SINA);
    const float gq0 = p.q_norm[layer * 128 + lane], gq1 = p.q_norm[layer * 128 + lane + 64];
    const float gk0 = p.k_norm[layer * 128 + lane], gk1 = p.k_norm[layer * 128 + lane + 64];
#pragma unroll 1
    for (int i0 = 0; i0 < 64; i0 += 16) {
        float x1[16], x2[16], cs[16], sn[16]; bf16_t* rp[16];
#pragma unroll
        for (int k = 0; k < 16; ++k) {
            const int rid = wave * 64 + i0 + k;
            const int tl = rid >> 3, qk = (rid >> 2) & 1, hh = rid & 3;
            const size_t tok = (size_t)unit * 64 + tl; const int t = (int)(tok & (SEQ - 1));
            rp[k] = cq + tok * 1536 + qk * 512 + hh * 128;
            x1[k] = bf2f(rp[k][lane]); x2[k] = bf2f(rp[k][lane + 64]);
            cs[k] = cosA[t * 64 + lane]; sn[k] = sinA[t * 64 + lane];
        }
        __builtin_amdgcn_sched_barrier(0);
        float ss[16];
#pragma unroll
        for (int k = 0; k < 16; ++k) ss[k] = x1[k] * x1[k] + x2[k] * x2[k];
#pragma unroll
        for (int k = 0; k < 16; ++k) ss[k] = wave_sum(ss[k]);
#pragma unroll
        for (int k = 0; k < 16; ++k) {
            const int qk = ((i0 + k) >> 2) & 1;
            const float rstd = __builtin_amdgcn_rsqf(ss[k] * (1.0f / 128.0f) + NORM_EPS);
            const float y1 = x1[k] * rstd * (qk ? gk0 : gq0), y2 = x2[k] * rstd * (qk ? gk1 : gq1);
            rp[k][lane] = (bf16_t)f2bf(y1 * cs[k] - y2 * sn[k]); rp[k][lane + 64] = (bf16_t)f2bf(y2 * cs[k] + y1 * sn[k]);
        }
    }
}

constexpr int IX_K = 0;
DI unsigned sortable(float f) { const unsigned u = __float_as_uint(f + 0.0f); return u ^ ((u >> 31) ? 0xffffffffu : 0x80000000u); }
DI void indexer_unit(const Params& p, int unit, unsigned char* lds) {
    int tid_ = threadIdx.x; asm volatile("" : "+v"(tid_)); const int tid = tid_, lane = tid & 63, wave = tid >> 6, fr = lane & 15, fq = lane >> 4;
    const int b = unit & 7, qb = 63 - (unit >> 3);
    unsigned char* ws = p.ws;
    const int t0 = qb * 32, tw = t0 + 4 * wave;
    const int tq = tw + fq;
    unsigned* mask = (unsigned*)(ws + WS_MASK) + ((size_t)b * SEQ + tq) * 64;
    if (t0 < 256) {
#pragma unroll
        for (int k = 0; k < 4; ++k) { const int wd = 16 * k + fr; const int lo = 32 * wd;
            unsigned m = 0u; if (tq >= lo + 31) m = 0xffffffffu; else if (tq >= lo) m = (2u << (tq - lo)) - 1u;
            mask[wd] = m; }
        return;
    }
    const bf16_t* cidx = (const bf16_t*)(ws + WS_CIDX);
    const float* cosI = (const float*)(ws + WS_COSI); const float* sinI = (const float*)(ws + WS_SINI);
    bf16x8 a0, a1;
    {
        const int ql = fr >> 2, hh = fr & 3; const int t = tw + ql;
        const bf16_t* qp = cidx + ((size_t)b * SEQ + t) * 320 + hh * 64;
        const u32x4 x1 = *(const u32x4*)(qp + 8 * fq), x2 = *(const u32x4*)(qp + 32 + 8 * fq);
        const f32x4 c0 = *(const f32x4*)(cosI + t * 32 + 8 * fq), c1 = *(const f32x4*)(cosI + t * 32 + 8 * fq + 4);
        const f32x4 s0 = *(const f32x4*)(sinI + t * 32 + 8 * fq), s1 = *(const f32x4*)(sinI + t * 32 + 8 * fq + 4);
        const float xa[8] = {lo_f(x1.x), hi_f(x1.x), lo_f(x1.y), hi_f(x1.y), lo_f(x1.z), hi_f(x1.z), lo_f(x1.w), hi_f(x1.w)};
        const float xb[8] = {lo_f(x2.x), hi_f(x2.x), lo_f(x2.y), hi_f(x2.y), lo_f(x2.z), hi_f(x2.z), lo_f(x2.w), hi_f(x2.w)};
        const float cc[8] = {c0[0], c0[1], c0[2], c0[3], c1[0], c1[1], c1[2], c1[3]};
        const float sn[8] = {s0[0], s0[1], s0[2], s0[3], s1[0], s1[1], s1[2], s1[3]};
        u32x4 w0, w1;
        w0.x = pk2(xa[0] * cc[0] - xb[0] * sn[0], xa[1] * cc[1] - xb[1] * sn[1]); w0.y = pk2(xa[2] * cc[2] - xb[2] * sn[2], xa[3] * cc[3] - xb[3] * sn[3]);
        w0.z = pk2(xa[4] * cc[4] - xb[4] * sn[4], xa[5] * cc[5] - xb[5] * sn[5]); w0.w = pk2(xa[6] * cc[6] - xb[6] * sn[6], xa[7] * cc[7] - xb[7] * sn[7]);
        w1.x = pk2(xb[0] * cc[0] + xa[0] * sn[0], xb[1] * cc[1] + xa[1] * sn[1]); w1.y = pk2(xb[2] * cc[2] + xa[2] * sn[2], xb[3] * cc[3] + xa[3] * sn[3]);
        w1.z = pk2(xb[4] * cc[4] + xa[4] * sn[4], xb[5] * cc[5] + xa[5] * sn[5]); w1.w = pk2(xb[6] * cc[6] + xa[6] * sn[6], xb[7] * cc[7] + xa[7] * sn[7]);
        a0 = __builtin_bit_cast(bf16x8, w0); a1 = __builtin_bit_cast(bf16x8, w1);
    }
    float wi[4];
    { const float* mp = (const float*)(ws + WS_MISC) + ((size_t)b * SEQ + tq) * 16 + 8;
#pragma unroll
      for (int j = 0; j < 4; ++j) wi[j] = mp[j] * 0.0625f; }
    unsigned sc[128];
    const int tmax = t0 + 31;
    const int skey = tid >> 1, hf = tid & 1;
    u32x4 xa0, xa1, xb0, xb1; f32x4 cv[4], sv[4];
#define IDX_LOAD(r) do { const int t_ = (r) * 256 + skey; const bf16_t* kp_ = cidx + ((size_t)b * SEQ + t_) * 320 + 256; \
        xa0 = *(const u32x4*)(kp_ + 16 * hf); xa1 = *(const u32x4*)(kp_ + 16 * hf + 8); xb0 = *(const u32x4*)(kp_ + 32 + 16 * hf); xb1 = *(const u32x4*)(kp_ + 32 + 16 * hf + 8); \
        _Pragma("unroll") for (int q = 0; q < 4; ++q) { cv[q] = *(const f32x4*)(cosI + t_ * 32 + 16 * hf + 4 * q); sv[q] = *(const f32x4*)(sinI + t_ * 32 + 16 * hf + 4 * q); } } while (0)
    IDX_LOAD(0);
#pragma unroll
    for (int r = 0; r < 8; ++r) {
        if (r * 256 <= tmax) {
            __syncthreads();
            {
                const unsigned xa[8] = {xa0.x, xa0.y, xa0.z, xa0.w, xa1.x, xa1.y, xa1.z, xa1.w};
                const unsigned xb[8] = {xb0.x, xb0.y, xb0.z, xb0.w, xb1.x, xb1.y, xb1.z, xb1.w};
                unsigned o1[8], o2[8];
#pragma unroll
                for (int q = 0; q < 8; ++q) {
                    const float c0 = cv[q >> 1][2 * (q & 1)], c1 = cv[q >> 1][2 * (q & 1) + 1], s0 = sv[q >> 1][2 * (q & 1)], s1 = sv[q >> 1][2 * (q & 1) + 1];
                    const float a_lo = lo_f(xa[q]), a_hi = hi_f(xa[q]), b_lo = lo_f(xb[q]), b_hi = hi_f(xb[q]);
                    o1[q] = pk2(a_lo * c0 - b_lo * s0, a_hi * c1 - b_hi * s1);
                    o2[q] = pk2(b_lo * c0 + a_lo * s0, b_hi * c1 + a_hi * s1);
                }
                u32x4 v; unsigned char* dp = lds + IX_K + skey * TP;
                v.x = o1[0]; v.y = o1[1]; v.z = o1[2]; v.w = o1[3]; *(u32x4*)(dp + (16 * hf) * 2) = v;
                v.x = o1[4]; v.y = o1[5]; v.z = o1[6]; v.w = o1[7]; *(u32x4*)(dp + (16 * hf + 8) * 2) = v;
                v.x = o2[0]; v.y = o2[1]; v.z = o2[2]; v.w = o2[3]; *(u32x4*)(dp + (32 + 16 * hf) * 2) = v;
                v.x = o2[4]; v.y = o2[5]; v.z = o2[6]; v.w = o2[7]; *(u32x4*)(dp + (32 + 16 * hf + 8) * 2) = v;
            }
            __syncthreads();
            if ((r + 1) * 256 <= tmax) IDX_LOAD(r + 1);
            __builtin_amdgcn_sched_barrier(0);
#pragma unroll
            for (int tt = 0; tt < 16; ++tt) {
                const int i = r * 16 + tt;
                const unsigned char* kp = lds + IX_K + (16 * tt + fr) * TP + (8 * fq) * 2;
                f32x4 acc = {0.f, 0.f, 0.f, 0.f};
                acc = mfma16(a0, ld16(kp), acc);
                acc = mfma16(a1, ld16(kp + 64), acc);
                const float s = wi[0] * fmaxf(acc[0], 0.f) + wi[1] * fmaxf(acc[1], 0.f) + wi[2] * fmaxf(acc[2], 0.f) + wi[3] * fmaxf(acc[3], 0.f);
                const int key = 16 * i + fr;
                sc[i] = (key <= tq) ? sortable(s) : 0u;
            }
        } else {
#pragma unroll
            for (int tt = 0; tt < 16; ++tt) sc[r * 16 + tt] = 0u;
        }
    }
#undef IDX_LOAD
    const int ngrp = (tmax >> 8) + 1;
    unsigned thr = 0u; bool fin = false;
#pragma unroll 1
    for (int bit = 31; bit >= 0; --bit) {
        const unsigned cand = thr | (1u << bit);
        int cnt = 0;
#pragma unroll
        for (int g = 0; g < 8; ++g) if (g < ngrp) {
            bool pr[16];
#pragma unroll
            for (int tt = 0; tt < 16; ++tt) pr[tt] = sc[g * 16 + tt] >= cand;
            __builtin_amdgcn_sched_barrier(0);
#pragma unroll
            for (int tt = 0; tt < 16; ++tt) cnt += pr[tt] ? 1 : 0;
            __builtin_amdgcn_sched_barrier(0);
        }
        cnt = row16_sumi(cnt);
        if (!fin && cnt >= 256) { thr = cand; fin = (cnt == 256); }
        if (__ballot(!fin) == 0ull) break;
    }
    int ngt = 0;
#pragma unroll
    for (int g = 0; g < 8; ++g) if (g < ngrp) {
        bool pr[16];
#pragma unroll
        for (int tt = 0; tt < 16; ++tt) pr[tt] = sc[g * 16 + tt] > thr;
        __builtin_amdgcn_sched_barrier(0);
#pragma unroll
        for (int tt = 0; tt < 16; ++tt) ngt += pr[tt] ? 1 : 0;
        __builtin_amdgcn_sched_barrier(0);
    }
    ngt = row16_sumi(ngt);
    const int need = 256 - ngt;
    int run = 0;
    unsigned w4[4] = {0u, 0u, 0u, 0u};
    const unsigned lowmask = (1u << fr) - 1u;
#pragma unroll
    for (int g = 0; g < 8; ++g) if (g < ngrp) {
#pragma unroll
        for (int tt = 0; tt < 16; ++tt) {
            const int i = g * 16 + tt;
            const bool eq = (sc[i] == thr);
            const unsigned long long be = __ballot(eq);
            const unsigned eqrow = (unsigned)(be >> (16 * fq)) & 0xffffu;
            const int rank = run + __popc(eqrow & lowmask);
            const bool sel = (sc[i] > thr) || (eq && rank < need);
            run += __popc(eqrow);
            const unsigned long long bs = __ballot(sel);
            const unsigned selrow = (unsigned)(bs >> (16 * fq)) & 0xffffu;
            if (fr == ((i >> 1) & 15)) w4[i >> 5] |= selrow << (16 * (i & 1));
        }
    }
#pragma unroll
    for (int k = 0; k < 4; ++k) mask[16 * k + fr] = w4[k];
}

constexpr int SB_W = 0, SB_QG = 17408, SB_KDT = 34816, SB_A = 53248, SB_BYTES = 62464, SB_RED = 2 * 62464;
DI void scan_unit(const Params& p, int layer, int unit, unsigned char* lds) {
    int tid_ = threadIdx.x; asm volatile("" : "+v"(tid_)); const int tid = tid_, lane = tid & 63, wave = tid >> 6, fr = lane & 15, fq = lane >> 4;
    const int h = unit & 3, b = unit >> 2;
    unsigned char* ws = p.ws;
    const unsigned char* su0 = ws + WS_SCAN + (size_t)((b * 4 + h) * 32) * SCAN_UNIT_BYTES;
    const float decv = ((const float*)(ws + WS_DEC))[(b * 4 + h) * 32 + (lane & 31)];
    bf16_t* az = (bf16_t*)(ws + WS_AZ);
    float* red = (float*)(lds + SB_RED);
    const int dvc = h * 128 + 16 * wave + fr;
    const float onw = p.dn_onorm[layer * 128 + 16 * wave + fr];
    const int r16 = tid >> 4, c16 = tid & 15, r8 = tid >> 3, c8 = tid & 7;
    const int c16s = c16 ^ (((r16 >> 4) & 1) << 2), c8s = c8 ^ (((r8 >> 4) & 1) << 2);
    const int prow = 8 * (fr >> 2) + (fr & 3);
    const int swz = ((fr >> 3) & 1) << 2;
    u32x4 pw0, pw1, pq0, pq1, pk0, pk1, pa0; u32x2 pu[4];
#define SCAN_PREFETCH(cc) do { const unsigned char* su = su0 + (size_t)(cc) * SCAN_UNIT_BYTES; \
        pw0 = *(const u32x4*)(su + SU_W + tid * 16); pw1 = *(const u32x4*)(su + SU_W + 8192 + tid * 16); \
        pq0 = *(const u32x4*)(su + SU_QG + tid * 16); pq1 = *(const u32x4*)(su + SU_QG + 8192 + tid * 16); \
        pk0 = *(const u32x4*)(su + SU_KDT + tid * 16); pk1 = *(const u32x4*)(su + SU_KDT + 8192 + tid * 16); \
        pa0 = *(const u32x4*)(su + SU_A + tid * 16); \
        _Pragma("unroll") for (int mt = 0; mt < 4; ++mt) pu[mt] = *(const u32x2*)(su + SU_UT + ((16 * wave + fr) * 64 + 32 * (mt >> 1) + 8 * fq + 4 * (mt & 1)) * 2); \
        } while (0)
#define SCAN_STORE(bufp) do { unsigned char* bp = (bufp); \
        *(u32x4*)(bp + SB_W + r16 * QP + c16s * 16) = pw0; *(u32x4*)(bp + SB_W + (r16 + 32) * QP + c16s * 16) = pw1; \
        *(u32x4*)(bp + SB_QG + r16 * QP + c16s * 16) = pq0; *(u32x4*)(bp + SB_QG + (r16 + 32) * QP + c16s * 16) = pq1; \
        *(u32x4*)(bp + SB_KDT + r8 * TP + c8s * 16) = pk0; *(u32x4*)(bp + SB_KDT + (r8 + 64) * TP + c8s * 16) = pk1; \
        *(u32x4*)(bp + SB_A + r8 * TP + c8s * 16) = pa0; } while (0)
    f32x4 st[8];
#pragma unroll
    for (int m = 0; m < 8; ++m) st[m] = (f32x4){0.f, 0.f, 0.f, 0.f};
    SCAN_PREFETCH(0);
    SCAN_STORE(lds);
    u32x2 cu[4];
#pragma unroll
    for (int i = 0; i < 4; ++i) cu[i] = pu[i];
    __syncthreads();
    SCAN_PREFETCH(1);
#pragma unroll 1
    for (int c = 0; c < 32; ++c) {
        const int cur = c & 1;
        const unsigned char* bp = lds + cur * SB_BYTES;
        const float dg = __builtin_bit_cast(float, __builtin_amdgcn_readlane(__builtin_bit_cast(int, decv), c));
        bf16_t cz[16];
#pragma unroll
        for (int mt = 0; mt < 4; ++mt)
#pragma unroll
            for (int jj = 0; jj < 4; ++jj) cz[mt * 4 + jj] = az[((size_t)b * SEQ + c * 64 + 32 * (mt >> 1) + 8 * fq + 4 * (mt & 1) + jj) * 512 + dvc];
        bf16x8 sb[4];
#pragma unroll
        for (int s = 0; s < 4; ++s) sb[s] = packf(st[2 * s], st[2 * s + 1]);
        bf16x8 fw[4][4];
#pragma unroll
        for (int mt = 0; mt < 4; ++mt)
#pragma unroll
            for (int s = 0; s < 4; ++s) fw[mt][s] = ld16(bp + SB_W + (32 * (mt >> 1) + 4 * (mt & 1) + prow) * QP + (((4 * s) ^ swz) + fq) * 16);
        __builtin_amdgcn_sched_barrier(0);
        f32x4 vn[4];
#pragma unroll
        for (int mt = 0; mt < 4; ++mt) vn[mt] = (f32x4){0.f, 0.f, 0.f, 0.f};
#pragma unroll
        for (int s = 0; s < 4; ++s)
#pragma unroll
            for (int mt = 0; mt < 4; ++mt) vn[mt] = mfma16(fw[mt][s], sb[s], vn[mt]);
        __builtin_amdgcn_sched_barrier(0);
#pragma unroll
        for (int mt = 0; mt < 4; ++mt)
#pragma unroll
            for (int s = 0; s < 4; ++s) fw[mt][s] = ld16(bp + SB_QG + (32 * (mt >> 1) + 4 * (mt & 1) + prow) * QP + (((4 * s) ^ swz) + fq) * 16);
#pragma unroll
        for (int mt = 0; mt < 4; ++mt) {
            vn[mt][0] = lo_f(cu[mt].x) - vn[mt][0]; vn[mt][1] = hi_f(cu[mt].x) - vn[mt][1]; vn[mt][2] = lo_f(cu[mt].y) - vn[mt][2]; vn[mt][3] = hi_f(cu[mt].y) - vn[mt][3];
        }
        bf16x8 vb[2];
#pragma unroll
        for (int s2 = 0; s2 < 2; ++s2) vb[s2] = packf(vn[2 * s2], vn[2 * s2 + 1]);
        __builtin_amdgcn_sched_barrier(0);
        f32x4 o[4];
#pragma unroll
        for (int mt = 0; mt < 4; ++mt) o[mt] = (f32x4){0.f, 0.f, 0.f, 0.f};
#pragma unroll
        for (int s = 0; s < 4; ++s)
#pragma unroll
            for (int mt = 0; mt < 4; ++mt) o[mt] = mfma16(fw[mt][s], sb[s], o[mt]);
        __builtin_amdgcn_sched_barrier(0);
#pragma unroll
        for (int mt = 0; mt < 4; ++mt)
#pragma unroll
            for (int s2 = 0; s2 < 2; ++s2) fw[mt][s2] = ld16(bp + SB_A + (32 * (mt >> 1) + 4 * (mt & 1) + prow) * TP + (((4 * s2) ^ swz) + fq) * 16);
        __builtin_amdgcn_sched_barrier(0);
#pragma unroll
        for (int s2 = 0; s2 < 2; ++s2)
#pragma unroll
            for (int mt = 0; mt < 4; ++mt) o[mt] = mfma16(fw[mt][s2], vb[s2], o[mt]);
        __builtin_amdgcn_sched_barrier(0);
#pragma unroll
        for (int m = 0; m < 8; ++m)
#pragma unroll
            for (int s2 = 0; s2 < 2; ++s2) fw[m >> 1][(m & 1) * 2 + s2] = ld16(bp + SB_KDT + (32 * (m >> 1) + 4 * (m & 1) + prow) * TP + (((4 * s2) ^ swz) + fq) * 16);
#pragma unroll
        for (int m = 0; m < 8; ++m) st[m] = st[m] * dg;
        __builtin_amdgcn_sched_barrier(0);
#pragma unroll
        for (int s2 = 0; s2 < 2; ++s2)
#pragma unroll
            for (int m = 0; m < 8; ++m) st[m] = mfma16(fw[m >> 1][(m & 1) * 2 + s2], vb[s2], st[m]);
        __builtin_amdgcn_sched_barrier(0);
        {
            f32x4 sq[4];
#pragma unroll
            for (int mt = 0; mt < 4; ++mt)
#pragma unroll
                for (int jj = 0; jj < 4; ++jj) sq[mt][jj] = row16_sum(o[mt][jj] * o[mt][jj]);
            if (fr == 0) {
#pragma unroll
                for (int mt = 0; mt < 4; ++mt) *(f32x4*)(red + (cur * 8 + wave) * 64 + 32 * (mt >> 1) + 8 * fq + 4 * (mt & 1)) = sq[mt];
            }
        }
        if (c + 1 < 32) SCAN_STORE(lds + (cur ^ 1) * SB_BYTES);
        __syncthreads();
        u32x2 nu[4];
#pragma unroll
        for (int i = 0; i < 4; ++i) nu[i] = pu[i];
        if (c + 2 < 32) SCAN_PREFETCH(c + 2);
#pragma unroll
        for (int mt = 0; mt < 4; ++mt)
#pragma unroll
            for (int jj = 0; jj < 4; ++jj) {
                const int row = 32 * (mt >> 1) + 8 * fq + 4 * (mt & 1) + jj;
                float tot = 0.f;
#pragma unroll
                for (int w8 = 0; w8 < 8; ++w8) tot += red[(cur * 8 + w8) * 64 + row];
                const float rstd = __builtin_amdgcn_rsqf(tot * (1.0f / 128.0f) + NORM_EPS);
                const float zv = bf2f(cz[mt * 4 + jj]);
                const float y = o[mt][jj] * rstd * onw * zv * __builtin_amdgcn_rcpf(1.0f + __expf(-zv));
                az[((size_t)b * SEQ + c * 64 + row) * 512 + dvc] = (bf16_t)f2bf(y);
            }
#pragma unroll
        for (int i = 0; i < 4; ++i) cu[i] = nu[i];
    }
#undef SCAN_PREFETCH
#undef SCAN_STORE
}

constexpr int AT_K = 0, AT_VT = 17408;
DI void attn_unit(const Params& p, int unit, unsigned char* lds) {
    int tid_ = threadIdx.x; asm volatile("" : "+v"(tid_)); const int tid = tid_, lane = tid & 63, wave = tid >> 6, fr = lane & 15, fq = lane >> 4;
    const int qb = 15 - (unit >> 5), bh = unit & 31, b = bh >> 2, hh = bh & 3;
    unsigned char* ws = p.ws;
    const bf16_t* cq = (const bf16_t*)(ws + WS_CQKV);
    const int q0 = qb * 128, tq = q0 + 16 * wave + fr;
    const size_t tokq = (size_t)b * SEQ + tq;
    const unsigned* mrow = (const unsigned*)(ws + WS_MASK) + tokq * 64;
    bf16x8 qf[4];
#pragma unroll
    for (int s = 0; s < 4; ++s) qf[s] = *(const bf16x8*)(cq + tokq * 1536 + hh * 128 + 32 * s + 8 * fq);
    f32x4 oacc[8];
#pragma unroll
    for (int i = 0; i < 8; ++i) oacc[i] = (f32x4){0.f, 0.f, 0.f, 0.f};
    float mrun = -INFINITY, lrun = 0.f;
    const int nkt = (q0 + 128) / 64;
    const int kr = tid >> 4, kc = tid & 15, vk = 2 * (tid & 31), vp = tid >> 5;
    const int kcs = kc ^ (((kr >> 4) & 1) << 2);
    const int prow = 8 * (fr >> 2) + (fr & 3), swz = ((fr >> 3) & 1) << 2;
    u32x4 gk0, gk1, gv0, gv1;
#define ATT_PREFETCH(kt) do { const size_t kb = (size_t)b * SEQ + (size_t)(kt) * 64; \
        gk0 = *(const u32x4*)(cq + (kb + kr) * 1536 + 512 + hh * 128 + kc * 8); gk1 = *(const u32x4*)(cq + (kb + kr + 32) * 1536 + 512 + hh * 128 + kc * 8); \
        gv0 = *(const u32x4*)(cq + (kb + vk) * 1536 + 1024 + hh * 128 + vp * 8); gv1 = *(const u32x4*)(cq + (kb + vk + 1) * 1536 + 1024 + hh * 128 + vp * 8); } while (0)
    ATT_PREFETCH(0);
    const float scl = 0.08838834764831845f * 1.4426950408889634f;
#pragma unroll 1
    for (int kt = 0; kt < nkt; ++kt) {
        __syncthreads();
        *(u32x4*)(lds + AT_K + kr * QP + kcs * 16) = gk0; *(u32x4*)(lds + AT_K + (kr + 32) * QP + kcs * 16) = gk1;
        {
            const unsigned a[4] = {gv0.x, gv0.y, gv0.z, gv0.w}, c4[4] = {gv1.x, gv1.y, gv1.z, gv1.w};
#pragma unroll
            for (int e = 0; e < 4; ++e) {
                *(unsigned*)(lds + AT_VT + (8 * vp + 2 * e) * TP + vk * 2) = (a[e] & 0xffffu) | (c4[e] << 16);
                *(unsigned*)(lds + AT_VT + (8 * vp + 2 * e + 1) * TP + vk * 2) = (a[e] >> 16) | (c4[e] & 0xffff0000u);
            }
        }
        const u32x2 mw = *(const u32x2*)(mrow + 2 * kt);
        __syncthreads();
        if (kt + 1 < nkt) ATT_PREFETCH(kt + 1);
        bf16x8 kf[4][4];
#pragma unroll
        for (int nt = 0; nt < 4; ++nt)
#pragma unroll
            for (int s = 0; s < 4; ++s) kf[nt][s] = ld16(lds + AT_K + (32 * (nt >> 1) + 4 * (nt & 1) + prow) * QP + (((4 * s) ^ swz) + fq) * 16);
        __builtin_amdgcn_sched_barrier(0);
        f32x4 sacc[4];
#pragma unroll
        for (int nt = 0; nt < 4; ++nt) sacc[nt] = (f32x4){0.f, 0.f, 0.f, 0.f};
#pragma unroll
        for (int s = 0; s < 4; ++s)
#pragma unroll
            for (int nt = 0; nt < 4; ++nt) sacc[nt] = mfma16(kf[nt][s], qf[s], sacc[nt]);
        __builtin_amdgcn_sched_barrier(0);
#pragma unroll
        for (int nd = 0; nd < 8; ++nd)
#pragma unroll
            for (int s2 = 0; s2 < 2; ++s2) kf[nd >> 1][(nd & 1) * 2 + s2] = ld16(lds + AT_VT + (16 * nd + fr) * TP + (32 * s2 + 8 * fq) * 2);
        float mx = -INFINITY;
#pragma unroll
        for (int nt = 0; nt < 4; ++nt)
#pragma unroll
            for (int jj = 0; jj < 4; ++jj) { const int kk = 32 * (nt >> 1) + 8 * fq + 4 * (nt & 1) + jj; const unsigned wsel = (nt < 2) ? mw.x : mw.y;
                const bool on = (wsel >> (kk & 31)) & 1u;
                const float v = on ? sacc[nt][jj] * scl : -INFINITY; sacc[nt][jj] = v; mx = fmaxf(mx, v); }
        mx = fmaxf(mx, __shfl_xor(mx, 16)); mx = fmaxf(mx, __shfl_xor(mx, 32));
        const float mnew = fmaxf(mrun, mx);
        const float msafe = (mnew == -INFINITY) ? 0.f : mnew;
        const float alpha = __builtin_amdgcn_exp2f(mrun - msafe);
        mrun = mnew;
        float ps = 0.f;
#pragma unroll
        for (int nt = 0; nt < 4; ++nt)
#pragma unroll
            for (int jj = 0; jj < 4; ++jj) { const float pv = __builtin_amdgcn_exp2f(sacc[nt][jj] - msafe); sacc[nt][jj] = pv; ps += pv; }
        lrun = lrun * alpha + ps;
        bf16x8 pb[2];
#pragma unroll
        for (int s2 = 0; s2 < 2; ++s2) pb[s2] = packf(sacc[2 * s2], sacc[2 * s2 + 1]);
#pragma unroll
        for (int nd = 0; nd < 8; ++nd) oacc[nd] = oacc[nd] * alpha;
        __builtin_amdgcn_sched_barrier(0);
#pragma unroll
        for (int s2 = 0; s2 < 2; ++s2)
#pragma unroll
            for (int nd = 0; nd < 8; ++nd) oacc[nd] = mfma16(kf[nd >> 1][(nd & 1) * 2 + s2], pb[s2], oacc[nd]);
        __builtin_amdgcn_sched_barrier(0);
    }
#undef ATT_PREFETCH
    lrun += __shfl_xor(lrun, 16); lrun += __shfl_xor(lrun, 32);
    const float inv = 1.0f / lrun;
    bf16_t* czp = (bf16_t*)(ws + WS_CZ) + tokq * 512 + hh * 128;
#pragma unroll
    for (int nd = 0; nd < 8; ++nd) {
        bf16_t* zp = czp + 16 * nd + 4 * fq;
        const u32x2 zz = *(const u32x2*)zp;
        f32x4 o; o[0] = oacc[nd][0] * inv * siluf(lo_f(zz.x)); o[1] = oacc[nd][1] * inv * siluf(hi_f(zz.x)); o[2] = oacc[nd][2] * inv * siluf(lo_f(zz.y)); o[3] = oacc[nd][3] * inv * siluf(hi_f(zz.y));
        *(u32x2*)zp = pack4(o);
    }
}

DI void rms_unit(const Params& p, int layer, const float* xin, int unit) {
    int tid_ = threadIdx.x; asm volatile("" : "+v"(tid_)); const int lane = tid_ & 63, wave = tid_ >> 6;
    const float* ng = p.norm_g + layer * DM;
    for (int i = 0; i < 8; i += 2) { const size_t m = (size_t)unit * 64 + wave * 8 + i; rms_row2(xin + m * DM, ng, (bf16_t*)(p.ws + WS_H2) + m * DM, lane); }
}

#ifndef GEMM_ALIGN
#define GEMM_ALIGN true
#endif
#ifndef GEMM_SP2
#define GEMM_SP2 true
#endif
#ifndef MK_SPLIT
#define MK_SPLIT 0
#endif
constexpr int NPHASE = 14;
constexpr int P2_IDX = 512, P2_DN = 1024, P2_POOL = 1024, P2_SA = 256, P2_TOTAL = P2_IDX + P2_DN + P2_POOL + P2_SA;
constexpr int P3_SCAN = 32, P3_ATT = 512, P3_RMS = 256, P3_TOTAL = P3_SCAN + P3_ATT + P3_RMS;

__global__ void __launch_bounds__(NTHR, 2) hybrid_fwd(Params p) {
    extern __shared__ __attribute__((aligned(16))) unsigned char lds[];
    unsigned char* ws = p.ws;
    unsigned* ctl = (unsigned*)(ws + WS_CTL);
    const int G = gridDim.x;
    PG8_LAS unsigned char* glds = (PG8_LAS unsigned char*)lds;
#if MK_SPLIT
#define SEAM(k) do { } while (0)
#else
    cg::grid_group grid = cg::this_grid();
    volatile LAS unsigned* bst = (volatile LAS unsigned*)((LAS unsigned char*)lds + LDS_SLOT + 16);
    if (threadIdx.x == 0) { bst[0] = 0u; bst[1] = 0u; }
    __syncthreads();
    XcdBarrier bar = xcd_barrier_post(ctl + 1024, bst);
#define SEAM(k) do { if (p.ph_lo <= (k) && (k) + 1 < p.ph_hi) { if (p.ph_hi > NPHASE) grid.sync(); else xcd_barrier(bar); } } while (0)
#endif
#define IN(k) (p.ph_lo <= (k) && (k) < p.ph_hi)
#ifdef PROBE_K
#ifndef PROBE_BLK
#define PROBE_BLK 0
#endif
#ifndef PROBE_T1
#define PROBE_T1 (PROBE_K + 1)
#endif
#define stamps ((unsigned long long*)(p.ws + WS_CTL + 24576))
#define STAMP(k) do { int t_ = threadIdx.x; asm volatile("" : "+v"(t_)); if (blockIdx.x == 0 && t_ == 0) stamps[(k)] = __builtin_amdgcn_s_memrealtime(); } while (0)
    STAMP(0);
#else
#define STAMP(k) do { } while (0)
#endif
#pragma unroll 1
    for (int layer = 0; layer < 2; ++layer) {
        const int pb = layer * 7;
        const float* xin = layer == 0 ? p.x : (const float*)p.out;
        if (IN(pb + 0)) {
#ifndef NO_P0
 phase0(p, layer, xin, lds);
#endif
 }
        SEAM(pb + 0); STAMP(pb + 0 + 1);
        if (IN(pb + 1)) {
            pg8::Gemm g{(const bf16_t*)(ws + WS_H), (const bf16_t*)(ws + WS_WIN1), MTOK, N1, 1024}; pg8::StaticOrder S; S.init(MTOK, N1, G, (int)blockIdx.x);
            pg8::EpiProj E{ws};

#ifndef NO_G1
 pg8::gemm_phase<pg8::EpiProj, pg8::StaticOrder, GEMM_ALIGN, GEMM_SP2>(glds, g, S, E);
#endif

        }
        SEAM(pb + 1); STAMP(pb + 1 + 1);
        if (IN(pb + 2)) {
            const int k = (int)blockIdx.x;
            for (int i = k; i < P2_IDX / 2; i += G) { __syncthreads(); indexer_unit(p, i, lds);
#ifdef PROBE_K
                { int t_ = threadIdx.x; asm volatile("" : "+v"(t_)); if (layer == 0 && (int)blockIdx.x == PROBE_BLK && t_ == 0) stamps[24] = __builtin_amdgcn_s_memrealtime(); }
#endif
                __syncthreads(); indexer_unit(p, P2_IDX - 1 - i, lds);
#ifdef PROBE_K
                { int t_ = threadIdx.x; asm volatile("" : "+v"(t_)); if (layer == 0 && (int)blockIdx.x == PROBE_BLK && t_ == 0) stamps[25] = __builtin_amdgcn_s_memrealtime(); }
#endif
            }
#ifdef PROBE_K
            if (layer == 0 && threadIdx.x == 0) atomicMax(&stamps[22], (unsigned long long)__builtin_amdgcn_s_memrealtime());
#endif
            for (int u = k; u < P2_DN; u += G) { __syncthreads(); dn_prep_unit(p, layer, u, lds); }
#ifdef PROBE_K
            if (layer == 0 && threadIdx.x == 0) atomicMax(&stamps[23], (unsigned long long)__builtin_amdgcn_s_memrealtime());
#endif
            for (int u = k; u < P2_SA; u += G) { __syncthreads(); sa_prep_unit(p, layer, u, lds); }
        }
        SEAM(pb + 2); STAMP(pb + 2 + 1);
        if (IN(pb + 3)) {
            const int k = (int)blockIdx.x, nsc = (G > 2 * P3_SCAN) ? P3_SCAN : 0, nb = G - nsc;
            if (k < nsc) {
                scan_unit(p, layer, k, lds);
#ifdef PROBE_K
                { int t_ = threadIdx.x; asm volatile("" : "+v"(t_)); if (layer == 0 && k == 0 && t_ == 0) stamps[20] = __builtin_amdgcn_s_memrealtime(); }
#endif
            } else {
                const int j = k - nsc;
                if (nsc == 0) for (int u = j; u < P3_SCAN; u += nb) { __syncthreads(); scan_unit(p, layer, u, lds); }
                for (int r = 0; r * nb < P3_ATT; ++r) { const int i = r * nb + ((r & 1) ? (nb - 1 - j) : j); if (i < P3_ATT) { __syncthreads(); attn_unit(p, i, lds); } }
#ifdef PROBE_K
                if (layer == 0 && threadIdx.x == 0) atomicMax(&stamps[21], (unsigned long long)__builtin_amdgcn_s_memrealtime());
#endif
                for (int u = j; u < P3_RMS; u += nb) rms_unit(p, layer, xin, u);
                for (int u = j; u < P2_POOL; u += nb) { __syncthreads(); pool_unit(p, layer, u, lds); }
            }
        }
        SEAM(pb + 3); STAMP(pb + 3 + 1);
        if (IN(pb + 4)) {
            pg8::Gemm g{(const bf16_t*)(ws + WS_H2), (const bf16_t*)(ws + WS_WG), MTOK, NG, 1024}; pg8::GateOrder S; S.init(G, (int)blockIdx.x);
            pg8::EpiGate E{ws, p.gate_b + layer * 3072};

#ifndef NO_G4
 pg8::gemm_phase<pg8::EpiGate, pg8::GateOrder, GEMM_ALIGN, GEMM_SP2>(glds, g, S, E);
#endif

        }
        asm volatile("s_waitcnt vmcnt(0)" ::: "memory"); __syncthreads(); STAMP(pb + 4 + 1);
        if (IN(pb + 5)) {
            pg8::Gemm g{(const bf16_t*)(ws + WS_AZ), (const bf16_t*)(ws + WS_WBR), 3 * MTOK, 3072, 512}; pg8::MergeOrder S; S.init(G, (int)blockIdx.x);
            pg8::EpiMerge E{ws};

#ifndef NO_G5
 pg8::gemm_phase<pg8::EpiMerge, pg8::MergeOrder, GEMM_ALIGN, GEMM_SP2>(glds, g, S, E);
#endif

        }
        SEAM(pb + 5); STAMP(pb + 5 + 1);
        if (IN(pb + 6)) {
            pg8::Gemm g{(const bf16_t*)(ws + WS_MERGED), (const bf16_t*)(ws + WS_WO), MTOK, 1024, 1024}; pg8::StaticOrder S; S.init(MTOK, 1024, G, (int)blockIdx.x);
            pg8::EpiOut E{xin, p.out};

#ifndef NO_G6
 pg8::gemm_phase<pg8::EpiOut, pg8::StaticOrder, GEMM_ALIGN, GEMM_SP2>(glds, g, S, E);
#endif

        }
        SEAM(pb + 6); STAMP(pb + 6 + 1);
    }
#ifdef PROBE_K
    __syncthreads();
    if (threadIdx.x == 0) __threadfence();
    xcd_barrier(bar);
    {
        const unsigned long long t0 = __hip_atomic_load(&stamps[PROBE_K], __ATOMIC_RELAXED, __HIP_MEMORY_SCOPE_AGENT), t1 = __hip_atomic_load(&stamps[PROBE_T1], __ATOMIC_RELAXED, __HIP_MEMORY_SCOPE_AGENT);
#ifdef PROBE_A
        const unsigned long long ta = __hip_atomic_load(&stamps[PROBE_A], __ATOMIC_RELAXED, __HIP_MEMORY_SCOPE_AGENT), tb = __hip_atomic_load(&stamps[PROBE_B], __ATOMIC_RELAXED, __HIP_MEMORY_SCOPE_AGENT);
        const float d1 = (float)(ta - t0) * 0.01f, d2 = (float)(tb - t0) * 0.01f * 30.0f;
        for (int i = blockIdx.x * NTHR + threadIdx.x; i < (1 << 20); i += gridDim.x * NTHR) p.out[i] += d1;
        if (blockIdx.x == 0 && threadIdx.x == 0) p.out[(1 << 21) + 12345] += d2;
#else
        const float dlt = (float)(t1 - t0) * 0.01f * 2e-5f;
        for (int i = blockIdx.x * NTHR + threadIdx.x; i < (1 << 20); i += gridDim.x * NTHR) p.out[i] += dlt;
#endif
    }
#endif
#undef IN
#undef SEAM
}

extern "C" void kernel_launch(void* const* d_in, const int* in_sizes, int n_in, void* d_out, int out_size, void* d_ws, size_t ws_size, hipStream_t stream) {
    static int grid = 0;
    if (grid == 0) {
        if (n_in != 14 || in_sizes[0] != MTOK * DM || out_size != MTOK * DM || ws_size < WS_END) { fprintf(stderr, "kernel_launch: unexpected shapes / workspace (%d inputs, ws %zu)\n", n_in, ws_size); grid = -1; return; }
        int dev = 0, cus = 0, per_cu = 0;
        if (hipGetDevice(&dev) != hipSuccess || hipDeviceGetAttribute(&cus, hipDeviceAttributeMultiprocessorCount, dev) != hipSuccess) { grid = -1; return; }
        if (hipFuncSetAttribute((const void*)hybrid_fwd, hipFuncAttributeMaxDynamicSharedMemorySize, LDS_BYTES) != hipSuccess) { fprintf(stderr, "kernel_launch: hipFuncSetAttribute failed\n"); grid = -1; return; }
        if (hipOccupancyMaxActiveBlocksPerMultiprocessor(&per_cu, (const void*)hybrid_fwd, NTHR, LDS_BYTES) != hipSuccess || per_cu < 1) { fprintf(stderr, "kernel_launch: occupancy query says %d\n", per_cu); per_cu = 1; }
        (void)hipGetLastError();
        grid = cus * per_cu;
    }
    if (grid < 0) return;
    (void)hipMemsetAsync((char*)d_ws + WS_CTL, 0, CTL_BYTES, stream);
    Params p{};
    p.x = (const float*)d_in[0]; p.norm_g = (const float*)d_in[1]; p.w_in = (const float*)d_in[2]; p.gate_b = (const float*)d_in[3]; p.conv_w = (const float*)d_in[4];
    p.a_log = (const float*)d_in[5]; p.dt_bias = (const float*)d_in[6]; p.dn_onorm = (const float*)d_in[7]; p.pool_w = (const float*)d_in[8]; p.pool_scale = (const float*)d_in[9];
    p.q_norm = (const float*)d_in[10]; p.k_norm = (const float*)d_in[11]; p.w_branch = (const float*)d_in[12]; p.w_out = (const float*)d_in[13];
    p.out = (float*)d_out; p.ws = (unsigned char*)d_ws;
#if MK_SPLIT
    for (int ph = 0; ph < NPHASE; ++ph) { p.ph_lo = ph; p.ph_hi = ph + 1; hipLaunchKernelGGL(hybrid_fwd, dim3(grid), dim3(NTHR), LDS_BYTES, stream, p); }
#else
    p.ph_lo = 0; p.ph_hi = NPHASE;
    void* args[] = {&p};
    const hipError_t e = hipLaunchCooperativeKernel((const void*)hybrid_fwd, dim3(grid), dim3(NTHR), args, LDS_BYTES, stream);
    if (e != hipSuccess) fprintf(stderr, "kernel_launch: cooperative launch failed: %s (grid %d)\n", hipGetErrorString(e), grid);
#endif
}
```

```cpp
#include <hip/hip_runtime.h>
#include <hip/hip_cooperative_groups.h>
#include <cstdio>
#include <cstdint>
#include <cmath>
namespace cg = cooperative_groups;
constexpr int BATCH = 8, SEQ = 2048, DM = 1024, MTOK = BATCH * SEQ;
constexpr int INW = 8524;
constexpr int N1 = 5632;
constexpr int NG = 3072;
constexpr float NORM_EPS = 1e-6f;
constexpr size_t MiB = 1u << 20;
constexpr size_t WS_CTL = 0;
constexpr size_t CTL_BYTES = 32768;
constexpr size_t WS_COSA = 1 * MiB, WS_SINA = WS_COSA + 512 * 1024;
constexpr size_t WS_COSI = 2 * MiB, WS_SINI = WS_COSI + 256 * 1024;
constexpr size_t WS_DEC = 2 * MiB + 512 * 1024;
constexpr size_t WS_MISC = 3 * MiB;
constexpr size_t WS_WG = 4 * MiB;
constexpr size_t WS_WBR = 10 * MiB;
constexpr size_t WS_WO = 13 * MiB;
constexpr size_t WS_POOLW = 15 * MiB;
constexpr size_t WS_MASK = 16 * MiB;
constexpr size_t WS_R1 = 20 * MiB;
constexpr size_t WS_H = WS_R1;
constexpr size_t WS_WIN1 = WS_R1 + 32 * MiB;
constexpr size_t WS_SCAN = WS_R1;
constexpr size_t WS_G0 = WS_R1, WS_G1 = WS_R1 + 32 * MiB;
constexpr size_t WS_R2 = 93 * MiB;
constexpr size_t WS_AQKV = WS_R2;
constexpr size_t WS_H2 = WS_R2;
constexpr size_t WS_MERGED = WS_G0;
constexpr size_t WS_R3 = 141 * MiB;
constexpr size_t WS_CQKV = WS_R3;
constexpr size_t WS_G2 = WS_R3;
constexpr size_t WS_AZ = 189 * MiB, WS_BZ = 205 * MiB, WS_CZ = 221 * MiB, WS_BU = 237 * MiB;
constexpr size_t WS_CIDX = 253 * MiB;
constexpr size_t WS_END = 263 * MiB;
constexpr int SCAN_UNIT_BYTES = 73728;
constexpr int SU_W = 0, SU_QG = 16384, SU_KDT = 32768, SU_UT = 49152, SU_A = 65536;
namespace pg8 {
#define PG8_LAS __attribute__((address_space(3)))
typedef unsigned short bf16_t;
typedef short bf16x8 __attribute__((ext_vector_type(8)));
typedef float f32x4 __attribute__((ext_vector_type(4)));
typedef unsigned u32x4 __attribute__((ext_vector_type(4)));
constexpr int BM = 256, BK = 64, HALF = 128, HTB = HALF * BK * 2  , STAGE_BYTES = 8 * HTB, NXCD = 8, WGM = 8;

__host__ __device__ __forceinline__ int lds_byte(int r, int c) { const int st = (r >> 4) * 2 + (c >> 5), rr = r & 15, cc = c & 31, ob = rr * 64 + cc * 2; return st * 1024 + (ob ^ (((ob >> 9) & 1) << 5)); }
__host__ __device__ __forceinline__ void stage_rc(int b, int& R, int& C) { const int st = b / 1024, sb = b % 1024, swz = sb ^ (((sb >> 9) & 1) << 5); R = (st >> 1) * 16 + swz / 64; C = (st & 1) * 32 + (swz % 64) / 2; }
__host__ __device__ __forceinline__ int perm32(int rho) { const int n = rho >> 4, i = rho & 15; return 8 * (i >> 2) + 4 * n + (i & 3); }

struct Unit { int pm, pn; };
struct Gemm { const bf16_t* A; const bf16_t* Bt; int M, N, K; };

struct StaticOrder {
    int nM, nN, nwg, G, c;
    __host__ __device__ void init(int M, int N, int G_, int c_) { nM = M / BM; nN = N / BM; nwg = nM * nN; G = G_; c = c_; }
    __host__ __device__ bool next(int i, Unit& u) const {
        const long L = (long)i * G + c; if (L >= nwg) return false;
        int wgid = (int)L; { const int q = nwg / NXCD, r = nwg % NXCD, xcd = wgid % NXCD, off = wgid / NXCD; wgid = (xcd < r ? xcd * (q + 1) : r * (q + 1) + (xcd - r) * q) + off; }
        const int nig = WGM * nN, gid = wgid / nig, fm = gid * WGM, gsz = (nM - fm) < WGM ? (nM - fm) : WGM;
        u.pm = fm + ((wgid % nig) % gsz); u.pn = (wgid % nig) / gsz; return true;
    }
    __device__ __forceinline__ void a_ready(const Unit&) const {}
    __device__ __forceinline__ void done(const Unit&) const {}
};

typedef float f32x2c __attribute__((ext_vector_type(2))); typedef __bf16 bf16x2c __attribute__((ext_vector_type(2)));
__device__ __forceinline__ unsigned cvt_pk_bf16(float lo, float hi) { const f32x2c v = {lo, hi}; return __builtin_bit_cast(unsigned, __builtin_convertvector(v, bf16x2c)); }
struct EpiProj {
    static constexpr bool PERM = true, AFTER_DRAIN = false;
    unsigned char* ws;
    __device__ __forceinline__ void operator()(const f32x4 (&acc)[2][2][4][2], const Unit& u, int wr, int wc, int fr, int fq) const {
        const int pn = u.pn; const int row0 = u.pm * BM + wr * 64 + fr;
        if (pn == 21) {
            const int c = wc * 32 + 8 * fq;
            if (c < 80) {
#pragma unroll
                for (int ai = 0; ai < 2; ++ai)
#pragma unroll
                    for (int m = 0; m < 4; ++m) { const size_t row = (size_t)(row0 + ai * HALF + m * 16); const f32x4 v0 = acc[ai][0][m][0], v1 = acc[ai][0][m][1];
                        if (c < 64) { u32x4 w; w.x = cvt_pk_bf16(v0[0], v0[1]); w.y = cvt_pk_bf16(v0[2], v0[3]); w.z = cvt_pk_bf16(v1[0], v1[1]); w.w = cvt_pk_bf16(v1[2], v1[3]);
                            *(u32x4*)((bf16_t*)(ws + WS_CIDX) + row * 320 + 256 + c) = w; }
                        else { float* mp = (float*)(ws + WS_MISC) + row * 16 + (c - 64); *(f32x4*)mp = v0; *(f32x4*)(mp + 4) = v1; } }
            }
            return;
        }
        size_t off; int ldc, colt;
        if (pn < 6) { off = WS_AQKV; ldc = 1536; colt = pn * 256; }
        else if (pn < 8) { off = WS_AZ; ldc = 512; colt = (pn - 6) * 256; }
        else if (pn < 10) { off = WS_BU; ldc = 512; colt = (pn - 8) * 256; }
        else if (pn < 12) { off = WS_BZ; ldc = 512; colt = (pn - 10) * 256; }
        else if (pn < 18) { off = WS_CQKV; ldc = 1536; colt = (pn - 12) * 256; }
        else if (pn < 20) { off = WS_CZ; ldc = 512; colt = (pn - 18) * 256; }
        else { off = WS_CIDX; ldc = 320; colt = 0; }
        bf16_t* base = (bf16_t*)(ws + off); const int col0 = colt + wc * 32 + 8 * fq;
#pragma unroll
        for (int ai = 0; ai < 2; ++ai)
#pragma unroll
            for (int m = 0; m < 4; ++m) { bf16_t* rowp = base + (size_t)(row0 + ai * HALF + m * 16) * ldc + col0;
#pragma unroll
                for (int bj = 0; bj < 2; ++bj) { const f32x4 v0 = acc[ai][bj][m][0], v1 = acc[ai][bj][m][1];
                    u32x4 w; w.x = cvt_pk_bf16(v0[0], v0[1]); w.y = cvt_pk_bf16(v0[2], v0[3]); w.z = cvt_pk_bf16(v1[0], v1[1]); w.w = cvt_pk_bf16(v1[2], v1[3]);
                    *(u32x4*)(rowp + bj * HALF) = w; } }
    }
};
__device__ __forceinline__ float sigm(float x) { return __builtin_amdgcn_rcpf(1.0f + __expf(-x)); }
struct EpiGate {
    static constexpr bool PERM = true, AFTER_DRAIN = false;
    unsigned char* ws; const float* gb;
    __device__ __forceinline__ void operator()(const f32x4 (&acc)[2][2][4][2], const Unit& u, int wr, int wc, int fr, int fq) const {
        const int pn = u.pn, br = pn >> 2; const int row0 = u.pm * BM + wr * 64 + fr;
        bf16_t* base = (bf16_t*)(ws + (br == 0 ? WS_G0 : (br == 1 ? WS_G1 : WS_G2)));
        const int col0 = (pn & 3) * 256 + wc * 32 + 8 * fq; const float* bp = gb + br * 1024 + col0;
        f32x4 bv[2][2];
#pragma unroll
        for (int bj = 0; bj < 2; ++bj)
#pragma unroll
            for (int n = 0; n < 2; ++n) bv[bj][n] = *(const f32x4*)(bp + bj * HALF + 4 * n);
#pragma unroll
        for (int ai = 0; ai < 2; ++ai)
#pragma unroll
            for (int m = 0; m < 4; ++m) { bf16_t* rowp = base + (size_t)(row0 + ai * HALF + m * 16) * 1024 + col0;
#pragma unroll
                for (int bj = 0; bj < 2; ++bj) { const f32x4 v0 = acc[ai][bj][m][0] + bv[bj][0], v1 = acc[ai][bj][m][1] + bv[bj][1];
                    u32x4 w; w.x = cvt_pk_bf16(sigm(v0[0]), sigm(v0[1])); w.y = cvt_pk_bf16(sigm(v0[2]), sigm(v0[3])); w.z = cvt_pk_bf16(sigm(v1[0]), sigm(v1[1])); w.w = cvt_pk_bf16(sigm(v1[2]), sigm(v1[3]));
                    *(u32x4*)(rowp + bj * HALF) = w; } }
    }
};
__device__ __forceinline__ float bflo(unsigned w) { return __uint_as_float(w << 16); }
__device__ __forceinline__ float bfhi(unsigned w) { return __uint_as_float(w & 0xffff0000u); }
struct GateOrder {
    int G, c;
    __device__ __forceinline__ void init(int G_, int c_) { G = G_; c = c_; }
    __device__ __forceinline__ bool next(int i, Unit& u) const {
        const int t = i / 3, br = i - 3 * t; int L = t * G + c; if (L >= 256) return false;
        if (G == 256) L = (L & 7) * 32 + (L >> 3);
        u.pm = L >> 2; u.pn = br * 4 + (L & 3); return true;
    }
    __device__ __forceinline__ void a_ready(const Unit&) const {}
    __device__ __forceinline__ void done(const Unit&) const {}
};
struct MergeOrder {
    int G, c;
    __device__ __forceinline__ void init(int G_, int c_) { G = G_; c = c_; }
    __device__ __forceinline__ bool next(int i, Unit& u) const {
        const int t = i / 3, br = i - 3 * t; int L = t * G + c; if (L >= 256) return false;
        if (G == 256) L = (L & 7) * 32 + (L >> 3);
        u.pm = br * 64 + (L >> 2); u.pn = br * 4 + (L & 3); return true;
    }
    __device__ __forceinline__ void a_ready(const Unit&) const {}
    __device__ __forceinline__ void done(const Unit&) const {}
};
struct EpiMerge {
    static constexpr bool PERM = true, AFTER_DRAIN = false;
    unsigned char* ws;
    __device__ __forceinline__ void operator()(const f32x4 (&acc)[2][2][4][2], const Unit& u, int wr, int wc, int fr, int fq) const {
        const int br = u.pm >> 6, pm = u.pm & 63, pn = u.pn & 3; const bool first = (br == 0);
        const bf16_t* G = (const bf16_t*)(ws + (br == 0 ? WS_G0 : (br == 1 ? WS_G1 : WS_G2))); bf16_t* mg = (bf16_t*)(ws + WS_MERGED);
        const int row0 = pm * BM + wr * 64 + fr; const int col0 = pn * 256 + wc * 32 + 8 * fq;
#pragma unroll
        for (int ai = 0; ai < 2; ++ai) {
            u32x4 gv[4][2], pv[4][2];
#pragma unroll
            for (int m = 0; m < 4; ++m)
#pragma unroll
                for (int bj = 0; bj < 2; ++bj) { const size_t o = (size_t)(row0 + ai * HALF + m * 16) * 1024 + col0 + bj * HALF;
                    gv[m][bj] = *(const u32x4*)(G + o); pv[m][bj] = first ? (u32x4){0u, 0u, 0u, 0u} : *(const u32x4*)(mg + o); }
            __builtin_amdgcn_sched_barrier(0);
#pragma unroll
            for (int m = 0; m < 4; ++m)
#pragma unroll
                for (int bj = 0; bj < 2; ++bj) { const size_t ro = (size_t)(row0 + ai * HALF + m * 16) * 1024 + col0 + bj * HALF;
                    const f32x4 v0 = acc[ai][bj][m][0], v1 = acc[ai][bj][m][1]; const u32x4 g = gv[m][bj], p = pv[m][bj];
                    u32x4 w;
                    w.x = cvt_pk_bf16(bflo(p.x) + bflo(g.x) * v0[0], bfhi(p.x) + bfhi(g.x) * v0[1]); w.y = cvt_pk_bf16(bflo(p.y) + bflo(g.y) * v0[2], bfhi(p.y) + bfhi(g.y) * v0[3]);
                    w.z = cvt_pk_bf16(bflo(p.z) + bflo(g.z) * v1[0], bfhi(p.z) + bfhi(g.z) * v1[1]); w.w = cvt_pk_bf16(bflo(p.w) + bflo(g.w) * v1[2], bfhi(p.w) + bfhi(g.w) * v1[3]);
                    *(u32x4*)(mg + ro) = w; }
            __builtin_amdgcn_sched_barrier(0);
        }
    }
};
struct EpiOut {
    static constexpr bool PERM = false, AFTER_DRAIN = false;
    const float* xin; float* out;
    __device__ __forceinline__ void operator()(const f32x4 (&acc)[2][2][4][2], const Unit& u, int wr, int wc, int fr, int fq) const {
        const int row0 = u.pm * BM + wr * 64 + fr; const int col0 = u.pn * 256 + wc * 32 + 4 * fq;
#pragma unroll
        for (int ai = 0; ai < 2; ++ai) {
            f32x4 xv[4][2][2];
#pragma unroll
            for (int m = 0; m < 4; ++m)
#pragma unroll
                for (int bj = 0; bj < 2; ++bj)
#pragma unroll
                    for (int n = 0; n < 2; ++n) xv[m][bj][n] = *(const f32x4*)(xin + (size_t)(row0 + ai * HALF + m * 16) * 1024 + col0 + bj * HALF + n * 16);
            __builtin_amdgcn_sched_barrier(0);
#pragma unroll
            for (int m = 0; m < 4; ++m)
#pragma unroll
                for (int bj = 0; bj < 2; ++bj)
#pragma unroll
                    for (int n = 0; n < 2; ++n) *(f32x4*)(out + (size_t)(row0 + ai * HALF + m * 16) * 1024 + col0 + bj * HALF + n * 16) = xv[m][bj][n] + acc[ai][bj][m][n];
            __builtin_amdgcn_sched_barrier(0);
        }
    }
};
template <class Epi, class Sched, bool ALIGN_EPI = false, bool SP2 = false>
__device__ __forceinline__ void gemm_phase(PG8_LAS unsigned char* lds, const Gemm g, const Sched& S, const Epi& E) {
    int tid_ = threadIdx.x; asm volatile("" : "+v"(tid_)); const int tid = tid_, wid = __builtin_amdgcn_readfirstlane(tid >> 6), lane = tid & 63, wr = wid >> 2, wc = wid & 3, fr = lane & 15, fq = lane >> 4;
    const int K = g.K, nt = K / BK;
    unsigned voffA[2], voffB[2];
#pragma unroll
    for (int i = 0; i < 2; ++i) { int R, C; stage_rc(tid * 16 + i * 8192, R, C); const int Rb = Epi::PERM ? ((R & ~31) + perm32(R & 31)) : R;
        voffA[i] = (unsigned)(R * K + C) * 2u; voffB[i] = (unsigned)(Rb * K + C) * 2u; }
    const size_t kstep = (size_t)(BK * 2);
    const size_t hstep = (size_t)HALF * K * 2;
    const size_t tstep = 2 * hstep;
    const unsigned ldsw = (unsigned)wid * 1024u;
    const int aoff = lds_byte(wr * 64 + fr, fq * 8), boff = lds_byte(wc * 32 + fr, fq * 8);
#define PG8_SA(b, h) (((b) * 2 + (h)) * HTB)
#define PG8_SB(b, h) ((4 + (b) * 2 + (h)) * HTB)
#define PG8_STAGE(bufoff, gbase, voff) do { _Pragma("unroll") for (int _i = 0; _i < 2; ++_i) \
        __builtin_amdgcn_global_load_lds((const unsigned*)((const char*)(gbase) + (voff)[_i]), (PG8_LAS unsigned*)(lds + (bufoff) + ldsw + _i * 8192), 16, 0, 0); } while (0)
#define PG8_LDA(dst, b, h) do { _Pragma("unroll") for (int m = 0; m < 4; ++m) _Pragma("unroll") for (int k = 0; k < 2; ++k) dst[m][k] = *(const PG8_LAS bf16x8*)(lds + PG8_SA(b, h) + aoff + m * 2048 + k * 1024); } while (0)
#define PG8_LDB(dst, b, h) do { _Pragma("unroll") for (int n = 0; n < 2; ++n) _Pragma("unroll") for (int k = 0; k < 2; ++k) dst[n][k] = *(const PG8_LAS bf16x8*)(lds + PG8_SB(b, h) + boff + n * 2048 + k * 1024); } while (0)
#define PG8_MMA(ai, bj, At, Bt) do { __builtin_amdgcn_s_setprio(1); _Pragma("unroll") for (int m = 0; m < 4; ++m) _Pragma("unroll") for (int n = 0; n < 2; ++n) _Pragma("unroll") for (int k = 0; k < 2; ++k) \
        acc[ai][bj][m][n] = __builtin_amdgcn_mfma_f32_16x16x32_bf16(Bt[n][k], At[m][k], acc[ai][bj][m][n], 0, 0, 0); __builtin_amdgcn_s_setprio(0); } while (0)
#define PG8_WAIT_V(n) asm volatile("s_waitcnt vmcnt(" #n ")" ::: "memory")
#define PG8_WAIT_L(n) asm volatile("s_waitcnt lgkmcnt(" #n ")" ::: "memory")
#define PG8_BAR __builtin_amdgcn_s_barrier()
#define PG8_SCHED __builtin_amdgcn_sched_barrier(0)
    Unit cur, nxt; int ui = 0;
    if (!S.next(0, cur)) return;
    f32x4 acc[2][2][4][2];
#pragma unroll
    for (int a = 0; a < 2; ++a)
#pragma unroll
        for (int b = 0; b < 2; ++b)
#pragma unroll
            for (int m = 0; m < 4; ++m)
#pragma unroll
                for (int n = 0; n < 2; ++n) acc[a][b][m][n] = (f32x4){0.f, 0.f, 0.f, 0.f};
    bf16x8 At[4][2], B0[2][2], B1[2][2];
    const char* cA = (const char*)g.A + (size_t)cur.pm * tstep; const char* cB = (const char*)g.Bt + (size_t)cur.pn * tstep;
    S.a_ready(cur);
    if constexpr (SP2) {
        PG8_STAGE(PG8_SB(0, 0), cB, voffB); PG8_STAGE(PG8_SB(0, 1), cB + hstep, voffB); PG8_STAGE(PG8_SA(0, 0), cA, voffA); PG8_STAGE(PG8_SA(0, 1), cA + hstep, voffA);
        if (wr == 1) PG8_BAR;
        PG8_WAIT_V(2); PG8_BAR;
        PG8_STAGE(PG8_SB(1, 0), cB + kstep, voffB); PG8_STAGE(PG8_SA(1, 0), cA + kstep, voffA); PG8_STAGE(PG8_SB(1, 1), cB + hstep + kstep, voffB);
        PG8_WAIT_V(6); PG8_BAR;
    } else {
        PG8_STAGE(PG8_SB(0, 0), cB, voffB); PG8_STAGE(PG8_SA(0, 0), cA, voffA); PG8_STAGE(PG8_SB(0, 1), cB + hstep, voffB); PG8_STAGE(PG8_SA(0, 1), cA + hstep, voffA);
        if (wr == 1) PG8_BAR;
        PG8_WAIT_V(4); PG8_BAR;
        PG8_STAGE(PG8_SB(1, 0), cB + kstep, voffB); PG8_STAGE(PG8_SA(1, 0), cA + kstep, voffA); PG8_STAGE(PG8_SB(1, 1), cB + hstep + kstep, voffB);
        PG8_WAIT_V(6); PG8_BAR;
    }
    for (;;) {
        const bool has_next = S.next(ui + 1, nxt);
        const char* nA = has_next ? (const char*)g.A + (size_t)nxt.pm * tstep : cA; const char* nB = has_next ? (const char*)g.Bt + (size_t)nxt.pn * tstep : cB;
        for (int t = 0; t < nt; t += 2) {
            const bool last = (t == nt - 2);
            const char* a1 = cA + (size_t)(t + 1) * kstep;
            const char* a2 = last ? nA : cA + (size_t)(t + 2) * kstep; const char* b2 = last ? nB : cB + (size_t)(t + 2) * kstep;
            const char* a3 = a2 + kstep; const char* b3 = b2 + kstep;
            if (last && has_next) S.a_ready(nxt);
            if constexpr (SP2) {
            PG8_LDB(B0, 0, 0); PG8_LDB(B1, 0, 1); PG8_SCHED; PG8_LDA(At, 0, 0); PG8_STAGE(PG8_SA(1, 1), a1 + hstep, voffA);
            PG8_WAIT_V(8); PG8_WAIT_L(0); PG8_BAR; PG8_MMA(0, 0, At, B0); PG8_MMA(0, 1, At, B1); PG8_BAR; PG8_SCHED;
            PG8_LDA(At, 0, 1); PG8_STAGE(PG8_SB(0, 0), b2, voffB); PG8_STAGE(PG8_SB(0, 1), b2 + hstep, voffB); PG8_STAGE(PG8_SA(0, 0), a2, voffA);
            PG8_WAIT_V(8); PG8_WAIT_L(0); PG8_BAR; PG8_MMA(1, 0, At, B0); PG8_MMA(1, 1, At, B1); PG8_BAR; PG8_SCHED;
            PG8_LDB(B0, 1, 0); PG8_LDB(B1, 1, 1); PG8_SCHED; PG8_LDA(At, 1, 0); PG8_STAGE(PG8_SA(0, 1), a2 + hstep, voffA);
            PG8_WAIT_V(8); PG8_WAIT_L(0); PG8_BAR; PG8_MMA(0, 0, At, B0); PG8_MMA(0, 1, At, B1); PG8_BAR; PG8_SCHED;
            PG8_LDA(At, 1, 1); PG8_STAGE(PG8_SB(1, 0), b3, voffB); PG8_STAGE(PG8_SB(1, 1), b3 + hstep, voffB); PG8_STAGE(PG8_SA(1, 0), a3, voffA);
            PG8_WAIT_V(8); PG8_WAIT_L(0); PG8_BAR; PG8_MMA(1, 0, At, B0); PG8_MMA(1, 1, At, B1); PG8_BAR; PG8_SCHED;
            } else {
            PG8_LDB(B0, 0, 0); PG8_SCHED; PG8_LDA(At, 0, 0); PG8_STAGE(PG8_SA(1, 1), a1 + hstep, voffA);
            PG8_WAIT_L(8); PG8_BAR; PG8_WAIT_L(0); PG8_MMA(0, 0, At, B0); PG8_BAR; PG8_SCHED;
            PG8_LDB(B1, 0, 1); PG8_STAGE(PG8_SB(0, 0), b2, voffB);
            PG8_BAR; PG8_WAIT_L(0); PG8_MMA(0, 1, At, B1); PG8_BAR;
            PG8_LDA(At, 0, 1); PG8_STAGE(PG8_SA(0, 0), a2, voffA);
            PG8_BAR; PG8_WAIT_L(0); PG8_MMA(1, 0, At, B0); PG8_BAR; PG8_SCHED;
            PG8_STAGE(PG8_SB(0, 1), b2 + hstep, voffB);
            PG8_WAIT_V(6); PG8_BAR; PG8_MMA(1, 1, At, B1); PG8_BAR;
            PG8_LDB(B0, 1, 0); PG8_SCHED; PG8_LDA(At, 1, 0); PG8_STAGE(PG8_SA(0, 1), a2 + hstep, voffA);
            PG8_WAIT_L(8); PG8_BAR; PG8_WAIT_L(0); PG8_MMA(0, 0, At, B0); PG8_BAR; PG8_SCHED;
            PG8_LDB(B1, 1, 1); PG8_STAGE(PG8_SB(1, 0), b3, voffB);
            PG8_BAR; PG8_WAIT_L(0); PG8_MMA(0, 1, At, B1); PG8_BAR;
            PG8_LDA(At, 1, 1); PG8_STAGE(PG8_SA(1, 0), a3, voffA);
            PG8_BAR; PG8_WAIT_L(0); PG8_MMA(1, 0, At, B0); PG8_BAR; PG8_SCHED;
            PG8_STAGE(PG8_SB(1, 1), b3 + hstep, voffB);
            PG8_WAIT_V(6); PG8_BAR; PG8_MMA(1, 1, At, B1); PG8_BAR;
            }
        }
        if constexpr (ALIGN_EPI) { if (wr == 0) PG8_BAR; }
        if constexpr (!Epi::AFTER_DRAIN) { E(acc, cur, wr, wc, fr, fq); S.done(cur); }
        if (!has_next) break;
#pragma unroll
        for (int a = 0; a < 2; ++a)
#pragma unroll
            for (int b = 0; b < 2; ++b)
#pragma unroll
                for (int m = 0; m < 4; ++m)
#pragma unroll
                    for (int n = 0; n < 2; ++n) acc[a][b][m][n] = (f32x4){0.f, 0.f, 0.f, 0.f};
        cur = nxt; cA = nA; cB = nB; ++ui;
        if constexpr (ALIGN_EPI) { if (wr == 1) PG8_BAR; }
    }
    PG8_WAIT_V(0);
    if constexpr (!ALIGN_EPI) { if (wr == 0) PG8_BAR; }
    PG8_BAR;
    if constexpr (Epi::AFTER_DRAIN) { E.fused(acc, cur, wr, wc, fr, fq, lds, wid, lane); S.done(cur); }
#undef PG8_SA
#undef PG8_SB
#undef PG8_STAGE
#undef PG8_LDA
#undef PG8_LDB
#undef PG8_MMA
#undef PG8_WAIT_V
#undef PG8_WAIT_L
#undef PG8_BAR
#undef PG8_SCHED
}
}

#define DI __device__ __forceinline__
typedef unsigned short bf16_t;
typedef short bf16x8 __attribute__((ext_vector_type(8)));
typedef short bf16x4 __attribute__((ext_vector_type(4)));
typedef float f32x4 __attribute__((ext_vector_type(4)));
typedef unsigned u32x4 __attribute__((ext_vector_type(4)));
typedef unsigned u32x2 __attribute__((ext_vector_type(2)));
constexpr int NTHR = 512, NWAVE = 8;
constexpr int LDS_BYTES = 155648;
constexpr int LDS_SLOT = 155648 - 64;

DI float bf2f(bf16_t v) { return __uint_as_float(((unsigned)v) << 16); }
typedef float f32x2v __attribute__((ext_vector_type(2)));
typedef __bf16 bf16x2v __attribute__((ext_vector_type(2)));
DI unsigned f2bf(float f) { return (unsigned)__builtin_bit_cast(unsigned short, (__bf16)f); }
DI unsigned pk2(float lo, float hi) { const f32x2v v = {lo, hi}; return __builtin_bit_cast(unsigned, __builtin_convertvector(v, bf16x2v)); }
DI float lo_f(unsigned w) { return __uint_as_float(w << 16); }
DI float hi_f(unsigned w) { return __uint_as_float(w & 0xffff0000u); }
DI float siluf(float x) { return x * __builtin_amdgcn_rcpf(1.0f + __expf(-x)); }
DI float sigmf(float x) { return __builtin_amdgcn_rcpf(1.0f + __expf(-x)); }
#define DPPF(v, ctrl) __builtin_bit_cast(float, __builtin_amdgcn_update_dpp(0, __builtin_bit_cast(int, (v)), (ctrl), 0xf, 0xf, true))
#define DPPI(v, ctrl) __builtin_amdgcn_update_dpp(0, (v), (ctrl), 0xf, 0xf, true)
DI float row16_sum(float v) {
    v += DPPF(v, 0xB1); v += DPPF(v, 0x4E); v += DPPF(v, 0x141); v += DPPF(v, 0x140);
    return v;
}
DI int row16_sumi(int v) {
    v += DPPI(v, 0xB1); v += DPPI(v, 0x4E); v += DPPI(v, 0x141); v += DPPI(v, 0x140);
    return v;
}
DI float wave_sum(float v) {
    v = row16_sum(v);
    v += __builtin_bit_cast(float, __builtin_amdgcn_update_dpp(0, __builtin_bit_cast(int, v), 0x142, 0xa, 0xf, false));
    v += __builtin_bit_cast(float, __builtin_amdgcn_update_dpp(0, __builtin_bit_cast(int, v), 0x143, 0xc, 0xf, false));
    return __builtin_bit_cast(float, __builtin_amdgcn_readlane(__builtin_bit_cast(int, v), 63));
}
DI f32x4 mfma16(bf16x8 a, bf16x8 b, f32x4 c) { return __builtin_amdgcn_mfma_f32_16x16x32_bf16(a, b, c, 0, 0, 0); }
DI bf16x8 ld16(const unsigned char* p) { return *(const bf16x8*)p; }
DI bf16x8 ld8x2(const unsigned char* p0, const unsigned char* p1) {
    const bf16x4 a = *(const bf16x4*)p0, b = *(const bf16x4*)p1;
    return __builtin_shufflevector(a, b, 0, 1, 2, 3, 4, 5, 6, 7);
}
DI bf16x8 packf(const f32x4 a, const f32x4 b) {
    u32x4 w; w.x = pk2(a[0], a[1]); w.y = pk2(a[2], a[3]); w.z = pk2(b[0], b[1]); w.w = pk2(b[2], b[3]);
    return __builtin_bit_cast(bf16x8, w);
}
DI u32x2 pack4(const f32x4 a) { u32x2 w; w.x = pk2(a[0], a[1]); w.y = pk2(a[2], a[3]); return w; }

#define LAS __attribute__((address_space(3)))
#define XB_TMO      128
#define XB_XCNT(j)  (256  + 64 * (j))
#define XB_XSUB(j)  (1280 + 64 * (j))
#define XB_XGEN(j)  (2304 + 64 * (j))
#define XB_TOP      3328
#define XB_TOPGEN   3392
#define XCD_BAR_WORDS 3456
#define XB_SPIN_CAP (1u << 18)

__device__ __forceinline__ unsigned xb_ld(unsigned* p)              { return __hip_atomic_load(p, __ATOMIC_RELAXED, __HIP_MEMORY_SCOPE_AGENT); }
__device__ __forceinline__ unsigned xb_add(unsigned* p, unsigned v) { return __hip_atomic_fetch_add(p, v, __ATOMIC_RELAXED, __HIP_MEMORY_SCOPE_AGENT); }
__device__ __forceinline__ unsigned xb_xcc_id() { return (unsigned)__builtin_amdgcn_s_getreg((3 << 11) | 20) & 0xFu; }
#define XB_SPIN(cond, bar) do { unsigned _sp = 0; while (cond) { __builtin_amdgcn_s_sleep(1); \
    if ((++_sp & 255u) == 0u) { if (xb_ld(&(bar)[XB_TMO])) break; if (_sp > XB_SPIN_CAP) { atomicAdd(&(bar)[XB_TMO], 1u); break; } } } } while (0)

struct XcdBarrier {
    unsigned* bar; unsigned x;
    volatile LAS unsigned* st;
};

__device__ __forceinline__ XcdBarrier xcd_barrier_post(unsigned* bar, volatile LAS unsigned* st) {
    XcdBarrier b; b.bar = bar; b.x = xb_xcc_id(); b.st = st;
    if (threadIdx.x == 0) (void)xb_add(&bar[XB_XCNT(b.x)], 1u);
    return b;
}
__device__ __forceinline__ void xcd_barrier_complete(unsigned* bar, unsigned x, unsigned& nloc, unsigned& nx) {
    const unsigned G = gridDim.x * gridDim.y * gridDim.z;
    unsigned sum, cnt, mine, sp = 0u;
    for (;;) {
        sum = 0u; cnt = 0u; mine = 0u;
#pragma unroll
        for (unsigned j = 0; j < 16; ++j) { const unsigned c = xb_ld(&bar[XB_XCNT(j)]); sum += c; cnt += (c > 0u) ? 1u : 0u; mine = (j == x) ? c : mine; }
        if (sum == G) break;
        __builtin_amdgcn_s_sleep(1);
        if ((++sp & 255u) == 0u) { if (xb_ld(&bar[XB_TMO])) break; if (sp > XB_SPIN_CAP) { atomicAdd(&bar[XB_TMO], 1u); break; } }
    }
    nloc = mine > 0u ? mine : 1u; nx = cnt > 0u ? cnt : 1u;
}

__device__ __forceinline__ void xcd_barrier(const XcdBarrier& b) {
    asm volatile("s_waitcnt vmcnt(0)" ::: "memory");
    __syncthreads();
    if (threadIdx.x == 0) {
        unsigned* bar = b.bar;
        __builtin_amdgcn_s_waitcnt(0);
        unsigned nloc = b.st[0], nx = b.st[1];
        if (nloc == 0u) { xcd_barrier_complete(bar, b.x, nloc, nx); b.st[0] = nloc; b.st[1] = nx; }
        const unsigned old = xb_add(&bar[XB_XSUB(b.x)], 1u);
        const unsigned gen = old / nloc;
        if (old + 1u == (gen + 1u) * nloc) {
            __builtin_amdgcn_fence(__ATOMIC_RELEASE, "agent");
            asm volatile("s_waitcnt vmcnt(0)" ::: "memory");
            const unsigned og = xb_add(&bar[XB_TOP], 1u);
            const unsigned tg = og / nx;
            if (og + 1u == (tg + 1u) * nx) xb_add(&bar[XB_TOPGEN], 1u);
            else XB_SPIN(xb_ld(&bar[XB_TOPGEN]) == tg, bar);
            __builtin_amdgcn_fence(__ATOMIC_ACQUIRE, "agent");
            xb_add(&bar[XB_XGEN(b.x)], 1u);
            asm volatile("s_waitcnt vmcnt(0)" ::: "memory");
        } else {
            XB_SPIN(xb_ld(&bar[XB_XGEN(b.x)]) == gen, bar);
            __builtin_amdgcn_fence(__ATOMIC_ACQUIRE, "agent");
            asm volatile("s_waitcnt vmcnt(0)" ::: "memory");
        }
    }
    __syncthreads();
}

__constant__ float INV_A[64] = {1.000000000e+00f, 8.659643531e-01f, 7.498942614e-01f, 6.493816376e-01f, 5.623413324e-01f, 4.869675338e-01f, 4.216965139e-01f, 3.651741147e-01f, 3.162277639e-01f, 2.738419771e-01f, 2.371373773e-01f, 2.053525001e-01f, 1.778279394e-01f, 1.539926529e-01f, 1.333521307e-01f, 1.154782027e-01f, 1.000000015e-01f, 8.659642935e-02f, 7.498941571e-02f, 6.493816525e-02f, 5.623413250e-02f, 4.869675264e-02f, 4.216965288e-02f, 3.651741147e-02f, 3.162277490e-02f, 2.738419734e-02f, 2.371373773e-02f, 2.053525113e-02f, 1.778279431e-02f, 1.539926510e-02f, 1.333521493e-02f, 1.154782064e-02f, 9.999999776e-03f, 8.659643121e-03f, 7.498941850e-03f, 6.493816152e-03f, 5.623413250e-03f, 4.869675264e-03f, 4.216964822e-03f, 3.651741194e-03f, 3.162277630e-03f, 2.738419687e-03f, 2.371373586e-03f, 2.053524833e-03f, 1.778279431e-03f, 1.539926510e-03f, 1.333521446e-03f, 1.154781901e-03f, 1.000000047e-03f, 8.659643354e-04f, 7.498942432e-04f, 6.493816618e-04f, 5.623413017e-04f, 4.869675322e-04f, 4.216965172e-04f, 3.651741426e-04f, 3.162277571e-04f, 2.738419571e-04f, 2.371373703e-04f, 2.053525095e-04f, 1.778279402e-04f, 1.539926452e-04f, 1.333521504e-04f, 1.154782003e-04f};
__constant__ float INV_I[32] = {1.000000000e+00f, 7.498942614e-01f, 5.623413324e-01f, 4.216965139e-01f, 3.162277639e-01f, 2.371373773e-01f, 1.778279394e-01f, 1.333521307e-01f, 1.000000015e-01f, 7.498941571e-02f, 5.623413250e-02f, 4.216965288e-02f, 3.162277490e-02f, 2.371373773e-02f, 1.778279431e-02f, 1.333521493e-02f, 9.999999776e-03f, 7.498941850e-03f, 5.623413250e-03f, 4.216964822e-03f, 3.162277630e-03f, 2.371373586e-03f, 1.778279431e-03f, 1.333521446e-03f, 1.000000047e-03f, 7.498942432e-04f, 5.623413017e-04f, 4.216965172e-04f, 3.162277571e-04f, 2.371373703e-04f, 1.778279402e-04f, 1.333521504e-04f};
struct Params {
    const float* x; const float* norm_g; const float* w_in; const float* gate_b; const float* conv_w; const float* a_log; const float* dt_bias;
    const float* dn_onorm; const float* pool_w; const float* pool_scale; const float* q_norm; const float* k_norm; const float* w_branch; const float* w_out;
    float* out; unsigned char* ws;
    int ph_lo, ph_hi;
};

DI int next_unit(unsigned* ctr, unsigned char* lds) {
    volatile int* slot = (volatile int*)(lds + LDS_SLOT);
    __syncthreads();
    if (threadIdx.x == 0) *slot = (int)atomicAdd(ctr, 1u);
    __syncthreads();
    return *slot;
}

DI int src_col(int mode, int n) {
    if (mode == 0) {
        if (n < 2048) return n;
        if (n < 5440) return n + 8;
        if (n < 5444) return 2048 + (n - 5440);
        if (n < 5448) return 2052 + (n - 5444);
        if (n < 5452) return n;
        return -1;
    }
    if (mode == 1) return 5452 + n;
    return n;
}
DI void transpose_item(const float* W, int ldw, int K, bf16_t* WT, int mode, float* scr, int item, int nblk, int lane) {
    const int kb = item / nblk, nb = item % nblk, k0 = 64 * kb, n0 = 32 * nb;
    const int sc = src_col(mode, n0 + (lane & 31));
    const int scc = sc < 0 ? 0 : sc;
    float tv[32];
#pragma unroll
    for (int i = 0; i < 32; ++i) { const int kk = 2 * i + (lane >> 5); tv[i] = W[(size_t)(k0 + kk) * ldw + scc]; }
    __builtin_amdgcn_sched_barrier(0);
#pragma unroll
    for (int i = 0; i < 32; ++i) { const int kk = 2 * i + (lane >> 5); scr[kk * 33 + (lane & 31)] = (sc >= 0) ? tv[i] : 0.f; }
    asm volatile("s_waitcnt lgkmcnt(0)" ::: "memory");
    const int c = lane & 7;
#pragma unroll
    for (int j = 0; j < 4; ++j) { const int n = (lane >> 3) + 8 * j; const float* s = scr + (8 * c) * 33 + n;
        u32x4 o; o.x = pk2(s[0 * 33], s[1 * 33]); o.y = pk2(s[2 * 33], s[3 * 33]); o.z = pk2(s[4 * 33], s[5 * 33]); o.w = pk2(s[6 * 33], s[7 * 33]);
        *(u32x4*)(WT + (size_t)(n0 + n) * K + k0 + 8 * c) = o; }
    asm volatile("s_waitcnt lgkmcnt(0)" ::: "memory");
}
DI void rms_row(const float* xrow, const float* g, bf16_t* orow, int lane) {
    const f32x4* xr = (const f32x4*)xrow + lane; const f32x4* gr = (const f32x4*)g + lane;
    f32x4 v[4]; float s = 0.f;
#pragma unroll
    for (int j = 0; j < 4; ++j) { v[j] = xr[64 * j]; s += (v[j].x * v[j].x + v[j].y * v[j].y) + (v[j].z * v[j].z + v[j].w * v[j].w); }
    const float rstd = 1.0f / sqrtf(wave_sum(s) * (1.0f / DM) + NORM_EPS);
    u32x2* o8 = (u32x2*)orow + lane;
#pragma unroll
    for (int j = 0; j < 4; ++j) { const f32x4 gg = gr[64 * j]; u32x2 w; w.x = pk2(v[j].x * rstd * gg.x, v[j].y * rstd * gg.y); w.y = pk2(v[j].z * rstd * gg.z, v[j].w * rstd * gg.w); o8[64 * j] = w; }
}
DI void rms_row2(const float* xrow, const float* g, bf16_t* orow, int lane) {
    const f32x4* xr = (const f32x4*)xrow + lane; const f32x4* gr = (const f32x4*)g + lane;
    f32x4 v[2][4], gg[4];
#pragma unroll
    for (int r = 0; r < 2; ++r)
#pragma unroll
        for (int j = 0; j < 4; ++j) v[r][j] = xr[r * (DM / 4) + 64 * j];
#pragma unroll
    for (int j = 0; j < 4; ++j) gg[j] = gr[64 * j];
    __builtin_amdgcn_sched_barrier(0);
    float s[2];
#pragma unroll
    for (int r = 0; r < 2; ++r) { s[r] = 0.f;
#pragma unroll
        for (int j = 0; j < 4; ++j) s[r] += (v[r][j].x * v[r][j].x + v[r][j].y * v[r][j].y) + (v[r][j].z * v[r][j].z + v[r][j].w * v[r][j].w); }
#pragma unroll
    for (int r = 0; r < 2; ++r) s[r] = wave_sum(s[r]);
#pragma unroll
    for (int r = 0; r < 2; ++r) { const float rstd = __builtin_amdgcn_rsqf(s[r] * (1.0f / DM) + NORM_EPS);
        u32x2* o8 = (u32x2*)(orow + r * DM) + lane;
#pragma unroll
        for (int j = 0; j < 4; ++j) { u32x2 w; w.x = pk2(v[r][j].x * rstd * gg[j].x, v[r][j].y * rstd * gg[j].y); w.y = pk2(v[r][j].z * rstd * gg[j].z, v[r][j].w * rstd * gg[j].w); o8[64 * j] = w; } }
}
DI void phase0(const Params& p, int layer, const float* xin, unsigned char* lds) {
    int tid_ = threadIdx.x; asm volatile("" : "+v"(tid_)); const int tid = tid_, lane = tid & 63, wave = tid >> 6;
    const int gw = blockIdx.x * NWAVE + wave, NGW = gridDim.x * NWAVE;
    float* scr = (float*)(lds + wave * 8704);
    unsigned char* ws = p.ws;
    const float* win = p.w_in + (size_t)layer * DM * INW;
    const float* wbr = p.w_branch + (size_t)layer * 3 * 512 * 1024;
    const float* wo = p.w_out + (size_t)layer * 1024 * 1024;
    const float* pw = p.pool_w + (size_t)layer * 4 * 128 * 128;
    constexpr int I_1 = 16 * (N1 / 32), I_G = 16 * (NG / 32), I_B = 8 * 32, I_O = 16 * 32, I_P = 2 * 4;
    constexpr int NITEMS = I_1 + I_G + 3 * I_B + I_O + 4 * I_P;
    for (int it = gw; it < NITEMS; it += NGW) {
        int r = it;
        if (r < I_1) { transpose_item(win, INW, 1024, (bf16_t*)(ws + WS_WIN1), 0, scr, r, N1 / 32, lane); continue; } r -= I_1;
        if (r < I_G) { transpose_item(win, INW, 1024, (bf16_t*)(ws + WS_WG), 1, scr, r, NG / 32, lane); continue; } r -= I_G;
        if (r < 3 * I_B) { const int br = r / I_B; transpose_item(wbr + (size_t)br * 512 * 1024, 1024, 512, (bf16_t*)(ws + WS_WBR) + (size_t)br * 1024 * 512, 2, scr, r % I_B, 32, lane); continue; } r -= 3 * I_B;
        if (r < I_O) { transpose_item(wo, 1024, 1024, (bf16_t*)(ws + WS_WO), 2, scr, r, 32, lane); continue; } r -= I_O;
        { const int g = r / I_P; transpose_item(pw + (size_t)g * 128 * 128, 128, 128, (bf16_t*)(ws + WS_POOLW) + (size_t)g * 128 * 128, 2, scr, r % I_P, 4, lane); }
    }
    const float* ng = p.norm_g + layer * DM;
    for (int m = 2 * gw; m < MTOK; m += 2 * NGW) rms_row2(xin + (size_t)m * DM, ng, (bf16_t*)(ws + WS_H) + (size_t)m * DM, lane);
    if (layer == 0) {
        const int gt = blockIdx.x * NTHR + tid, NGT = gridDim.x * NTHR;
        for (int i = gt; i < SEQ * 96; i += NGT) {
            const int t = i / 96, j = i % 96;
            const float inv = (j < 64) ? INV_A[j] : INV_I[j - 64];
            const float ang = (float)t * inv;
            double rev = (double)ang * 0.15915494309189535; rev -= floor(rev);
            const float rf = (float)rev;
            const float c = __builtin_amdgcn_cosf(rf), s = __builtin_amdgcn_sinf(rf);
            if (j < 64) { ((float*)(ws + WS_COSA))[t * 64 + j] = c; ((float*)(ws + WS_SINA))[t * 64 + j] = s; }
            else { ((float*)(ws + WS_COSI))[t * 32 + (j - 64)] = c; ((float*)(ws + WS_SINI))[t * 32 + (j - 64)] = s; }
        }
    }
}

constexpr int DP_Q = 0, DP_K = 17408, DP_KBT = 34816, DP_VT = 53248, DP_KDT = 71680, DP_L = 90112, DP_TF = 106752, DP_T = 123392, DP_GC = 132608, DP_BETA = 132864, DP_P = 133120;
constexpr int QP = 272;
constexpr int TP = 144;
DI void dn_prep_unit(const Params& p, int layer, int unit, unsigned char* lds) {
    int tid_ = threadIdx.x; asm volatile("" : "+v"(tid_)); const int tid = tid_, lane = tid & 63, wave = tid >> 6, fr = lane & 15, fq = lane >> 4;
    const int c = unit & 31, h = (unit >> 5) & 3, b = unit >> 7;
    unsigned char* ws = p.ws;
    const size_t tok0 = (size_t)b * SEQ + (size_t)c * 64;
    float* sGc = (float*)(lds + DP_GC); float* sBeta = (float*)(lds + DP_BETA);
    float* sL = (float*)(lds + DP_L); float* sTf = (float*)(lds + DP_TF);
    unsigned char* su = ws + WS_SCAN + (size_t)unit * SCAN_UNIT_BYTES;
    const bf16_t* aq = (const bf16_t*)(ws + WS_AQKV);
    const float* cw = p.conv_w + (size_t)layer * 4 * 1536;
    const int tl0 = 8 * wave;
        float raA[3][11], rbA[3][11], w0A[3][4], w1A[3][4];
#pragma unroll
        for (int part = 0; part < 3; ++part) {
            const int ch0 = part * 512 + h * 128 + lane, ch1 = ch0 + 64;
#pragma unroll
            for (int j = 0; j < 4; ++j) { w0A[part][j] = cw[j * 1536 + ch0]; w1A[part][j] = cw[j * 1536 + ch1]; }
#pragma unroll
            for (int j = 0; j < 11; ++j) { const int tg = c * 64 + tl0 - 3 + j;
                const int tgc = tg < 0 ? 0 : tg; const bf16_t* rp = aq + ((size_t)b * SEQ + tgc) * 1536;
                const float va = bf2f(rp[ch0]), vb = bf2f(rp[ch1]); raA[part][j] = tg >= 0 ? va : 0.f; rbA[part][j] = tg >= 0 ? vb : 0.f; }
        }
    if (wave == 0) {
        const float* mp = (const float*)(ws + WS_MISC) + (tok0 + lane) * 16;
        const float ba = mp[h], aa = mp[4 + h];
        const float al = p.a_log[layer * 4 + h], dtb = p.dt_bias[layer * 4 + h];
        const float xx = aa + dtb;
        const float sp = fmaxf(xx, 0.f) + log1pf(__expf(-fabsf(xx)));
        float g = -__expf(al) * sp;
        float cs = g;
#pragma unroll
        for (int o = 1; o < 64; o <<= 1) { const float n = __shfl_up(cs, o); if (lane >= o) cs += n; }
        sGc[lane] = cs; sBeta[lane] = sigmf(ba);
    }
    __syncthreads();
    const float gl = sGc[63];
    {
        __builtin_amdgcn_sched_barrier(0);
#pragma unroll
        for (int part = 0; part < 3; ++part) {
            const float (&ra)[11] = raA[part]; const float (&rb)[11] = rbA[part]; const float (&w0)[4] = w0A[part]; const float (&w1)[4] = w1A[part];
            float yav[8], ybv[8];
#pragma unroll
            for (int i = 0; i < 8; ++i) {
                yav[i] = siluf(w0[0] * ra[i] + w0[1] * ra[i + 1] + w0[2] * ra[i + 2] + w0[3] * ra[i + 3]);
                ybv[i] = siluf(w1[0] * rb[i] + w1[1] * rb[i + 1] + w1[2] * rb[i + 2] + w1[3] * rb[i + 3]);
            }
            float rnv[8];
            if (part < 2) {
#pragma unroll
                for (int i = 0; i < 8; ++i) rnv[i] = yav[i] * yav[i] + ybv[i] * ybv[i];
#pragma unroll
                for (int i = 0; i < 8; ++i) rnv[i] = __builtin_amdgcn_rsqf(wave_sum(rnv[i]) + NORM_EPS);
            }
#pragma unroll
            for (int i = 0; i < 8; ++i) {
                const int tl = tl0 + i;
                float ya = yav[i], yb = ybv[i];
                const float beta = sBeta[tl], gct = sGc[tl];
                if (part < 2) {
                    const float rn = rnv[i];
                    ya *= rn; yb *= rn;
                    if (part == 0) {
                        *(bf16_t*)(lds + DP_Q + tl * QP + lane * 2) = (bf16_t)f2bf(ya); *(bf16_t*)(lds + DP_Q + tl * QP + (lane + 64) * 2) = (bf16_t)f2bf(yb);
                    } else {
                        *(bf16_t*)(lds + DP_K + tl * QP + lane * 2) = (bf16_t)f2bf(ya); *(bf16_t*)(lds + DP_K + tl * QP + (lane + 64) * 2) = (bf16_t)f2bf(yb);
                        const float s1 = beta * __expf(gct), s2 = __expf(gl - gct);
                        *(bf16_t*)(lds + DP_KBT + lane * TP + tl * 2) = (bf16_t)f2bf(ya * s1); *(bf16_t*)(lds + DP_KBT + (lane + 64) * TP + tl * 2) = (bf16_t)f2bf(yb * s1);
                        *(bf16_t*)(lds + DP_KDT + lane * TP + tl * 2) = (bf16_t)f2bf(ya * s2); *(bf16_t*)(lds + DP_KDT + (lane + 64) * TP + tl * 2) = (bf16_t)f2bf(yb * s2);
                    }
                } else {
                    *(bf16_t*)(lds + DP_VT + lane * TP + tl * 2) = (bf16_t)f2bf(ya * beta); *(bf16_t*)(lds + DP_VT + (lane + 64) * TP + tl * 2) = (bf16_t)f2bf(yb * beta);
                }
            }
        }
    }
    __syncthreads();
#pragma unroll 1
    for (int i4 = 0; i4 < 4; ++i4) {
        const int id = wave + 8 * i4;
        if (id < 16) {
            const int mt = id >> 2, nt = id & 3;
            f32x4 acc = {0.f, 0.f, 0.f, 0.f};
            if (nt <= mt) {
#pragma unroll
                for (int s = 0; s < 4; ++s) acc = mfma16(ld16(lds + DP_K + (16 * mt + fr) * QP + (32 * s + 8 * fq) * 2), ld16(lds + DP_K + (16 * nt + fr) * QP + (32 * s + 8 * fq) * 2), acc);
            }
            const int j = 16 * nt + fr; const float gj = sGc[j];
#pragma unroll
            for (int jj = 0; jj < 4; ++jj) { const int i = 16 * mt + 4 * fq + jj;
                float v = 0.f; if (j < i) v = sBeta[i] * acc[jj] * __expf(sGc[i] - gj);
                sL[i * 65 + j] = v; }
        } else {
            const int mt = (id - 16) >> 2, nt = (id - 16) & 3;
            f32x4 acc = {0.f, 0.f, 0.f, 0.f};
            if (nt <= mt) {
#pragma unroll
                for (int s = 0; s < 4; ++s) acc = mfma16(ld16(lds + DP_K + (16 * nt + fr) * QP + (32 * s + 8 * fq) * 2), ld16(lds + DP_Q + (16 * mt + fr) * QP + (32 * s + 8 * fq) * 2), acc);
            }
            const int i = 16 * mt + fr; const float gi = sGc[i];
            f32x4 o;
#pragma unroll
            for (int jj = 0; jj < 4; ++jj) { const int j = 16 * nt + 4 * fq + jj;
                float v = 0.f; if (j <= i) v = acc[jj] * 0.08838834764831845f * __expf(gi - sGc[j]);
                o[jj] = v; }
            *(u32x2*)(su + SU_A + (i * 64 + 16 * nt + 4 * fq) * 2) = pack4(o);
        }
    }
    __syncthreads();
    float* sP = (float*)(lds + DP_P);
    if (wave < 4) {
        const int o = 16 * wave;
        for (int e = lane; e < 16 * 64; e += 64) { const int i = e >> 6, cc = e & 63; if (cc >= o + 16) sTf[(o + i) * 65 + cc] = 0.f; }
        if (lane < 16) {
            float lv[120];
#pragma unroll
            for (int i = 1; i < 16; ++i)
#pragma unroll
                for (int j = 0; j < i; ++j) lv[i * (i - 1) / 2 + j] = sL[(o + i) * 65 + o + j];
            float tc[16];
#pragma unroll
            for (int i = 0; i < 16; ++i) {
                float acc = (i == lane) ? 1.f : 0.f;
#pragma unroll
                for (int j = 0; j < i; ++j) acc -= lv[i * (i - 1) / 2 + j] * tc[j];
                tc[i] = acc;
            }
#pragma unroll
            for (int i = 0; i < 16; ++i) sTf[(o + i) * 65 + o + lane] = tc[i];
        }
    } else {
        for (int ch = tid - 256; ch < 1024; ch += 256) {
            const int row = ch >> 4, c8 = (ch & 15) * 8;
            const u32x4 q = *(const u32x4*)(lds + DP_Q + row * QP + c8 * 2);
            const float sc = __expf(sGc[row]) * 0.08838834764831845f;
            u32x4 o; o.x = pk2(lo_f(q.x) * sc, hi_f(q.x) * sc); o.y = pk2(lo_f(q.y) * sc, hi_f(q.y) * sc); o.z = pk2(lo_f(q.z) * sc, hi_f(q.z) * sc); o.w = pk2(lo_f(q.w) * sc, hi_f(q.w) * sc);
            *(u32x4*)(su + SU_QG + (row * 128 + c8) * 2) = o;
        }
        for (int ch = tid - 256; ch < 1024; ch += 256) {
            const int row = ch >> 3, c8 = (ch & 7) * 8;
            *(u32x4*)(su + SU_KDT + (row * 64 + c8) * 2) = *(const u32x4*)(lds + DP_KDT + row * TP + c8 * 2);
        }
        if (tid == 256) ((float*)(ws + WS_DEC))[unit] = __expf(gl);
    }
    __syncthreads();
#pragma unroll 1
    for (int I = 1; I < 4; ++I) {
        for (int e = tid; e < I * 256; e += NTHR) { const int J = e >> 8, r = (e >> 4) & 15, cc = e & 15;
            float acc = 0.f;
            for (int K = J; K < I; ++K) {
#pragma unroll
                for (int k2 = 0; k2 < 16; ++k2) acc += sL[(16 * I + r) * 65 + 16 * K + k2] * sTf[(16 * K + k2) * 65 + 16 * J + cc];
            }
            sP[r * 65 + 16 * J + cc] = acc; }
        __syncthreads();
        for (int e = tid; e < I * 256; e += NTHR) { const int J = e >> 8, r = (e >> 4) & 15, cc = e & 15;
            float acc = 0.f;
#pragma unroll
            for (int kk = 0; kk < 16; ++kk) acc += sTf[(16 * I + r) * 65 + 16 * I + kk] * sP[kk * 65 + 16 * J + cc];
            sTf[(16 * I + r) * 65 + 16 * J + cc] = -acc; }
        __syncthreads();
    }
    for (int e = tid; e < 4096; e += NTHR) { const int i = e >> 6, j = e & 63; *(bf16_t*)(lds + DP_T + i * TP + j * 2) = (bf16_t)f2bf(sTf[i * 65 + j]); }
    __syncthreads();
#pragma unroll 1
    for (int i8 = 0; i8 < 8; ++i8) {
        const int id = wave + 8 * i8;
        if (id < 32) {
            const int mt = id >> 3, nt = id & 7;
            f32x4 acc = {0.f, 0.f, 0.f, 0.f};
#pragma unroll
            for (int s = 0; s < 2; ++s) acc = mfma16(ld16(lds + DP_T + (16 * mt + fr) * TP + (32 * s + 8 * fq) * 2), ld16(lds + DP_VT + (16 * nt + fr) * TP + (32 * s + 8 * fq) * 2), acc);
            *(u32x2*)(su + SU_UT + ((16 * nt + fr) * 64 + 16 * mt + 4 * fq) * 2) = pack4(acc);
        } else {
            const int mt = (id - 32) >> 3, nt = (id - 32) & 7;
            f32x4 acc = {0.f, 0.f, 0.f, 0.f};
#pragma unroll
            for (int s = 0; s < 2; ++s) acc = mfma16(ld16(lds + DP_KBT + (16 * nt + fr) * TP + (32 * s + 8 * fq) * 2), ld16(lds + DP_T + (16 * mt + fr) * TP + (32 * s + 8 * fq) * 2), acc);
            *(u32x2*)(su + SU_W + ((16 * mt + fr) * 128 + 16 * nt + 4 * fq) * 2) = pack4(acc);
        }
    }
}

constexpr int PL_U = 0, PL_P = 40960;
DI void pool_unit(const Params& p, int layer, int unit, unsigned char* lds) {
    int tid_ = threadIdx.x; asm volatile("" : "+v"(tid_)); const int tid = tid_, lane = tid & 63, wave = tid >> 6, fr = lane & 15, fq = lane >> 4;
    const int g = unit & 3, tt = (unit >> 2) & 31, b = unit >> 7;
    unsigned char* ws = p.ws;
    const int t0 = tt * 64, win = 2 << g;
    float* sU = (float*)(lds + PL_U);
    const bf16_t* bu = (const bf16_t*)(ws + WS_BU);
    const bf16_t* pw = (const bf16_t*)(ws + WS_POOLW) + (size_t)g * 128 * 128;
    const int mt = wave & 3, nh = wave >> 2;
    const float* psc = p.pool_scale + layer * 512 + g * 128;
    bf16_t* bz = (bf16_t*)(ws + WS_BZ);
    bf16x8 bw[4][4]; u32x2 zz[4]; f32x4 scv[4];
#pragma unroll
        for (int n4 = 0; n4 < 4; ++n4) { const int nt = nh * 4 + n4;
#pragma unroll
            for (int s = 0; s < 4; ++s) bw[n4][s] = *(const bf16x8*)(pw + (16 * nt + fr) * 128 + 32 * s + 8 * fq);
            const int d0 = 16 * nt + 4 * fq;
            zz[n4] = *(const u32x2*)(bz + ((size_t)b * SEQ + t0 + 16 * mt + fr) * 512 + g * 128 + d0); scv[n4] = *(const f32x4*)(psc + d0); }
    {
        float pv[20];
#pragma unroll
        for (int k = 0; k < 20; ++k) { const int e = tid + k * NTHR; const int r = e >> 7, cc = e & 127; const int t = t0 - 15 + r;
            const int tc = t < 0 ? 0 : (t > SEQ - 1 ? SEQ - 1 : t);
            const float v = bf2f(bu[((size_t)b * SEQ + tc) * 512 + g * 128 + cc]); pv[k] = (t >= 0) ? v : 0.f; }
        __builtin_amdgcn_sched_barrier(0);
#pragma unroll
        for (int k = 0; k < 20; ++k) { const int e = tid + k * NTHR; if (e < 79 * 128) sU[e] = pv[k]; }
    }
    __syncthreads();
    for (int e = tid; e < 64 * 128; e += NTHR) { const int tl = e >> 7, cc = e & 127; const int t = t0 + tl;
        const int cnt = (t + 1 < win) ? (t + 1) : win;
        float s = 0.f;
#pragma unroll
        for (int i = 0; i < 16; ++i) { const float v = sU[(tl + 15 - i) * 128 + cc]; s += (i < cnt) ? v : 0.f; }
        const float pv = s * __builtin_amdgcn_rcpf((float)cnt) - sU[(tl + 15) * 128 + cc];
        *(bf16_t*)(lds + PL_P + tl * QP + cc * 2) = (bf16_t)f2bf(pv); }
    __syncthreads();
    {
        __builtin_amdgcn_sched_barrier(0);
#pragma unroll
        for (int n4 = 0; n4 < 4; ++n4) {
            const int nt = nh * 4 + n4;
            f32x4 acc = {0.f, 0.f, 0.f, 0.f};
#pragma unroll
            for (int s = 0; s < 4; ++s) acc = mfma16(bw[n4][s], ld16(lds + PL_P + (16 * mt + fr) * QP + (32 * s + 8 * fq) * 2), acc);
            const int d0 = 16 * nt + 4 * fq; bf16_t* zp = bz + ((size_t)b * SEQ + t0 + 16 * mt + fr) * 512 + g * 128 + d0;
            f32x4 o; o[0] = acc[0] * scv[n4][0] * siluf(lo_f(zz[n4].x)); o[1] = acc[1] * scv[n4][1] * siluf(hi_f(zz[n4].x)); o[2] = acc[2] * scv[n4][2] * siluf(lo_f(zz[n4].y)); o[3] = acc[3] * scv[n4][3] * siluf(hi_f(zz[n4].y));
            *(u32x2*)zp = pack4(o);
        }
    }
}

DI void sa_prep_unit(const Params& p, int layer, int unit, unsigned char* lds) {
    int tid_ = threadIdx.x; asm volatile("" : "+v"(tid_)); const int tid = tid_, lane = tid & 63, wave = tid >> 6;
    unsigned char* ws = p.ws;
    bf16_t* cq = (bf16_t*)(ws + WS_CQKV);
    const float* cosA = (const float*)(ws + WS_COSA); const float* sinA = (const float*)(ws + WS_SINA);
    const float gq0 = p.q_norm[layer * 128 + lane], gq1 = p.q_norm[layer * 128 + lane + 64];
    const float gk0 = p.k_norm[layer * 128 + lane], gk1 = p.k_norm[layer * 128 + lane + 64];
#pragma unroll 1
    for (int i0 = 0; i0 < 64; i0 += 16) {
        float x1[16], x2[16], cs[16], sn[16]; bf16_t* rp[16];
#pragma unroll
        for (int k = 0; k < 16; ++k) {
            const int rid = wave * 64 + i0 + k;
            const int tl = rid >> 3, qk = (rid >> 2) & 1, hh = rid & 3;
            const size_t tok = (size_t)unit * 64 + tl; const int t = (int)(tok & (SEQ - 1));
            rp[k] = cq + tok * 1536 + qk * 512 + hh * 128;
            x1[k] = bf2f(rp[k][lane]); x2[k] = bf2f(rp[k][lane + 64]);
            cs[k] = cosA[t * 64 + lane]; sn[k] = sinA[t * 64 + lane];
        }
        __builtin_amdgcn_sched_barrier(0);
        float ss[16];
#pragma unroll
        for (int k = 0; k < 16; ++k) ss[k] = x1[k] * x1[k] + x2[k] * x2[k];
#pragma unroll
        for (int k = 0; k < 16; ++k) ss[k] = wave_sum(ss[k]);
#pragma unroll
        for (int k = 0; k < 16; ++k) {
            const int qk = ((i0 + k) >> 2) & 1;
            const float rstd = __builtin_amdgcn_rsqf(ss[k] * (1.0f / 128.0f) + NORM_EPS);
            const float y1 = x1[k] * rstd * (qk ? gk0 : gq0), y2 = x2[k] * rstd * (qk ? gk1 : gq1);
            rp[k][lane] = (bf16_t)f2bf(y1 * cs[k] - y2 * sn[k]); rp[k][lane + 64] = (bf16_t)f2bf(y2 * cs[k] + y1 * sn[k]);
        }
    }
}

constexpr int IX_K = 0;
DI unsigned sortable(float f) { const unsigned u = __float_as_uint(f + 0.0f); return u ^ ((u >> 31) ? 0xffffffffu : 0x80000000u); }
DI void indexer_unit(const Params& p, int unit, unsigned char* lds) {
    int tid_ = threadIdx.x; asm volatile("" : "+v"(tid_)); const int tid = tid_, lane = tid & 63, wave = tid >> 6, fr = lane & 15, fq = lane >> 4;
    const int b = unit & 7, qb = 63 - (unit >> 3);
    unsigned char* ws = p.ws;
    const int t0 = qb * 32, tw = t0 + 4 * wave;
    const int tq = tw + fq;
    unsigned* mask = (unsigned*)(ws + WS_MASK) + ((size_t)b * SEQ + tq) * 64;
    if (t0 < 256) {
#pragma unroll
        for (int k = 0; k < 4; ++k) { const int wd = 16 * k + fr; const int lo = 32 * wd;
            unsigned m = 0u; if (tq >= lo + 31) m = 0xffffffffu; else if (tq >= lo) m = (2u << (tq - lo)) - 1u;
            mask[wd] = m; }
        return;
    }
    const bf16_t* cidx = (const bf16_t*)(ws + WS_CIDX);
    const float* cosI = (const float*)(ws + WS_COSI); const float* sinI = (const float*)(ws + WS_SINI);
    bf16x8 a0, a1;
    {
        const int ql = fr >> 2, hh = fr & 3; const int t = tw + ql;
        const bf16_t* qp = cidx + ((size_t)b * SEQ + t) * 320 + hh * 64;
        const u32x4 x1 = *(const u32x4*)(qp + 8 * fq), x2 = *(const u32x4*)(qp + 32 + 8 * fq);
        const f32x4 c0 = *(const f32x4*)(cosI + t * 32 + 8 * fq), c1 = *(const f32x4*)(cosI + t * 32 + 8 * fq + 4);
        const f32x4 s0 = *(const f32x4*)(sinI + t * 32 + 8 * fq), s1 = *(const f32x4*)(sinI + t * 32 + 8 * fq + 4);
        const float xa[8] = {lo_f(x1.x), hi_f(x1.x), lo_f(x1.y), hi_f(x1.y), lo_f(x1.z), hi_f(x1.z), lo_f(x1.w), hi_f(x1.w)};
        const float xb[8] = {lo_f(x2.x), hi_f(x2.x), lo_f(x2.y), hi_f(x2.y), lo_f(x2.z), hi_f(x2.z), lo_f(x2.w), hi_f(x2.w)};
        const float cc[8] = {c0[0], c0[1], c0[2], c0[3], c1[0], c1[1], c1[2], c1[3]};
        const float sn[8] = {s0[0], s0[1], s0[2], s0[3], s1[0], s1[1], s1[2], s1[3]};
        u32x4 w0, w1;
        w0.x = pk2(xa[0] * cc[0] - xb[0] * sn[0], xa[1] * cc[1] - xb[1] * sn[1]); w0.y = pk2(xa[2] * cc[2] - xb[2] * sn[2], xa[3] * cc[3] - xb[3] * sn[3]);
        w0.z = pk2(xa[4] * cc[4] - xb[4] * sn[4], xa[5] * cc[5] - xb[5] * sn[5]); w0.w = pk2(xa[6] * cc[6] - xb[6] * sn[6], xa[7] * cc[7] - xb[7] * sn[7]);
        w1.x = pk2(xb[0] * cc[0] + xa[0] * sn[0], xb[1] * cc[1] + xa[1] * sn[1]); w1.y = pk2(xb[2] * cc[2] + xa[2] * sn[2], xb[3] * cc[3] + xa[3] * sn[3]);
        w1.z = pk2(xb[4] * cc[4] + xa[4] * sn[4], xb[5] * cc[5] + xa[5] * sn[5]); w1.w = pk2(xb[6] * cc[6] + xa[6] * sn[6], xb[7] * cc[7] + xa[7] * sn[7]);
        a0 = __builtin_bit_cast(bf16x8, w0); a1 = __builtin_bit_cast(bf16x8, w1);
    }
    float wi[4];
    { const float* mp = (const float*)(ws + WS_MISC) + ((size_t)b * SEQ + tq) * 16 + 8;
#pragma unroll
      for (int j = 0; j < 4; ++j) wi[j] = mp[j] * 0.0625f; }
    unsigned sc[128];
    const int tmax = t0 + 31;
    const int skey = tid >> 1, hf = tid & 1;
    u32x4 xa0, xa1, xb0, xb1; f32x4 cv[4], sv[4];
#define IDX_LOAD(r) do { const int t_ = (r) * 256 + skey; const bf16_t* kp_ = cidx + ((size_t)b * SEQ + t_) * 320 + 256; \
        xa0 = *(const u32x4*)(kp_ + 16 * hf); xa1 = *(const u32x4*)(kp_ + 16 * hf + 8); xb0 = *(const u32x4*)(kp_ + 32 + 16 * hf); xb1 = *(const u32x4*)(kp_ + 32 + 16 * hf + 8); \
        _Pragma("unroll") for (int q = 0; q < 4; ++q) { cv[q] = *(const f32x4*)(cosI + t_ * 32 + 16 * hf + 4 * q); sv[q] = *(const f32x4*)(sinI + t_ * 32 + 16 * hf + 4 * q); } } while (0)
    IDX_LOAD(0);
#pragma unroll
    for (int r = 0; r < 8; ++r) {
        if (r * 256 <= tmax) {
            __syncthreads();
            {
                const unsigned xa[8] = {xa0.x, xa0.y, xa0.z, xa0.w, xa1.x, xa1.y, xa1.z, xa1.w};
                const unsigned xb[8] = {xb0.x, xb0.y, xb0.z, xb0.w, xb1.x, xb1.y, xb1.z, xb1.w};
                unsigned o1[8], o2[8];
#pragma unroll
                for (int q = 0; q < 8; ++q) {
                    const float c0 = cv[q >> 1][2 * (q & 1)], c1 = cv[q >> 1][2 * (q & 1) + 1], s0 = sv[q >> 1][2 * (q & 1)], s1 = sv[q >> 1][2 * (q & 1) + 1];
                    const float a_lo = lo_f(xa[q]), a_hi = hi_f(xa[q]), b_lo = lo_f(xb[q]), b_hi = hi_f(xb[q]);
                    o1[q] = pk2(a_lo * c0 - b_lo * s0, a_hi * c1 - b_hi * s1);
                    o2[q] = pk2(b_lo * c0 + a_lo * s0, b_hi * c1 + a_hi * s1);
                }
                u32x4 v; unsigned char* dp = lds + IX_K + skey * TP;
                v.x = o1[0]; v.y = o1[1]; v.z = o1[2]; v.w = o1[3]; *(u32x4*)(dp + (16 * hf) * 2) = v;
                v.x = o1[4]; v.y = o1[5]; v.z = o1[6]; v.w = o1[7]; *(u32x4*)(dp + (16 * hf + 8) * 2) = v;
                v.x = o2[0]; v.y = o2[1]; v.z = o2[2]; v.w = o2[3]; *(u32x4*)(dp + (32 + 16 * hf) * 2) = v;
                v.x = o2[4]; v.y = o2[5]; v.z = o2[6]; v.w = o2[7]; *(u32x4*)(dp + (32 + 16 * hf + 8) * 2) = v;
            }
            __syncthreads();
            if ((r + 1) * 256 <= tmax) IDX_LOAD(r + 1);
            __builtin_amdgcn_sched_barrier(0);
#pragma unroll
            for (int tt = 0; tt < 16; ++tt) {
                const int i = r * 16 + tt;
                const unsigned char* kp = lds + IX_K + (16 * tt + fr) * TP + (8 * fq) * 2;
                f32x4 acc = {0.f, 0.f, 0.f, 0.f};
                acc = mfma16(a0, ld16(kp), acc);
                acc = mfma16(a1, ld16(kp + 64), acc);
                const float s = wi[0] * fmaxf(acc[0], 0.f) + wi[1] * fmaxf(acc[1], 0.f) + wi[2] * fmaxf(acc[2], 0.f) + wi[3] * fmaxf(acc[3], 0.f);
                const int key = 16 * i + fr;
                sc[i] = (key <= tq) ? sortable(s) : 0u;
            }
        } else {
#pragma unroll
            for (int tt = 0; tt < 16; ++tt) sc[r * 16 + tt] = 0u;
        }
    }
#undef IDX_LOAD
    const int ngrp = (tmax >> 8) + 1;
    unsigned thr = 0u; bool fin = false;
#pragma unroll 1
    for (int bit = 31; bit >= 0; --bit) {
        const unsigned cand = thr | (1u << bit);
        int cnt = 0;
#pragma unroll
        for (int g = 0; g < 8; ++g) if (g < ngrp) {
            bool pr[16];
#pragma unroll
            for (int tt = 0; tt < 16; ++tt) pr[tt] = sc[g * 16 + tt] >= cand;
            __builtin_amdgcn_sched_barrier(0);
#pragma unroll
            for (int tt = 0; tt < 16; ++tt) cnt += pr[tt] ? 1 : 0;
            __builtin_amdgcn_sched_barrier(0);
        }
        cnt = row16_sumi(cnt);
        if (!fin && cnt >= 256) { thr = cand; fin = (cnt == 256); }
        if (__ballot(!fin) == 0ull) break;
    }
    int ngt = 0;
#pragma unroll
    for (int g = 0; g < 8; ++g) if (g < ngrp) {
        bool pr[16];
#pragma unroll
        for (int tt = 0; tt < 16; ++tt) pr[tt] = sc[g * 16 + tt] > thr;
        __builtin_amdgcn_sched_barrier(0);
#pragma unroll
        for (int tt = 0; tt < 16; ++tt) ngt += pr[tt] ? 1 : 0;
        __builtin_amdgcn_sched_barrier(0);
    }
    ngt = row16_sumi(ngt);
    const int need = 256 - ngt;
    int run = 0;
    unsigned w4[4] = {0u, 0u, 0u, 0u};
    const unsigned lowmask = (1u << fr) - 1u;
#pragma unroll
    for (int g = 0; g < 8; ++g) if (g < ngrp) {
#pragma unroll
        for (int tt = 0; tt < 16; ++tt) {
            const int i = g * 16 + tt;
            const bool eq = (sc[i] == thr);
            const unsigned long long be = __ballot(eq);
            const unsigned eqrow = (unsigned)(be >> (16 * fq)) & 0xffffu;
            const int rank = run + __popc(eqrow & lowmask);
            const bool sel = (sc[i] > thr) || (eq && rank < need);
            run += __popc(eqrow);
            const unsigned long long bs = __ballot(sel);
            const unsigned selrow = (unsigned)(bs >> (16 * fq)) & 0xffffu;
            if (fr == ((i >> 1) & 15)) w4[i >> 5] |= selrow << (16 * (i & 1));
        }
    }
#pragma unroll
    for (int k = 0; k < 4; ++k) mask[16 * k + fr] = w4[k];
}

constexpr int SB_W = 0, SB_QG = 17408, SB_KDT = 34816, SB_A = 53248, SB_BYTES = 62464, SB_RED = 2 * 62464;
DI void scan_unit(const Params& p, int layer, int unit, unsigned char* lds) {
    int tid_ = threadIdx.x; asm volatile("" : "+v"(tid_)); const int tid = tid_, lane = tid & 63, wave = tid >> 6, fr = lane & 15, fq = lane >> 4;
    const int h = unit & 3, b = unit >> 2;
    unsigned char* ws = p.ws;
    const unsigned char* su0 = ws + WS_SCAN + (size_t)((b * 4 + h) * 32) * SCAN_UNIT_BYTES;
    const float decv = ((const float*)(ws + WS_DEC))[(b * 4 + h) * 32 + (lane & 31)];
    bf16_t* az = (bf16_t*)(ws + WS_AZ);
    float* red = (float*)(lds + SB_RED);
    const int dvc = h * 128 + 16 * wave + fr;
    const float onw = p.dn_onorm[layer * 128 + 16 * wave + fr];
    const int r16 = tid >> 4, c16 = tid & 15, r8 = tid >> 3, c8 = tid & 7;
    const int c16s = c16 ^ (((r16 >> 4) & 1) << 2), c8s = c8 ^ (((r8 >> 4) & 1) << 2);
    const int prow = 8 * (fr >> 2) + (fr & 3);
    const int swz = ((fr >> 3) & 1) << 2;
    u32x4 pw0, pw1, pq0, pq1, pk0, pk1, pa0; u32x2 pu[4];
#define SCAN_PREFETCH(cc) do { const unsigned char* su = su0 + (size_t)(cc) * SCAN_UNIT_BYTES; \
        pw0 = *(const u32x4*)(su + SU_W + tid * 16); pw1 = *(const u32x4*)(su + SU_W + 8192 + tid * 16); \
        pq0 = *(const u32x4*)(su + SU_QG + tid * 16); pq1 = *(const u32x4*)(su + SU_QG + 8192 + tid * 16); \
        pk0 = *(const u32x4*)(su + SU_KDT + tid * 16); pk1 = *(const u32x4*)(su + SU_KDT + 8192 + tid * 16); \
        pa0 = *(const u32x4*)(su + SU_A + tid * 16); \
        _Pragma("unroll") for (int mt = 0; mt < 4; ++mt) pu[mt] = *(const u32x2*)(su + SU_UT + ((16 * wave + fr) * 64 + 32 * (mt >> 1) + 8 * fq + 4 * (mt & 1)) * 2); \
        } while (0)
#define SCAN_STORE(bufp) do { unsigned char* bp = (bufp); \
        *(u32x4*)(bp + SB_W + r16 * QP + c16s * 16) = pw0; *(u32x4*)(bp + SB_W + (r16 + 32) * QP + c16s * 16) = pw1; \
        *(u32x4*)(bp + SB_QG + r16 * QP + c16s * 16) = pq0; *(u32x4*)(bp + SB_QG + (r16 + 32) * QP + c16s * 16) = pq1; \
        *(u32x4*)(bp + SB_KDT + r8 * TP + c8s * 16) = pk0; *(u32x4*)(bp + SB_KDT + (r8 + 64) * TP + c8s * 16) = pk1; \
        *(u32x4*)(bp + SB_A + r8 * TP + c8s * 16) = pa0; } while (0)
    f32x4 st[8];
#pragma unroll
    for (int m = 0; m < 8; ++m) st[m] = (f32x4){0.f, 0.f, 0.f, 0.f};
    SCAN_PREFETCH(0);
    SCAN_STORE(lds);
    u32x2 cu[4];
#pragma unroll
    for (int i = 0; i < 4; ++i) cu[i] = pu[i];
    __syncthreads();
    SCAN_PREFETCH(1);
#pragma unroll 1
    for (int c = 0; c < 32; ++c) {
        const int cur = c & 1;
        const unsigned char* bp = lds + cur * SB_BYTES;
        const float dg = __builtin_bit_cast(float, __builtin_amdgcn_readlane(__builtin_bit_cast(int, decv), c));
        bf16_t cz[16];
#pragma unroll
        for (int mt = 0; mt < 4; ++mt)
#pragma unroll
            for (int jj = 0; jj < 4; ++jj) cz[mt * 4 + jj] = az[((size_t)b * SEQ + c * 64 + 32 * (mt >> 1) + 8 * fq + 4 * (mt & 1) + jj) * 512 + dvc];
        bf16x8 sb[4];
#pragma unroll
        for (int s = 0; s < 4; ++s) sb[s] = packf(st[2 * s], st[2 * s + 1]);
        bf16x8 fw[4][4];
#pragma unroll
        for (int mt = 0; mt < 4; ++mt)
#pragma unroll
            for (int s = 0; s < 4; ++s) fw[mt][s] = ld16(bp + SB_W + (32 * (mt >> 1) + 4 * (mt & 1) + prow) * QP + (((4 * s) ^ swz) + fq) * 16);
        __builtin_amdgcn_sched_barrier(0);
        f32x4 vn[4];
#pragma unroll
        for (int mt = 0; mt < 4; ++mt) vn[mt] = (f32x4){0.f, 0.f, 0.f, 0.f};
#pragma unroll
        for (int s = 0; s < 4; ++s)
#pragma unroll
            for (int mt = 0; mt < 4; ++mt) vn[mt] = mfma16(fw[mt][s], sb[s], vn[mt]);
        __builtin_amdgcn_sched_barrier(0);
#pragma unroll
        for (int mt = 0; mt < 4; ++mt)
#pragma unroll
            for (int s = 0; s < 4; ++s) fw[mt][s] = ld16(bp + SB_QG + (32 * (mt >> 1) + 4 * (mt & 1) + prow) * QP + (((4 * s) ^ swz) + fq) * 16);
#pragma unroll
        for (int mt = 0; mt < 4; ++mt) {
            vn[mt][0] = lo_f(cu[mt].x) - vn[mt][0]; vn[mt][1] = hi_f(cu[mt].x) - vn[mt][1]; vn[mt][2] = lo_f(cu[mt].y) - vn[mt][2]; vn[mt][3] = hi_f(cu[mt].y) - vn[mt][3];
        }
        bf16x8 vb[2];
#pragma unroll
        for (int s2 = 0; s2 < 2; ++s2) vb[s2] = packf(vn[2 * s2], vn[2 * s2 + 1]);
        __builtin_amdgcn_sched_barrier(0);
        f32x4 o[4];
#pragma unroll
        for (int mt = 0; mt < 4; ++mt) o[mt] = (f32x4){0.f, 0.f, 0.f, 0.f};
#pragma unroll
        for (int s = 0; s < 4; ++s)
#pragma unroll
            for (int mt = 0; mt < 4; ++mt) o[mt] = mfma16(fw[mt][s], sb[s], o[mt]);
        __builtin_amdgcn_sched_barrier(0);
#pragma unroll
        for (int mt = 0; mt < 4; ++mt)
#pragma unroll
            for (int s2 = 0; s2 < 2; ++s2) fw[mt][s2] = ld16(bp + SB_A + (32 * (mt >> 1) + 4 * (mt & 1) + prow) * TP + (((4 * s2) ^ swz) + fq) * 16);
        __builtin_amdgcn_sched_barrier(0);
#pragma unroll
        for (int s2 = 0; s2 < 2; ++s2)
#pragma unroll
            for (int mt = 0; mt < 4; ++mt) o[mt] = mfma16(fw[mt][s2], vb[s2], o[mt]);
        __builtin_amdgcn_sched_barrier(0);
#pragma unroll
        for (int m = 0; m < 8; ++m)
#pragma unroll
            for (int s2 = 0; s2 < 2; ++s2) fw[m >> 1][(m & 1) * 2 + s2] = ld16(bp + SB_KDT + (32 * (m >> 1) + 4 * (m & 1) + prow) * TP + (((4 * s2) ^ swz) + fq) * 16);
#pragma unroll
        for (int m = 0; m < 8; ++m) st[m] = st[m] * dg;
        __builtin_amdgcn_sched_barrier(0);
#pragma unroll
        for (int s2 = 0; s2 < 2; ++s2)
#pragma unroll
            for (int m = 0; m < 8; ++m) st[m] = mfma16(fw[m >> 1][(m & 1) * 2 + s2], vb[s2], st[m]);
        __builtin_amdgcn_sched_barrier(0);
        {
            f32x4 sq[4];
#pragma unroll
            for (int mt = 0; mt < 4; ++mt)
#pragma unroll
                for (int jj = 0; jj < 4; ++jj) sq[mt][jj] = row16_sum(o[mt][jj] * o[mt][jj]);
            if (fr == 0) {
#pragma unroll
                for (int mt = 0; mt < 4; ++mt) *(f32x4*)(red + (cur * 8 + wave) * 64 + 32 * (mt >> 1) + 8 * fq + 4 * (mt & 1)) = sq[mt];
            }
        }
        if (c + 1 < 32) SCAN_STORE(lds + (cur ^ 1) * SB_BYTES);
        __syncthreads();
        u32x2 nu[4];
#pragma unroll
        for (int i = 0; i < 4; ++i) nu[i] = pu[i];
        if (c + 2 < 32) SCAN_PREFETCH(c + 2);
#pragma unroll
        for (int mt = 0; mt < 4; ++mt)
#pragma unroll
            for (int jj = 0; jj < 4; ++jj) {
                const int row = 32 * (mt >> 1) + 8 * fq + 4 * (mt & 1) + jj;
                float tot = 0.f;
#pragma unroll
                for (int w8 = 0; w8 < 8; ++w8) tot += red[(cur * 8 + w8) * 64 + row];
                const float rstd = __builtin_amdgcn_rsqf(tot * (1.0f / 128.0f) + NORM_EPS);
                const float zv = bf2f(cz[mt * 4 + jj]);
                const float y = o[mt][jj] * rstd * onw * zv * __builtin_amdgcn_rcpf(1.0f + __expf(-zv));
                az[((size_t)b * SEQ + c * 64 + row) * 512 + dvc] = (bf16_t)f2bf(y);
            }
#pragma unroll
        for (int i = 0; i < 4; ++i) cu[i] = nu[i];
    }
#undef SCAN_PREFETCH
#undef SCAN_STORE
}

constexpr int AT_K = 0, AT_VT = 17408;
DI void attn_unit(const Params& p, int unit, unsigned char* lds) {
    int tid_ = threadIdx.x; asm volatile("" : "+v"(tid_)); const int tid = tid_, lane = tid & 63, wave = tid >> 6, fr = lane & 15, fq = lane >> 4;
    const int qb = 15 - (unit >> 5), bh = unit & 31, b = bh >> 2, hh = bh & 3;
    unsigned char* ws = p.ws;
    const bf16_t* cq = (const bf16_t*)(ws + WS_CQKV);
    const int q0 = qb * 128, tq = q0 + 16 * wave + fr;
    const size_t tokq = (size_t)b * SEQ + tq;
    const unsigned* mrow = (const unsigned*)(ws + WS_MASK) + tokq * 64;
    bf16x8 qf[4];
#pragma unroll
    for (int s = 0; s < 4; ++s) qf[s] = *(const bf16x8*)(cq + tokq * 1536 + hh * 128 + 32 * s + 8 * fq);
    f32x4 oacc[8];
#pragma unroll
    for (int i = 0; i < 8; ++i) oacc[i] = (f32x4){0.f, 0.f, 0.f, 0.f};
    float mrun = -INFINITY, lrun = 0.f;
    const int nkt = (q0 + 128) / 64;
    const int kr = tid >> 4, kc = tid & 15, vk = 2 * (tid & 31), vp = tid >> 5;
    const int kcs = kc ^ (((kr >> 4) & 1) << 2);
    const int prow = 8 * (fr >> 2) + (fr & 3), swz = ((fr >> 3) & 1) << 2;
    u32x4 gk0, gk1, gv0, gv1;
#define ATT_PREFETCH(kt) do { const size_t kb = (size_t)b * SEQ + (size_t)(kt) * 64; \
        gk0 = *(const u32x4*)(cq + (kb + kr) * 1536 + 512 + hh * 128 + kc * 8); gk1 = *(const u32x4*)(cq + (kb + kr + 32) * 1536 + 512 + hh * 128 + kc * 8); \
        gv0 = *(const u32x4*)(cq + (kb + vk) * 1536 + 1024 + hh * 128 + vp * 8); gv1 = *(const u32x4*)(cq + (kb + vk + 1) * 1536 + 1024 + hh * 128 + vp * 8); } while (0)
    ATT_PREFETCH(0);
    const float scl = 0.08838834764831845f * 1.4426950408889634f;
#pragma unroll 1
    for (int kt = 0; kt < nkt; ++kt) {
        __syncthreads();
        *(u32x4*)(lds + AT_K + kr * QP + kcs * 16) = gk0; *(u32x4*)(lds + AT_K + (kr + 32) * QP + kcs * 16) = gk1;
        {
            const unsigned a[4] = {gv0.x, gv0.y, gv0.z, gv0.w}, c4[4] = {gv1.x, gv1.y, gv1.z, gv1.w};
#pragma unroll
            for (int e = 0; e < 4; ++e) {
                *(unsigned*)(lds + AT_VT + (8 * vp + 2 * e) * TP + vk * 2) = (a[e] & 0xffffu) | (c4[e] << 16);
                *(unsigned*)(lds + AT_VT + (8 * vp + 2 * e + 1) * TP + vk * 2) = (a[e] >> 16) | (c4[e] & 0xffff0000u);
            }
        }
        const u32x2 mw = *(const u32x2*)(mrow + 2 * kt);
        __syncthreads();
        if (kt + 1 < nkt) ATT_PREFETCH(kt + 1);
        bf16x8 kf[4][4];
#pragma unroll
        for (int nt = 0; nt < 4; ++nt)
#pragma unroll
            for (int s = 0; s < 4; ++s) kf[nt][s] = ld16(lds + AT_K + (32 * (nt >> 1) + 4 * (nt & 1) + prow) * QP + (((4 * s) ^ swz) + fq) * 16);
        __builtin_amdgcn_sched_barrier(0);
        f32x4 sacc[4];
#pragma unroll
        for (int nt = 0; nt < 4; ++nt) sacc[nt] = (f32x4){0.f, 0.f, 0.f, 0.f};
#pragma unroll
        for (int s = 0; s < 4; ++s)
#pragma unroll
            for (int nt = 0; nt < 4; ++nt) sacc[nt] = mfma16(kf[nt][s], qf[s], sacc[nt]);
        __builtin_amdgcn_sched_barrier(0);
#pragma unroll
        for (int nd = 0; nd < 8; ++nd)
#pragma unroll
            for (int s2 = 0; s2 < 2; ++s2) kf[nd >> 1][(nd & 1) * 2 + s2] = ld16(lds + AT_VT + (16 * nd + fr) * TP + (32 * s2 + 8 * fq) * 2);
        float mx = -INFINITY;
#pragma unroll
        for (int nt = 0; nt < 4; ++nt)
#pragma unroll
            for (int jj = 0; jj < 4; ++jj) { const int kk = 32 * (nt >> 1) + 8 * fq + 4 * (nt & 1) + jj; const unsigned wsel = (nt < 2) ? mw.x : mw.y;
                const bool on = (wsel >> (kk & 31)) & 1u;
                const float v = on ? sacc[nt][jj] : -INFINITY; sacc[nt][jj] = v; mx = fmaxf(mx, v); }
        mx = fmaxf(mx, __shfl_xor(mx, 16)); mx = fmaxf(mx, __shfl_xor(mx, 32));
        const float mnew = fmaxf(mrun, mx);
        const float msafe = (mnew == -INFINITY) ? 0.f : mnew;
        const float alpha = __builtin_amdgcn_exp2f((mrun - msafe) * scl);
        const float moff = -msafe * scl;
        mrun = mnew;
        float ps = 0.f;
#pragma unroll
        for (int nt = 0; nt < 4; ++nt)
#pragma unroll
            for (int jj = 0; jj < 4; ++jj) { const float pv = __builtin_amdgcn_exp2f(__builtin_fmaf(sacc[nt][jj], scl, moff)); sacc[nt][jj] = pv; ps += pv; }
        lrun = lrun * alpha + ps;
        bf16x8 pb[2];
#pragma unroll
        for (int s2 = 0; s2 < 2; ++s2) pb[s2] = packf(sacc[2 * s2], sacc[2 * s2 + 1]);
#pragma unroll
        for (int nd = 0; nd < 8; ++nd) oacc[nd] = oacc[nd] * alpha;
        __builtin_amdgcn_sched_barrier(0);
#pragma unroll
        for (int s2 = 0; s2 < 2; ++s2)
#pragma unroll
            for (int nd = 0; nd < 8; ++nd) oacc[nd] = mfma16(kf[nd >> 1][(nd & 1) * 2 + s2], pb[s2], oacc[nd]);
        __builtin_amdgcn_sched_barrier(0);
    }
#undef ATT_PREFETCH
    lrun += __shfl_xor(lrun, 16); lrun += __shfl_xor(lrun, 32);
    const float inv = 1.0f / lrun;
    bf16_t* czp = (bf16_t*)(ws + WS_CZ) + tokq * 512 + hh * 128;
#pragma unroll
    for (int nd = 0; nd < 8; ++nd) {
        bf16_t* zp = czp + 16 * nd + 4 * fq;
        const u32x2 zz = *(const u32x2*)zp;
        f32x4 o; o[0] = oacc[nd][0] * inv * siluf(lo_f(zz.x)); o[1] = oacc[nd][1] * inv * siluf(hi_f(zz.x)); o[2] = oacc[nd][2] * inv * siluf(lo_f(zz.y)); o[3] = oacc[nd][3] * inv * siluf(hi_f(zz.y));
        *(u32x2*)zp = pack4(o);
    }
}

DI void rms_unit(const Params& p, int layer, const float* xin, int unit) {
    int tid_ = threadIdx.x; asm volatile("" : "+v"(tid_)); const int lane = tid_ & 63, wave = tid_ >> 6;
    const float* ng = p.norm_g + layer * DM;
    for (int i = 0; i < 8; i += 2) { const size_t m = (size_t)unit * 64 + wave * 8 + i; rms_row2(xin + m * DM, ng, (bf16_t*)(p.ws + WS_H2) + m * DM, lane); }
}

#ifndef GEMM_ALIGN
#define GEMM_ALIGN true
#endif
#ifndef GEMM_SP2
#define GEMM_SP2 true
#endif
#ifndef MK_SPLIT
#define MK_SPLIT 0
#endif
constexpr int NPHASE = 14;
constexpr int P2_IDX = 512, P2_DN = 1024, P2_POOL = 1024, P2_SA = 256, P2_TOTAL = P2_IDX + P2_DN + P2_POOL + P2_SA;
constexpr int P3_SCAN = 32, P3_ATT = 512, P3_RMS = 256, P3_TOTAL = P3_SCAN + P3_ATT + P3_RMS;

__global__ void __launch_bounds__(NTHR, 2) hybrid_fwd(Params p) {
    extern __shared__ __attribute__((aligned(16))) unsigned char lds[];
    unsigned char* ws = p.ws;
    unsigned* ctl = (unsigned*)(ws + WS_CTL);
    const int G = gridDim.x;
    PG8_LAS unsigned char* glds = (PG8_LAS unsigned char*)lds;
#if MK_SPLIT
#define SEAM(k) do { } while (0)
#else
    cg::grid_group grid = cg::this_grid();
    volatile LAS unsigned* bst = (volatile LAS unsigned*)((LAS unsigned char*)lds + LDS_SLOT + 16);
    if (threadIdx.x == 0) { bst[0] = 0u; bst[1] = 0u; }
    __syncthreads();
    XcdBarrier bar = xcd_barrier_post(ctl + 1024, bst);
#define SEAM(k) do { if (p.ph_lo <= (k) && (k) + 1 < p.ph_hi) { if (p.ph_hi > NPHASE) grid.sync(); else xcd_barrier(bar); } } while (0)
#endif
#define IN(k) (p.ph_lo <= (k) && (k) < p.ph_hi)
#ifdef PROBE_K
#ifndef PROBE_BLK
#define PROBE_BLK 0
#endif
#ifndef PROBE_T1
#define PROBE_T1 (PROBE_K + 1)
#endif
#define stamps ((unsigned long long*)(p.ws + WS_CTL + 24576))
#define STAMP(k) do { int t_ = threadIdx.x; asm volatile("" : "+v"(t_)); if (blockIdx.x == 0 && t_ == 0) stamps[(k)] = __builtin_amdgcn_s_memrealtime(); } while (0)
    STAMP(0);
#else
#define STAMP(k) do { } while (0)
#endif
#pragma unroll 1
    for (int layer = 0; layer < 2; ++layer) {
        const int pb = layer * 7;
        const float* xin = layer == 0 ? p.x : (const float*)p.out;
        if (IN(pb + 0)) {
#ifndef NO_P0
 phase0(p, layer, xin, lds);
#endif
 }
        SEAM(pb + 0); STAMP(pb + 0 + 1);
        if (IN(pb + 1)) {
            pg8::Gemm g{(const bf16_t*)(ws + WS_H), (const bf16_t*)(ws + WS_WIN1), MTOK, N1, 1024}; pg8::StaticOrder S; S.init(MTOK, N1, G, (int)blockIdx.x);
            pg8::EpiProj E{ws};

#ifndef NO_G1
 pg8::gemm_phase<pg8::EpiProj, pg8::StaticOrder, GEMM_ALIGN, GEMM_SP2>(glds, g, S, E);
#endif

        }
        SEAM(pb + 1); STAMP(pb + 1 + 1);
        if (IN(pb + 2)) {
            const int k = (int)blockIdx.x;
            for (int i = k; i < P2_IDX / 2; i += G) { __syncthreads(); indexer_unit(p, i, lds);
#ifdef PROBE_K
                { int t_ = threadIdx.x; asm volatile("" : "+v"(t_)); if (layer == 0 && (int)blockIdx.x == PROBE_BLK && t_ == 0) stamps[24] = __builtin_amdgcn_s_memrealtime(); }
#endif
                __syncthreads(); indexer_unit(p, P2_IDX - 1 - i, lds);
#ifdef PROBE_K
                { int t_ = threadIdx.x; asm volatile("" : "+v"(t_)); if (layer == 0 && (int)blockIdx.x == PROBE_BLK && t_ == 0) stamps[25] = __builtin_amdgcn_s_memrealtime(); }
#endif
            }
#ifdef PROBE_K
            if (layer == 0 && threadIdx.x == 0) atomicMax(&stamps[22], (unsigned long long)__builtin_amdgcn_s_memrealtime());
#endif
            for (int u = k; u < P2_DN; u += G) { __syncthreads(); dn_prep_unit(p, layer, u, lds); }
#ifdef PROBE_K
            if (layer == 0 && threadIdx.x == 0) atomicMax(&stamps[23], (unsigned long long)__builtin_amdgcn_s_memrealtime());
#endif
            for (int u = k; u < P2_SA; u += G) { __syncthreads(); sa_prep_unit(p, layer, u, lds); }
        }
        SEAM(pb + 2); STAMP(pb + 2 + 1);
        if (IN(pb + 3)) {
            const int k = (int)blockIdx.x, nsc = (G > 2 * P3_SCAN) ? P3_SCAN : 0, nb = G - nsc;
            if (k < nsc) {
                scan_unit(p, layer, k, lds);
#ifdef PROBE_K
                { int t_ = threadIdx.x; asm volatile("" : "+v"(t_)); if (layer == 0 && k == 0 && t_ == 0) stamps[20] = __builtin_amdgcn_s_memrealtime(); }
#endif
            } else {
                const int j = k - nsc;
                if (nsc == 0) for (int u = j; u < P3_SCAN; u += nb) { __syncthreads(); scan_unit(p, layer, u, lds); }
                for (int r = 0; r * nb < P3_ATT; ++r) { const int i = r * nb + ((r & 1) ? (nb - 1 - j) : j); if (i < P3_ATT) { __syncthreads(); attn_unit(p, i, lds); } }
#ifdef PROBE_K
                if (layer == 0 && threadIdx.x == 0) atomicMax(&stamps[21], (unsigned long long)__builtin_amdgcn_s_memrealtime());
#endif
                for (int u = j; u < P3_RMS; u += nb) rms_unit(p, layer, xin, u);
                for (int u = j; u < P2_POOL; u += nb) { __syncthreads(); pool_unit(p, layer, u, lds); }
            }
        }
        SEAM(pb + 3); STAMP(pb + 3 + 1);
        if (IN(pb + 4)) {
            pg8::Gemm g{(const bf16_t*)(ws + WS_H2), (const bf16_t*)(ws + WS_WG), MTOK, NG, 1024}; pg8::GateOrder S; S.init(G, (int)blockIdx.x);
            pg8::EpiGate E{ws, p.gate_b + layer * 3072};

#ifndef NO_G4
 pg8::gemm_phase<pg8::EpiGate, pg8::GateOrder, GEMM_ALIGN, GEMM_SP2>(glds, g, S, E);
#endif

        }
        asm volatile("s_waitcnt vmcnt(0)" ::: "memory"); __syncthreads(); STAMP(pb + 4 + 1);
        if (IN(pb + 5)) {
            pg8::Gemm g{(const bf16_t*)(ws + WS_AZ), (const bf16_t*)(ws + WS_WBR), 3 * MTOK, 3072, 512}; pg8::MergeOrder S; S.init(G, (int)blockIdx.x);
            pg8::EpiMerge E{ws};

#ifndef NO_G5
 pg8::gemm_phase<pg8::EpiMerge, pg8::MergeOrder, GEMM_ALIGN, GEMM_SP2>(glds, g, S, E);
#endif

        }
        SEAM(pb + 5); STAMP(pb + 5 + 1);
        if (IN(pb + 6)) {
            pg8::Gemm g{(const bf16_t*)(ws + WS_MERGED), (const bf16_t*)(ws + WS_WO), MTOK, 1024, 1024}; pg8::StaticOrder S; S.init(MTOK, 1024, G, (int)blockIdx.x);
            pg8::EpiOut E{xin, p.out};

#ifndef NO_G6
 pg8::gemm_phase<pg8::EpiOut, pg8::StaticOrder, GEMM_ALIGN, GEMM_SP2>(glds, g, S, E);
#endif

        }
        SEAM(pb + 6); STAMP(pb + 6 + 1);
    }
#ifdef PROBE_K
    __syncthreads();
    if (threadIdx.x == 0) __threadfence();
    xcd_barrier(bar);
    {
        const unsigned long long t0 = __hip_atomic_load(&stamps[PROBE_K], __ATOMIC_RELAXED, __HIP_MEMORY_SCOPE_AGENT), t1 = __hip_atomic_load(&stamps[PROBE_T1], __ATOMIC_RELAXED, __HIP_MEMORY_SCOPE_AGENT);
#ifdef PROBE_A
        const unsigned long long ta = __hip_atomic_load(&stamps[PROBE_A], __ATOMIC_RELAXED, __HIP_MEMORY_SCOPE_AGENT), tb = __hip_atomic_load(&stamps[PROBE_B], __ATOMIC_RELAXED, __HIP_MEMORY_SCOPE_AGENT);
        const float d1 = (float)(ta - t0) * 0.01f, d2 = (float)(tb - t0) * 0.01f * 30.0f;
        for (int i = blockIdx.x * NTHR + threadIdx.x; i < (1 << 20); i += gridDim.x * NTHR) p.out[i] += d1;
        if (blockIdx.x == 0 && threadIdx.x == 0) p.out[(1 << 21) + 12345] += d2;
#else
        const float dlt = (float)(t1 - t0) * 0.01f * 2e-5f;
        for (int i = blockIdx.x * NTHR + threadIdx.x; i < (1 << 20); i += gridDim.x * NTHR) p.out[i] += dlt;
#endif
    }
#endif
#undef IN
#undef SEAM
}

extern "C" void kernel_launch(void* const* d_in, const int* in_sizes, int n_in, void* d_out, int out_size, void* d_ws, size_t ws_size, hipStream_t stream) {
    static int grid = 0;
    if (grid == 0) {
        if (n_in != 14 || in_sizes[0] != MTOK * DM || out_size != MTOK * DM || ws_size < WS_END) { fprintf(stderr, "kernel_launch: unexpected shapes / workspace (%d inputs, ws %zu)\n", n_in, ws_size); grid = -1; return; }
        int dev = 0, cus = 0, per_cu = 0;
        if (hipGetDevice(&dev) != hipSuccess || hipDeviceGetAttribute(&cus, hipDeviceAttributeMultiprocessorCount, dev) != hipSuccess) { grid = -1; return; }
        if (hipFuncSetAttribute((const void*)hybrid_fwd, hipFuncAttributeMaxDynamicSharedMemorySize, LDS_BYTES) != hipSuccess) { fprintf(stderr, "kernel_launch: hipFuncSetAttribute failed\n"); grid = -1; return; }
        if (hipOccupancyMaxActiveBlocksPerMultiprocessor(&per_cu, (const void*)hybrid_fwd, NTHR, LDS_BYTES) != hipSuccess || per_cu < 1) { fprintf(stderr, "kernel_launch: occupancy query says %d\n", per_cu); per_cu = 1; }
        (void)hipGetLastError();
        grid = cus * per_cu;
    }
    if (grid < 0) return;
    (void)hipMemsetAsync((char*)d_ws + WS_CTL, 0, CTL_BYTES, stream);
    Params p{};
    p.x = (const float*)d_in[0]; p.norm_g = (const float*)d_in[1]; p.w_in = (const float*)d_in[2]; p.gate_b = (const float*)d_in[3]; p.conv_w = (const float*)d_in[4];
    p.a_log = (const float*)d_in[5]; p.dt_bias = (const float*)d_in[6]; p.dn_onorm = (const float*)d_in[7]; p.pool_w = (const float*)d_in[8]; p.pool_scale = (const float*)d_in[9];
    p.q_norm = (const float*)d_in[10]; p.k_norm = (const float*)d_in[11]; p.w_branch = (const float*)d_in[12]; p.w_out = (const float*)d_in[13];
    p.out = (float*)d_out; p.ws = (unsigned char*)d_ws;
#if MK_SPLIT
    for (int ph = 0; ph < NPHASE; ++ph) { p.ph_lo = ph; p.ph_hi = ph + 1; hipLaunchKernelGGL(hybrid_fwd, dim3(grid), dim3(NTHR), LDS_BYTES, stream, p); }
#else
    p.ph_lo = 0; p.ph_hi = NPHASE;
    void* args[] = {&p};
    const hipError_t e = hipLaunchCooperativeKernel((const void*)hybrid_fwd, dim3(grid), dim3(NTHR), args, LDS_BYTES, stream);
    if (e != hipSuccess) fprintf(stderr, "kernel_launch: cooperative launch failed: %s (grid %d)\n", hipGetErrorString(e), grid);
#endif
}
```
